# Optimizing an MI355X kernel written in HIP

```python
import jax, jax.numpy as jnp
from jax import lax
import numpy as np

D_MODEL = 1024
BATCH = 32
SEQ = 2048
DEPTH = 1

RET_HEADS = 4
RET_HEAD_DIM = 128
RET_WIDTH = RET_HEADS * RET_HEAD_DIM
RET_CHUNK = 128
RET_ROPE_BASE = 10000.0
ATT_HEADS = 8
ATT_HEAD_DIM = 64
ATT_WIDTH = ATT_HEADS * ATT_HEAD_DIM
ATT_ROT_DIM = ATT_HEAD_DIM // 4
ATT_ROPE_BASE = 500000.0
MOBA_BLOCK = 256
MOBA_TOPK = 3
QUERY_BLOCK = 128
MIX_WIDTH = RET_WIDTH + ATT_WIDTH
IN_WIDTH = 4 * RET_WIDTH + 3 * ATT_WIDTH
FFN_DIM = 2816
NORM_EPS = 1e-6

kernel_name = "hybrid_retention_moba_macaron"


def _rms(x, w=None):
    xf = x.astype(jnp.float32)
    y = xf * lax.rsqrt(jnp.mean(xf * xf, axis=-1, keepdims=True) + NORM_EPS)
    if w is not None:
        y = y * w.astype(jnp.float32)
    return y.astype(x.dtype)


def _rope(x, theta, rot_dim):
    s = x.shape[1]
    half = rot_dim // 2
    inv_freq = theta ** (-jnp.arange(half, dtype=jnp.float32) * 2.0 / rot_dim)
    ang = jnp.arange(s, dtype=jnp.float32)[:, None] * inv_freq[None, :]
    cos = jnp.cos(ang)[None, :, None, :]
    sin = jnp.sin(ang)[None, :, None, :]
    xf = x.astype(jnp.float32)
    x1 = xf[..., :half]
    x2 = xf[..., half:rot_dim]
    out = jnp.concatenate([x1 * cos - x2 * sin, x2 * cos + x1 * sin, xf[..., rot_dim:]], axis=-1)
    return out.astype(x.dtype)


def _swiglu(h, w_gate, w_up, w_down):
    return (jax.nn.silu(h @ w_gate) * (h @ w_up)) @ w_down


def _retention(q, k, v):
    b, s, h, d = q.shape
    c = RET_CHUNK
    n = s // c
    log_g = jnp.log(1.0 - 2.0 ** (-5.0 - jnp.arange(h, dtype=jnp.float32)))
    i = jnp.arange(c, dtype=jnp.float32)
    diff = i[:, None] - i[None, :]
    inner_decay = jnp.where(diff[None] >= 0,
                            jnp.exp(jnp.maximum(diff, 0.0)[None] * log_g[:, None, None]), 0.0)
    q_decay = jnp.exp((i[None, :] + 1.0) * log_g[:, None])[None, :, :, None]
    k_decay = jnp.exp((c - 1.0 - i[None, :]) * log_g[:, None])[None, :, :, None]
    chunk_decay = jnp.exp(c * log_g)[None, :, None, None]

    def to_chunks(t):
        return t.reshape(b, n, c, h, d).transpose(1, 0, 3, 2, 4)

    def step(state, qkv):
        qc, kc, vc = qkv
        scores = jnp.einsum('bhid,bhjd->bhij', qc, kc) * inner_decay
        o = jnp.einsum('bhij,bhjd->bhid', scores, vc)
        o = o + jnp.einsum('bhid,bhde->bhie', qc, state) * q_decay
        state = state * chunk_decay + jnp.einsum('bhjd,bhje->bhde', kc * k_decay, vc)
        return state, o

    state0 = jnp.zeros((b, h, d, d), jnp.float32)
    _, o = lax.scan(step, state0, (to_chunks(q), to_chunks(k), to_chunks(v)))
    return o.transpose(1, 0, 3, 2, 4).reshape(b, s, h, d)


def _moba(q, k, v):
    b, s, h, dh = q.shape
    bs = MOBA_BLOCK
    qb = QUERY_BLOCK
    nb = -(-s // bs)
    pad = nb * bs - s
    nq = s // qb
    n_sel = min(MOBA_TOPK, nb)
    scale = dh ** -0.5
    qh = q.transpose(0, 2, 1, 3)
    kh = jnp.pad(k.transpose(0, 2, 1, 3), ((0, 0), (0, 0), (0, pad), (0, 0)))
    vh = jnp.pad(v.transpose(0, 2, 1, 3), ((0, 0), (0, 0), (0, pad), (0, 0)))
    k_blocks = kh.reshape(b, h, nb, bs, dh)
    v_blocks = vh.reshape(b, h, nb, bs, dh)
    k_mean = jnp.mean(k_blocks.astype(jnp.float32), axis=3)
    own = jnp.arange(s) // bs
    gate = jnp.einsum('bhsd,bhnd->bhsn', qh.astype(jnp.float32), k_mean)
    past = jnp.arange(nb)[None, :] < own[:, None]
    gate = jnp.where(past, gate, -jnp.inf)
    _, idx = lax.top_k(gate, n_sel)
    valid = idx < own[:, None]

    def blocks(t):
        t = t.reshape(b, h, nq, qb, *t.shape[3:])
        t = jnp.moveaxis(t, 2, 1)
        return t.reshape(b * nq, h, qb, *t.shape[4:])

    batch_id = jnp.repeat(jnp.arange(b), nq)
    qblk_id = jnp.tile(jnp.arange(nq), b)
    head_ix = jnp.arange(h)[:, None, None]

    def attend(args):
        qi, idx_i, valid_i, bi, ji = args
        kb = k_blocks[bi]
        vb = v_blocks[bi]
        k_sel = kb[head_ix, idx_i]
        v_sel = vb[head_ix, idx_i]
        own_blk = (ji * qb) // bs
        k_own = lax.dynamic_index_in_dim(kb, own_blk, axis=1, keepdims=False)
        v_own = lax.dynamic_index_in_dim(vb, own_blk, axis=1, keepdims=False)
        s_sel = jnp.einsum('hqd,hqnkd->hqnk', qi, k_sel).astype(jnp.float32) * scale
        s_sel = jnp.where(valid_i[..., None], s_sel, -jnp.inf)
        s_own = jnp.einsum('hqd,hkd->hqk', qi, k_own).astype(jnp.float32) * scale
        q_pos = ji * qb + jnp.arange(qb)
        k_pos = own_blk * bs + jnp.arange(bs)
        s_own = jnp.where(k_pos[None, None, :] <= q_pos[None, :, None], s_own, -jnp.inf)
        logits = jnp.concatenate([s_sel.reshape(h, qb, n_sel * bs), s_own], axis=-1)
        p = jax.nn.softmax(logits, axis=-1).astype(qi.dtype)
        p_sel = p[..., :n_sel * bs].reshape(h, qb, n_sel, bs)
        p_own = p[..., n_sel * bs:]
        return (jnp.einsum('hqnk,hqnkd->hqd', p_sel, v_sel)
                + jnp.einsum('hqk,hkd->hqd', p_own, v_own))

    out = lax.map(attend, (blocks(qh), blocks(idx), blocks(valid), batch_id, qblk_id))
    return out.reshape(b, nq, h, qb, dh).transpose(0, 1, 3, 2, 4).reshape(b, s, h * dh)


def setup_inputs(seed: int = 0) -> dict:
    key = jax.random.key(seed)
    ks = jax.random.split(key, 16)
    L = DEPTH

    def w(k, shape, fan_in):
        return jax.random.normal(k, shape, jnp.float32) * fan_in ** -0.5

    def gain(k, shape):
        return 1.0 + 0.02 * jax.random.normal(k, shape, jnp.float32)

    return {
        "x": jax.random.normal(ks[0], (BATCH, SEQ, D_MODEL), jnp.float32),
        "ffn1_norm_w": gain(ks[1], (L, D_MODEL)),
        "ffn1_w_gate": w(ks[2], (L, D_MODEL, FFN_DIM), D_MODEL),
        "ffn1_w_up": w(ks[3], (L, D_MODEL, FFN_DIM), D_MODEL),
        "ffn1_w_down": w(ks[4], (L, FFN_DIM, D_MODEL), FFN_DIM),
        "mix_norm_w": gain(ks[5], (L, D_MODEL)),
        "w_in": w(ks[6], (L, D_MODEL, IN_WIDTH), D_MODEL),
        "ret_out_beta": gain(ks[7], (L, RET_WIDTH)),
        "q_norm_w": gain(ks[8], (L, ATT_HEAD_DIM)),
        "k_norm_w": gain(ks[9], (L, ATT_HEAD_DIM)),
        "att_out_beta": gain(ks[10], (L, ATT_WIDTH)),
        "w_out": w(ks[11], (L, MIX_WIDTH, D_MODEL), MIX_WIDTH),
        "ffn2_norm_w": gain(ks[12], (L, D_MODEL)),
        "ffn2_w_gate": w(ks[13], (L, D_MODEL, FFN_DIM), D_MODEL),
        "ffn2_w_up": w(ks[14], (L, D_MODEL, FFN_DIM), D_MODEL),
        "ffn2_w_down": w(ks[15], (L, FFN_DIM, D_MODEL), FFN_DIM),
    }


def reference(x, ffn1_norm_w, ffn1_w_gate, ffn1_w_up, ffn1_w_down, mix_norm_w, w_in,
              ret_out_beta, q_norm_w, k_norm_w, att_out_beta, w_out,
              ffn2_norm_w, ffn2_w_gate, ffn2_w_up, ffn2_w_down):
    b, s, _ = x.shape
    R = RET_WIDTH
    A = ATT_WIDTH
    for l in range(DEPTH):
        x = x + 0.5 * _swiglu(_rms(x, ffn1_norm_w[l]), ffn1_w_gate[l], ffn1_w_up[l], ffn1_w_down[l])

        hn = _rms(x, mix_norm_w[l])
        proj = hn @ w_in[l]
        rq = proj[..., 0:R].reshape(b, s, RET_HEADS, RET_HEAD_DIM)
        rk = proj[..., R:2 * R].reshape(b, s, RET_HEADS, RET_HEAD_DIM)
        rv = proj[..., 2 * R:3 * R].reshape(b, s, RET_HEADS, RET_HEAD_DIM)
        rg = proj[..., 3 * R:4 * R]
        o0 = 4 * R
        aq = proj[..., o0:o0 + A].reshape(b, s, ATT_HEADS, ATT_HEAD_DIM)
        ak = proj[..., o0 + A:o0 + 2 * A].reshape(b, s, ATT_HEADS, ATT_HEAD_DIM)
        av = proj[..., o0 + 2 * A:o0 + 3 * A].reshape(b, s, ATT_HEADS, ATT_HEAD_DIM)

        rq = _rope(rq, RET_ROPE_BASE, RET_HEAD_DIM)
        rk = _rope(rk, RET_ROPE_BASE, RET_HEAD_DIM) * (RET_HEAD_DIM ** -0.5)
        ret = _retention(rq.astype(jnp.float32), rk.astype(jnp.float32), rv.astype(jnp.float32))
        ret = _rms(ret).reshape(b, s, R).astype(x.dtype)
        ret = ret * jax.nn.silu(rg) * ret_out_beta[l]

        aq = _rope(_rms(aq, q_norm_w[l]), ATT_ROPE_BASE, ATT_ROT_DIM)
        ak = _rope(_rms(ak, k_norm_w[l]), ATT_ROPE_BASE, ATT_ROT_DIM)
        att = _moba(aq, ak, av)
        att = _rms(att.reshape(b, s, ATT_HEADS, ATT_HEAD_DIM)).reshape(b, s, A) * att_out_beta[l]

        x = x + jnp.concatenate([ret, att], axis=-1) @ w_out[l]

        x = x + 0.5 * _swiglu(_rms(x, ffn2_norm_w[l]), ffn2_w_gate[l], ffn2_w_up[l], ffn2_w_down[l])
    return x
```

```cpp
#include <hip/hip_runtime.h>
#include <cstdio>
#include <cstdint>
#include <cmath>
namespace pg8 {
#define PG8_LAS __attribute__((address_space(3)))
typedef unsigned short bf16_t;
typedef short bf16x8 __attribute__((ext_vector_type(8)));
typedef float f32x4 __attribute__((ext_vector_type(4)));
typedef unsigned u32x4 __attribute__((ext_vector_type(4)));
constexpr int BM = 256, BK = 64, HALF = 128, HTB = HALF * BK * 2  , STAGE_BYTES = 8 * HTB, NXCD = 8, WGM = 8;

__host__ __device__ __forceinline__ int lds_byte(int r, int c) { const int st = (r >> 4) * 2 + (c >> 5), rr = r & 15, cc = c & 31, ob = rr * 64 + cc * 2; return st * 1024 + (ob ^ (((ob >> 9) & 1) << 5)); }
__host__ __device__ __forceinline__ void stage_rc(int b, int& R, int& C) { const int st = b / 1024, sb = b % 1024, swz = sb ^ (((sb >> 9) & 1) << 5); R = (st >> 1) * 16 + swz / 64; C = (st & 1) * 32 + (swz % 64) / 2; }
__host__ __device__ __forceinline__ int perm32(int rho) { const int n = rho >> 4, i = rho & 15; return 8 * (i >> 2) + 4 * n + (i & 3); }

struct Unit { int pm, pn; };
struct Gemm { const bf16_t* A; const bf16_t* Bt; int M, N, K; };

struct StaticOrder {
    int nM, nN, nwg, G, c;
    __host__ __device__ void init(int M, int N, int G_, int c_) { nM = M / BM; nN = N / BM; nwg = nM * nN; G = G_; c = c_; }
    __host__ __device__ bool next(int i, Unit& u) const {
        const long L = (long)i * G + c; if (L >= nwg) return false;
        int wgid = (int)L; { const int q = nwg / NXCD, r = nwg % NXCD, xcd = wgid % NXCD, off = wgid / NXCD; wgid = (xcd < r ? xcd * (q + 1) : r * (q + 1) + (xcd - r) * q) + off; }
        const int nig = WGM * nN, gid = wgid / nig, fm = gid * WGM, gsz = (nM - fm) < WGM ? (nM - fm) : WGM;
        u.pm = fm + ((wgid % nig) % gsz); u.pn = (wgid % nig) / gsz; return true;
    }
    __device__ __forceinline__ void a_ready(const Unit&) const {}
    __device__ __forceinline__ void done(const Unit&) const {}
};

__device__ __forceinline__ unsigned cvt_pk_bf16(float lo, float hi) { unsigned r; asm volatile("v_cvt_pk_bf16_f32 %0, %1, %2" : "=v"(r) : "v"(lo), "v"(hi)); return r; }
__device__ __forceinline__ float rstd_ss16(const float* ss, int row) {
    const f32x4* p = (const f32x4*)(ss + (size_t)row * 16);
    const f32x4 a = p[0], b = p[1], c = p[2], d = p[3];
    const float s = (((a[0] + a[1]) + (a[2] + a[3])) + ((b[0] + b[1]) + (b[2] + b[3]))) + (((c[0] + c[1]) + (c[2] + c[3])) + ((d[0] + d[1]) + (d[2] + d[3])));
    return __builtin_amdgcn_rsqf(s * (1.0f / 1024.0f) + 1e-6f);
}
template <bool SS16> struct EpiSwiGLU {
    static constexpr bool PERM = true, AFTER_DRAIN = false;
    bf16_t* H; int ldh; const float* rs;
    __device__ __forceinline__ void operator()(const f32x4 (&acc)[2][2][4][2], const Unit& u, int wr, int wc, int fr, int fq) const {
        const int row0 = u.pm * BM + wr * 64 + fr; const int col0 = u.pn * HALF + wc * 32 + 8 * fq;
#pragma unroll
        for (int ai = 0; ai < 2; ++ai)
#pragma unroll
            for (int m = 0; m < 4; ++m) {
                const int row = row0 + ai * HALF + m * 16;
                const float r = SS16 ? rstd_ss16(rs, row) : rs[row];
                float hv[8];
#pragma unroll
                for (int n = 0; n < 2; ++n)
#pragma unroll
                    for (int i = 0; i < 4; ++i) { const float g = acc[ai][0][m][n][i] * r, uu = acc[ai][1][m][n][i] * r;
                        const float e = __builtin_amdgcn_exp2f(-1.4426950408889634f * g); hv[n * 4 + i] = g * __builtin_amdgcn_rcpf(1.0f + e) * uu; }
                u32x4 w; w.x = cvt_pk_bf16(hv[0], hv[1]); w.y = cvt_pk_bf16(hv[2], hv[3]); w.z = cvt_pk_bf16(hv[4], hv[5]); w.w = cvt_pk_bf16(hv[6], hv[7]);
                *(u32x4*)(H + (size_t)row * ldh + col0) = w;
            }
    }
};
template <bool WRITE_BF, bool HALF_ALPHA> struct EpiResid {
    static constexpr bool PERM = true, AFTER_DRAIN = false;
    const float* base; float* out; bf16_t* xb; float* ss;
    __device__ __forceinline__ void operator()(const f32x4 (&acc)[2][2][4][2], const Unit& u, int wr, int wc, int fr, int fq) const {
        const int row0 = u.pm * BM + wr * 64 + fr; const int col0 = u.pn * BM + wc * 32 + 8 * fq; const float alpha = HALF_ALPHA ? 0.5f : 1.0f;
#pragma unroll
        for (int ai = 0; ai < 2; ++ai)
#pragma unroll
            for (int m = 0; m < 4; ++m) {
                const int row = row0 + ai * HALF + m * 16; const size_t off = (size_t)row * 1024 + col0; float sq = 0.f;
#pragma unroll
                for (int bj = 0; bj < 2; ++bj) {
                    const f32x4 b0 = *(const f32x4*)(base + off + bj * HALF), b1 = *(const f32x4*)(base + off + bj * HALF + 4);
                    const f32x4 v0 = b0 + acc[ai][bj][m][0] * alpha, v1 = b1 + acc[ai][bj][m][1] * alpha;
                    *(f32x4*)(out + off + bj * HALF) = v0; *(f32x4*)(out + off + bj * HALF + 4) = v1;
                    if (WRITE_BF) {
                        u32x4 w; w.x = cvt_pk_bf16(v0[0], v0[1]); w.y = cvt_pk_bf16(v0[2], v0[3]); w.z = cvt_pk_bf16(v1[0], v1[1]); w.w = cvt_pk_bf16(v1[2], v1[3]);
                        *(u32x4*)(xb + off + bj * HALF) = w;
                        sq += (v0[0] * v0[0] + v0[1] * v0[1]) + (v0[2] * v0[2] + v0[3] * v0[3]) + (v1[0] * v1[0] + v1[1] * v1[1]) + (v1[2] * v1[2] + v1[3] * v1[3]);
                    }
                }
                if (WRITE_BF) { sq += __shfl_xor(sq, 16); sq += __shfl_xor(sq, 32); if (fq == 0) ss[(size_t)row * 16 + u.pn * 4 + wc] = sq; }
            }
    }
};
struct EpiProj {
    static constexpr bool PERM = true, AFTER_DRAIN = false;
    bf16_t* O; int ldo; const float* ss;
    __device__ __forceinline__ void operator()(const f32x4 (&acc)[2][2][4][2], const Unit& u, int wr, int wc, int fr, int fq) const {
        const int row0 = u.pm * BM + wr * 64 + fr; const int col0 = u.pn * BM + wc * 32 + 8 * fq;
#pragma unroll
        for (int ai = 0; ai < 2; ++ai)
#pragma unroll
            for (int m = 0; m < 4; ++m) {
                const int row = row0 + ai * HALF + m * 16; const float r = rstd_ss16(ss, row);
#pragma unroll
                for (int bj = 0; bj < 2; ++bj) { const f32x4 v0 = acc[ai][bj][m][0] * r, v1 = acc[ai][bj][m][1] * r;
                    u32x4 w; w.x = cvt_pk_bf16(v0[0], v0[1]); w.y = cvt_pk_bf16(v0[2], v0[3]); w.z = cvt_pk_bf16(v1[0], v1[1]); w.w = cvt_pk_bf16(v1[2], v1[3]);
                    *(u32x4*)(O + (size_t)row * ldo + col0 + bj * HALF) = w; }
            }
    }
};

template <class Epi, class Sched, bool ALIGN_EPI = false, bool SP2 = false>
__device__ __forceinline__ void gemm_phase(PG8_LAS unsigned char* lds, const Gemm g, const Sched& S, const Epi& E) {
    const int tid = threadIdx.x, wid = __builtin_amdgcn_readfirstlane(tid >> 6), lane = tid & 63, wr = wid >> 2, wc = wid & 3, fr = lane & 15, fq = lane >> 4;
    const int K = g.K, nt = K / BK;
    unsigned voffA[2], voffB[2];
#pragma unroll
    for (int i = 0; i < 2; ++i) { int R, C; stage_rc(tid * 16 + i * 8192, R, C); const int Rb = Epi::PERM ? ((R & ~31) + perm32(R & 31)) : R;
        voffA[i] = (unsigned)(R * K + C) * 2u; voffB[i] = (unsigned)(Rb * K + C) * 2u; }
    const size_t kstep = (size_t)(BK * 2);
    const size_t hstep = (size_t)HALF * K * 2;
    const size_t tstep = 2 * hstep;
    const unsigned ldsw = (unsigned)wid * 1024u;
    const int aoff = lds_byte(wr * 64 + fr, fq * 8), boff = lds_byte(wc * 32 + fr, fq * 8);
#define PG8_SA(b, h) (((b) * 2 + (h)) * HTB)
#define PG8_SB(b, h) ((4 + (b) * 2 + (h)) * HTB)
#define PG8_STAGE(bufoff, gbase, voff) do { _Pragma("unroll") for (int _i = 0; _i < 2; ++_i) \
        __builtin_amdgcn_global_load_lds((const unsigned*)((const char*)(gbase) + (voff)[_i]), (PG8_LAS unsigned*)(lds + (bufoff) + ldsw + _i * 8192), 16, 0, 0); } while (0)
#define PG8_LDA(dst, b, h) do { _Pragma("unroll") for (int m = 0; m < 4; ++m) _Pragma("unroll") for (int k = 0; k < 2; ++k) dst[m][k] = *(const PG8_LAS bf16x8*)(lds + PG8_SA(b, h) + aoff + m * 2048 + k * 1024); } while (0)
#define PG8_LDB(dst, b, h) do { _Pragma("unroll") for (int n = 0; n < 2; ++n) _Pragma("unroll") for (int k = 0; k < 2; ++k) dst[n][k] = *(const PG8_LAS bf16x8*)(lds + PG8_SB(b, h) + boff + n * 2048 + k * 1024); } while (0)
#define PG8_MMA(ai, bj, At, Bt) do { __builtin_amdgcn_s_setprio(1); _Pragma("unroll") for (int m = 0; m < 4; ++m) _Pragma("unroll") for (int n = 0; n < 2; ++n) _Pragma("unroll") for (int k = 0; k < 2; ++k) \
        acc[ai][bj][m][n] = __builtin_amdgcn_mfma_f32_16x16x32_bf16(Bt[n][k], At[m][k], acc[ai][bj][m][n], 0, 0, 0); __builtin_amdgcn_s_setprio(0); } while (0)
#define PG8_WAIT_V(n) asm volatile("s_waitcnt vmcnt(" #n ")" ::: "memory")
#define PG8_WAIT_L(n) asm volatile("s_waitcnt lgkmcnt(" #n ")" ::: "memory")
#define PG8_BAR __builtin_amdgcn_s_barrier()
#define PG8_SCHED __builtin_amdgcn_sched_barrier(0)
    Unit cur, nxt; int ui = 0;
    if (!S.next(0, cur)) return;
    f32x4 acc[2][2][4][2];
#pragma unroll
    for (int a = 0; a < 2; ++a)
#pragma unroll
        for (int b = 0; b < 2; ++b)
#pragma unroll
            for (int m = 0; m < 4; ++m)
#pragma unroll
                for (int n = 0; n < 2; ++n) acc[a][b][m][n] = (f32x4){0.f, 0.f, 0.f, 0.f};
    bf16x8 At[4][2], B0[2][2], B1[2][2];
    const char* cA = (const char*)g.A + (size_t)cur.pm * tstep; const char* cB = (const char*)g.Bt + (size_t)cur.pn * tstep;
    S.a_ready(cur);
    if constexpr (SP2) {
        PG8_STAGE(PG8_SB(0, 0), cB, voffB); PG8_STAGE(PG8_SB(0, 1), cB + hstep, voffB); PG8_STAGE(PG8_SA(0, 0), cA, voffA); PG8_STAGE(PG8_SA(0, 1), cA + hstep, voffA);
        if (wr == 1) PG8_BAR;
        PG8_WAIT_V(2); PG8_BAR;
        PG8_STAGE(PG8_SB(1, 0), cB + kstep, voffB); PG8_STAGE(PG8_SA(1, 0), cA + kstep, voffA); PG8_STAGE(PG8_SB(1, 1), cB + hstep + kstep, voffB);
        PG8_WAIT_V(6); PG8_BAR;
    } else {
        PG8_STAGE(PG8_SB(0, 0), cB, voffB); PG8_STAGE(PG8_SA(0, 0), cA, voffA); PG8_STAGE(PG8_SB(0, 1), cB + hstep, voffB); PG8_STAGE(PG8_SA(0, 1), cA + hstep, voffA);
        if (wr == 1) PG8_BAR;
        PG8_WAIT_V(4); PG8_BAR;
        PG8_STAGE(PG8_SB(1, 0), cB + kstep, voffB); PG8_STAGE(PG8_SA(1, 0), cA + kstep, voffA); PG8_STAGE(PG8_SB(1, 1), cB + hstep + kstep, voffB);
        PG8_WAIT_V(6); PG8_BAR;
    }
    for (;;) {
        const bool has_next = S.next(ui + 1, nxt);
        const char* nA = has_next ? (const char*)g.A + (size_t)nxt.pm * tstep : cA; const char* nB = has_next ? (const char*)g.Bt + (size_t)nxt.pn * tstep : cB;
        for (int t = 0; t < nt; t += 2) {
            const bool last = (t == nt - 2);
            const char* a1 = cA + (size_t)(t + 1) * kstep;
            const char* a2 = last ? nA : cA + (size_t)(t + 2) * kstep; const char* b2 = last ? nB : cB + (size_t)(t + 2) * kstep;
            const char* a3 = a2 + kstep; const char* b3 = b2 + kstep;
            if (last && has_next) S.a_ready(nxt);
            if constexpr (SP2) {
            PG8_LDB(B0, 0, 0); PG8_LDB(B1, 0, 1); PG8_SCHED; PG8_LDA(At, 0, 0); PG8_STAGE(PG8_SA(1, 1), a1 + hstep, voffA);
            PG8_WAIT_V(8); PG8_WAIT_L(0); PG8_BAR; PG8_MMA(0, 0, At, B0); PG8_MMA(0, 1, At, B1); PG8_BAR; PG8_SCHED;
            PG8_LDA(At, 0, 1); PG8_STAGE(PG8_SB(0, 0), b2, voffB); PG8_STAGE(PG8_SB(0, 1), b2 + hstep, voffB); PG8_STAGE(PG8_SA(0, 0), a2, voffA);
            PG8_WAIT_V(8); PG8_WAIT_L(0); PG8_BAR; PG8_MMA(1, 0, At, B0); PG8_MMA(1, 1, At, B1); PG8_BAR; PG8_SCHED;
            PG8_LDB(B0, 1, 0); PG8_LDB(B1, 1, 1); PG8_SCHED; PG8_LDA(At, 1, 0); PG8_STAGE(PG8_SA(0, 1), a2 + hstep, voffA);
            PG8_WAIT_V(8); PG8_WAIT_L(0); PG8_BAR; PG8_MMA(0, 0, At, B0); PG8_MMA(0, 1, At, B1); PG8_BAR; PG8_SCHED;
            PG8_LDA(At, 1, 1); PG8_STAGE(PG8_SB(1, 0), b3, voffB); PG8_STAGE(PG8_SB(1, 1), b3 + hstep, voffB); PG8_STAGE(PG8_SA(1, 0), a3, voffA);
            PG8_WAIT_V(8); PG8_WAIT_L(0); PG8_BAR; PG8_MMA(1, 0, At, B0); PG8_MMA(1, 1, At, B1); PG8_BAR; PG8_SCHED;
            } else {
            PG8_LDB(B0, 0, 0); PG8_SCHED; PG8_LDA(At, 0, 0); PG8_STAGE(PG8_SA(1, 1), a1 + hstep, voffA);
            PG8_WAIT_L(8); PG8_BAR; PG8_WAIT_L(0); PG8_MMA(0, 0, At, B0); PG8_BAR; PG8_SCHED;
            PG8_LDB(B1, 0, 1); PG8_STAGE(PG8_SB(0, 0), b2, voffB);
            PG8_BAR; PG8_WAIT_L(0); PG8_MMA(0, 1, At, B1); PG8_BAR;
            PG8_LDA(At, 0, 1); PG8_STAGE(PG8_SA(0, 0), a2, voffA);
            PG8_BAR; PG8_WAIT_L(0); PG8_MMA(1, 0, At, B0); PG8_BAR; PG8_SCHED;
            PG8_STAGE(PG8_SB(0, 1), b2 + hstep, voffB);
            PG8_WAIT_V(6); PG8_BAR; PG8_MMA(1, 1, At, B1); PG8_BAR;
            PG8_LDB(B0, 1, 0); PG8_SCHED; PG8_LDA(At, 1, 0); PG8_STAGE(PG8_SA(0, 1), a2 + hstep, voffA);
            PG8_WAIT_L(8); PG8_BAR; PG8_WAIT_L(0); PG8_MMA(0, 0, At, B0); PG8_BAR; PG8_SCHED;
            PG8_LDB(B1, 1, 1); PG8_STAGE(PG8_SB(1, 0), b3, voffB);
            PG8_BAR; PG8_WAIT_L(0); PG8_MMA(0, 1, At, B1); PG8_BAR;
            PG8_LDA(At, 1, 1); PG8_STAGE(PG8_SA(1, 0), a3, voffA);
            PG8_BAR; PG8_WAIT_L(0); PG8_MMA(1, 0, At, B0); PG8_BAR; PG8_SCHED;
            PG8_STAGE(PG8_SB(1, 1), b3 + hstep, voffB);
            PG8_WAIT_V(6); PG8_BAR; PG8_MMA(1, 1, At, B1); PG8_BAR;
            }
        }
        if constexpr (ALIGN_EPI) { if (wr == 0) PG8_BAR; }
        if constexpr (!Epi::AFTER_DRAIN) { E(acc, cur, wr, wc, fr, fq); S.done(cur); }
        if (!has_next) break;
#pragma unroll
        for (int a = 0; a < 2; ++a)
#pragma unroll
            for (int b = 0; b < 2; ++b)
#pragma unroll
                for (int m = 0; m < 4; ++m)
#pragma unroll
                    for (int n = 0; n < 2; ++n) acc[a][b][m][n] = (f32x4){0.f, 0.f, 0.f, 0.f};
        cur = nxt; cA = nA; cB = nB; ++ui;
        if constexpr (ALIGN_EPI) { if (wr == 1) PG8_BAR; }
    }
    PG8_WAIT_V(0);
    if constexpr (!ALIGN_EPI) { if (wr == 0) PG8_BAR; }
    PG8_BAR;
    if constexpr (Epi::AFTER_DRAIN) { E.fused(acc, cur, wr, wc, fr, fq, lds, wid, lane); S.done(cur); }
#undef PG8_SA
#undef PG8_SB
#undef PG8_STAGE
#undef PG8_LDA
#undef PG8_LDB
#undef PG8_MMA
#undef PG8_WAIT_V
#undef PG8_WAIT_L
#undef PG8_BAR
#undef PG8_SCHED
}
}
#define GAS __attribute__((address_space(1)))
#define LAS __attribute__((address_space(3)))
typedef unsigned short bf16;
typedef unsigned v4u __attribute__((ext_vector_type(4)));
typedef float f32x4 __attribute__((ext_vector_type(4)));
typedef short bf16x8 __attribute__((ext_vector_type(8)));
typedef GAS unsigned gu32;
typedef GAS unsigned long long gu64;
#define RLX_AGENT __ATOMIC_RELAXED, __HIP_MEMORY_SCOPE_AGENT
#define LDS_WAIT() asm volatile("s_waitcnt lgkmcnt(0)" ::: "memory")
#define VM_WAIT() asm volatile("s_waitcnt vmcnt(0)" ::: "memory")
__device__ __forceinline__ unsigned long long rt() { return __builtin_amdgcn_s_memrealtime(); }
__device__ __forceinline__ unsigned f2bf(float f) { unsigned u = __builtin_bit_cast(unsigned, f); return (u + 0x7fffu + ((u >> 16) & 1u)) >> 16; }
__device__ __forceinline__ unsigned pk2(float lo, float hi) { return f2bf(lo) | (f2bf(hi) << 16); }

#define XB_TMO      128
#define XB_XCNT(j)  (256  + 64 * (j))
#define XB_XSUB(j)  (1280 + 64 * (j))
#define XB_XGEN(j)  (2304 + 64 * (j))
#define XB_TOP      3328
#define XB_TOPGEN   3392
#define XCD_BAR_WORDS 3456
#define XB_SPIN_CAP (1u << 18)

__device__ __forceinline__ unsigned xb_ld(unsigned* p)              { return __hip_atomic_load(p, __ATOMIC_RELAXED, __HIP_MEMORY_SCOPE_AGENT); }
__device__ __forceinline__ unsigned xb_add(unsigned* p, unsigned v) { return __hip_atomic_fetch_add(p, v, __ATOMIC_RELAXED, __HIP_MEMORY_SCOPE_AGENT); }
__device__ __forceinline__ unsigned xb_xcc_id() { return (unsigned)__builtin_amdgcn_s_getreg((3 << 11) | 20) & 0xFu; }
#define XB_SPIN(cond, bar) do { unsigned _sp = 0; while (cond) { __builtin_amdgcn_s_sleep(1); \
    if ((++_sp & 255u) == 0u) { if (xb_ld(&(bar)[XB_TMO])) break; if (_sp > XB_SPIN_CAP) { atomicAdd(&(bar)[XB_TMO], 1u); break; } } } } while (0)

struct XcdBarrier {
    unsigned* bar; unsigned x;
    volatile LAS unsigned* st;
};

__device__ __forceinline__ XcdBarrier xcd_barrier_post(unsigned* bar, volatile LAS unsigned* st) {
    XcdBarrier b; b.bar = bar; b.x = xb_xcc_id(); b.st = st;
    if (threadIdx.x == 0) (void)xb_add(&bar[XB_XCNT(b.x)], 1u);
    return b;
}
__device__ __forceinline__ void xcd_barrier_complete(unsigned* bar, unsigned x, unsigned& nloc, unsigned& nx) {
    const unsigned G = gridDim.x * gridDim.y * gridDim.z;
    unsigned sum, cnt, mine, sp = 0u;
    for (;;) {
        sum = 0u; cnt = 0u; mine = 0u;
#pragma unroll
        for (unsigned j = 0; j < 16; ++j) { const unsigned c = xb_ld(&bar[XB_XCNT(j)]); sum += c; cnt += (c > 0u) ? 1u : 0u; mine = (j == x) ? c : mine; }
        if (sum == G) break;
        __builtin_amdgcn_s_sleep(1);
        if ((++sp & 255u) == 0u) { if (xb_ld(&bar[XB_TMO])) break; if (sp > XB_SPIN_CAP) { atomicAdd(&bar[XB_TMO], 1u); break; } }
    }
    nloc = mine > 0u ? mine : 1u; nx = cnt > 0u ? cnt : 1u;
}

__device__ __forceinline__ void xcd_barrier(const XcdBarrier& b) {
    asm volatile("s_waitcnt vmcnt(0)" ::: "memory");
    __syncthreads();
    if (threadIdx.x == 0) {
        unsigned* bar = b.bar;
        __builtin_amdgcn_s_waitcnt(0);
        unsigned nloc = b.st[0], nx = b.st[1];
        if (nloc == 0u) { xcd_barrier_complete(bar, b.x, nloc, nx); b.st[0] = nloc; b.st[1] = nx; }
        const unsigned old = xb_add(&bar[XB_XSUB(b.x)], 1u);
        const unsigned gen = old / nloc;
        if (old + 1u == (gen + 1u) * nloc) {
            __builtin_amdgcn_fence(__ATOMIC_RELEASE, "agent");
            asm volatile("s_waitcnt vmcnt(0)" ::: "memory");
            const unsigned og = xb_add(&bar[XB_TOP], 1u);
            const unsigned tg = og / nx;
            if (og + 1u == (tg + 1u) * nx) xb_add(&bar[XB_TOPGEN], 1u);
            else XB_SPIN(xb_ld(&bar[XB_TOPGEN]) == tg, bar);
            __builtin_amdgcn_fence(__ATOMIC_ACQUIRE, "agent");
            xb_add(&bar[XB_XGEN(b.x)], 1u);
            asm volatile("s_waitcnt vmcnt(0)" ::: "memory");
        } else {
            XB_SPIN(xb_ld(&bar[XB_XGEN(b.x)]) == gen, bar);
            __builtin_amdgcn_fence(__ATOMIC_ACQUIRE, "agent");
            asm volatile("s_waitcnt vmcnt(0)" ::: "memory");
        }
    }
    __syncthreads();
}

#ifndef PG8_SP2
#define PG8_SP2 true
#endif
#ifndef PG8_ALIGN
#define PG8_ALIGN true
#endif
#ifndef MK_PER_PHASE
#define MK_PER_PHASE 0
#endif

constexpr int NWAVES = 8;
constexpr int BATCH = 32, SEQ = 2048, D = 1024, M = BATCH * SEQ;
constexpr int FF = 2816, INW = 3584;
constexpr int RH = 4, RD = 128, AH = 8, AD = 64, NBLK = 8, BLK = 256;
constexpr int PC_RQ = 0, PC_RK = 512, PC_RV = 1024, PC_RG = 1536, PC_AQ = 2048, PC_AK = 2560, PC_AV = 3072;
constexpr float EPS = 1e-6f;
constexpr float C2 = 0.125f * 1.4426950408889634f;
constexpr int N_PHASES = 10;

constexpr size_t MiB = 1u << 20;
constexpr size_t WS_CTL = 0, CTL_ZERO_BYTES = 1 * MiB;
constexpr size_t WS_W1A = 2 * MiB, WS_WD1 = 14 * MiB, WS_WIN = 20 * MiB, WS_WOUT = 27 * MiB, WS_W2A = 29 * MiB, WS_WD2 = 40 * MiB;
constexpr size_t WS_ROPE_R = 46 * MiB, WS_ROPE_A = 47 * MiB, WS_KMEAN = 47 * MiB + 512 * 1024, WS_RS0 = 48 * MiB, WS_SS1 = 49 * MiB, WS_SS2 = 53 * MiB;
constexpr size_t WS_XB = 64 * MiB, WS_MIX = 192 * MiB, WS_BIG = 320 * MiB, WS_END = 768 * MiB;
static_assert(WS_W1A + (size_t)2 * FF * D * 2 <= WS_WD1 && WS_WD1 + (size_t)D * FF * 2 <= WS_WIN && WS_WIN + (size_t)INW * D * 2 <= WS_WOUT && WS_WOUT + (size_t)D * D * 2 <= WS_W2A &&
              WS_W2A + (size_t)2 * FF * D * 2 <= WS_WD2 && WS_WD2 + (size_t)D * FF * 2 <= WS_ROPE_R && WS_ROPE_R + (size_t)SEQ * 64 * 8 <= WS_ROPE_A && WS_ROPE_A + (size_t)SEQ * 8 * 8 <= WS_KMEAN &&
              WS_KMEAN + (size_t)BATCH * AH * NBLK * AD * 4 <= WS_RS0 && WS_RS0 + (size_t)M * 4 <= WS_SS1 && WS_SS1 + (size_t)M * 64 <= WS_SS2 && WS_SS2 + (size_t)M * 64 <= WS_XB &&
              WS_XB + (size_t)M * D * 2 <= WS_MIX && WS_MIX + (size_t)M * D * 2 <= WS_BIG && WS_BIG + (size_t)M * INW * 2 <= WS_END, "d_ws map");
constexpr int CW_TMO = 0, CW_CODE = 1;
constexpr int CW_BAR = 4096;

constexpr int RING_OFF = 0, RING_BYTES = 131072;
constexpr int LDSCTL_OFF = RING_BYTES, MISC_OFF = LDSCTL_OFF + 320;
constexpr int LDS_BYTES = 147456;
static_assert(MISC_OFF + 128 <= LDS_BYTES, "LDS map");


typedef float f32x2 __attribute__((ext_vector_type(2)));
struct Frame {
    LAS unsigned char* lds;
    volatile LAS unsigned* MISC;
    gu32* ctl;
    int tid, lane, wave;
    int vcu, G;
    const float* x; float* out;
    bf16 *W1A, *WD1, *WIN, *WOUT, *W2A, *WD2;
    bf16 *XB, *MIXB, *HB, *PROJ;
    f32x2 *ROPE_R, *ROPE_A;
    float *KMEAN, *RS0, *SS1, *SS2;
};
__device__ __forceinline__ float bf_lo(unsigned u) { return __uint_as_float(u << 16); }
__device__ __forceinline__ float bf_hi(unsigned u) { return __uint_as_float(u & 0xffff0000u); }
__device__ __forceinline__ void unpack8(const v4u r, float (&x)[8]) { x[0] = bf_lo(r.x); x[1] = bf_hi(r.x); x[2] = bf_lo(r.y); x[3] = bf_hi(r.y); x[4] = bf_lo(r.z); x[5] = bf_hi(r.z); x[6] = bf_lo(r.w); x[7] = bf_hi(r.w); }
__device__ __forceinline__ v4u pack8(const float (&y)[8]) { v4u o; o.x = pk2(y[0], y[1]); o.y = pk2(y[2], y[3]); o.z = pk2(y[4], y[5]); o.w = pk2(y[6], y[7]); return o; }
__device__ __forceinline__ float wave_sum(float v) {
#pragma unroll
    for (int o = 1; o < 64; o <<= 1) v += __shfl_xor(v, o);
    return v;
}
__device__ __forceinline__ float silu_f(float g) { return g * __builtin_amdgcn_rcpf(1.0f + __builtin_amdgcn_exp2f(-1.4426950408889634f * g)); }

__device__ __forceinline__ void p0_transpose_item(const float* W, int K, int N, bf16* WT, int k0, int n0, int dst_row0, const float* kscale, LAS float* scr, int lane) {
#pragma unroll 8
    for (int i = 0; i < 32; ++i) { const int kk = 2 * i + (lane >> 5); const float sc = kscale ? kscale[k0 + kk] : 1.0f; scr[kk * 33 + (lane & 31)] = W[(size_t)(k0 + kk) * N + n0 + (lane & 31)] * sc; }
    LDS_WAIT(); asm volatile("" ::: "memory");
    const int c = lane & 7;
#pragma unroll
    for (int j = 0; j < 4; ++j) { const int n = (lane >> 3) + 8 * j; const LAS float* s = scr + (8 * c) * 33 + n;
        v4u o; o.x = pk2(s[0 * 33], s[1 * 33]); o.y = pk2(s[2 * 33], s[3 * 33]); o.z = pk2(s[4 * 33], s[5 * 33]); o.w = pk2(s[6 * 33], s[7 * 33]);
        *(GAS v4u*)(WT + (size_t)(dst_row0 + n) * K + k0 + 8 * c) = o; }
    LDS_WAIT(); asm volatile("" ::: "memory");
}
__device__ __forceinline__ void x_row_to_bf16(Frame& F, const float* xrow, bf16* orow, float* rs) {
    const GAS f32x4* xr = (const GAS f32x4*)xrow + F.lane;
    f32x4 v[4]; float s = 0.f;
#pragma unroll
    for (int j = 0; j < 4; ++j) { v[j] = xr[64 * j]; s += (v[j].x * v[j].x + v[j].y * v[j].y) + (v[j].z * v[j].z + v[j].w * v[j].w); }
    const float tot = wave_sum(s);
    if (F.lane == 0) *rs = 1.0f / sqrtf(tot * (1.f / D) + EPS);
    GAS unsigned long long* o8 = (GAS unsigned long long*)orow + F.lane;
#pragma unroll
    for (int j = 0; j < 4; ++j) o8[64 * j] = (unsigned long long)pk2(v[j].x, v[j].y) | ((unsigned long long)pk2(v[j].z, v[j].w) << 32);
}
struct Args { const float* in[16]; float* out; unsigned char* ws; float invf_r[64]; float invf_a[8]; int ph_lo, ph_hi, li, pad; };
__device__ __forceinline__ void p0_prologue(Frame& F, const Args& args) {
    LAS float* scr = (LAS float*)(F.lds + RING_OFF + F.wave * 16384);
    const int gw = F.vcu * NWAVES + F.wave, NGW = F.G * NWAVES;
    constexpr int I_GU = (D / 64) * (FF / 32), I_DN = (FF / 64) * (D / 32), I_IN = (D / 64) * (INW / 32), I_OUT = (D / 64) * (D / 32);
    constexpr int NITEMS = 2 * (2 * I_GU + I_DN) + I_IN + I_OUT;
    for (int it = gw; it < NITEMS; it += NGW) {
        int r = it;
#pragma unroll
        for (int f = 0; f < 2; ++f) {
            const float* nw = args.in[f == 0 ? 1 : 12]; const float* wg = args.in[f == 0 ? 2 : 13]; const float* wu = args.in[f == 0 ? 3 : 14]; const float* wd = args.in[f == 0 ? 4 : 15];
            bf16* WA = f == 0 ? F.W1A : F.W2A; bf16* WD = f == 0 ? F.WD1 : F.WD2;
            if (r >= 0 && r < I_GU) { const int nblk = FF / 32, kb = r / nblk, nb = r % nblk, n0 = 32 * nb; p0_transpose_item(wg, D, FF, WA, 64 * kb, n0, 256 * (n0 / 128) + (n0 % 128), nw, scr, F.lane); r = -1; } else if (r >= 0) r -= I_GU;
            if (r >= 0 && r < I_GU) { const int nblk = FF / 32, kb = r / nblk, nb = r % nblk, n0 = 32 * nb; p0_transpose_item(wu, D, FF, WA, 64 * kb, n0, 256 * (n0 / 128) + 128 + (n0 % 128), nw, scr, F.lane); r = -1; } else if (r >= 0) r -= I_GU;
            if (r >= 0 && r < I_DN) { const int nblk = D / 32, kb = r / nblk, nb = r % nblk, n0 = 32 * nb; p0_transpose_item(wd, FF, D, WD, 64 * kb, n0, n0, nullptr, scr, F.lane); r = -1; } else if (r >= 0) r -= I_DN;
        }
        if (r >= 0 && r < I_IN) { const int nblk = INW / 32, kb = r / nblk, nb = r % nblk, n0 = 32 * nb; p0_transpose_item(args.in[6], D, INW, F.WIN, 64 * kb, n0, n0, args.in[5], scr, F.lane); r = -1; } else if (r >= 0) r -= I_IN;
        if (r >= 0 && r < I_OUT) { const int nblk = D / 32, kb = r / nblk, nb = r % nblk, n0 = 32 * nb; p0_transpose_item(args.in[11], D, D, F.WOUT, 64 * kb, n0, n0, nullptr, scr, F.lane); r = -1; }
    }
    for (int m = gw; m < M; m += NGW) x_row_to_bf16(F, F.x + (size_t)m * D, F.XB + (size_t)m * D, F.RS0 + m);
    const int gt = F.vcu * (NWAVES * 64) + F.tid, NGT = F.G * NWAVES * 64;
    for (int idx = gt; idx < SEQ * 72; idx += NGT) {
        const int pos = idx / 72, i = idx % 72;
        float invf = 0.f;
#pragma unroll
        for (int k = 0; k < 64; ++k) invf = (i == k) ? args.invf_r[k] : invf;
#pragma unroll
        for (int k = 0; k < 8; ++k) invf = (i == 64 + k) ? args.invf_a[k] : invf;
        const float ang = (float)pos * invf;
        double rv = (double)ang * 0.15915494309189535; rv -= floor(rv);
        const float a = (float)(rv * 6.283185307179586);
        f32x2 cs; cs.x = cosf(a); cs.y = sinf(a);
        if (i < 64) F.ROPE_R[pos * 64 + i] = cs; else F.ROPE_A[pos * 8 + (i - 64)] = cs;
    }
}

__device__ __forceinline__ void prep_unit(Frame& F, const float* qnw, const float* knw, int b, int n) {
    const int lane = F.lane, w = F.wave;
    bf16* P = F.PROJ + (size_t)(b * SEQ + n * BLK) * INW;
    LAS float* part = (LAS float*)(F.lds + RING_OFF);
    {
        const int c = lane & 7, ts = lane >> 3;
        float wq[8], wk[8];
#pragma unroll
        for (int j = 0; j < 8; ++j) { wq[j] = qnw[c * 8 + j]; wk[j] = knw[c * 8 + j]; }
        for (int hs = 0; hs < 16; ++hs) {
            const bool isk = hs >= 8; const int h = hs & 7;
            const int col = (isk ? PC_AK : PC_AQ) + h * AD + c * 8;
            float ksum[8];
#pragma unroll
            for (int j = 0; j < 8; ++j) ksum[j] = 0.f;
            for (int ti = 0; ti < 4; ++ti) {
                const int tok = ti * 64 + w * 8 + ts;
                GAS v4u* p = (GAS v4u*)(P + (size_t)tok * INW + col);
                float xv[8]; unpack8(*p, xv);
                float sq = 0.f;
#pragma unroll
                for (int j = 0; j < 8; ++j) sq += xv[j] * xv[j];
                sq += __shfl_xor(sq, 1); sq += __shfl_xor(sq, 2); sq += __shfl_xor(sq, 4);
                const float r = 1.0f / sqrtf(sq * (1.0f / AD) + EPS);
                float y[8], yp[8];
#pragma unroll
                for (int j = 0; j < 8; ++j) y[j] = xv[j] * r * (isk ? wk[j] : wq[j]);
#pragma unroll
                for (int j = 0; j < 8; ++j) yp[j] = __shfl_xor(y[j], 1);
                if (c < 2) {
                    const f32x2* cs = F.ROPE_A + (size_t)(n * BLK + tok) * 8;
#pragma unroll
                    for (int j = 0; j < 8; ++j) { const f32x2 t = cs[j]; y[j] = (c == 0) ? (y[j] * t.x - yp[j] * t.y) : (y[j] * t.x + yp[j] * t.y); }
                }
                if (isk) {
#pragma unroll
                    for (int j = 0; j < 8; ++j) ksum[j] += y[j];
                } else {
#pragma unroll
                    for (int j = 0; j < 8; ++j) y[j] *= C2;
                }
                *p = pack8(y);
            }
            if (isk) {
#pragma unroll
                for (int j = 0; j < 8; ++j) { float v = ksum[j]; v += __shfl_xor(v, 8); v += __shfl_xor(v, 16); v += __shfl_xor(v, 32); ksum[j] = v; }
                if (ts == 0) {
#pragma unroll
                    for (int j = 0; j < 8; ++j) part[(w * 8 + h) * 64 + c * 8 + j] = ksum[j];
                }
            }
        }
    }
    __syncthreads();
    {   const int h = F.tid >> 6, d = F.tid & 63; float s = 0.f;
#pragma unroll
        for (int ww = 0; ww < 8; ++ww) s += part[(ww * 8 + h) * 64 + d];
        F.KMEAN[(size_t)((b * AH + h) * NBLK + n) * AD + d] = s * (1.0f / BLK);
    }
    __syncthreads();
    {
        const int c = lane & 15, ts = lane >> 4;
        for (int hs = 0; hs < 8; ++hs) {
            const bool isk = hs >= 4; const int h = hs & 3;
            const int col = (isk ? PC_RK : PC_RQ) + h * RD + c * 8;
            const float sc = isk ? 0.08838834764831845f : 1.0f;
            for (int ti = 0; ti < 8; ++ti) {
                const int tok = ti * 32 + w * 4 + ts;
                GAS v4u* p = (GAS v4u*)(P + (size_t)tok * INW + col);
                float xv[8], xp[8], y[8]; unpack8(*p, xv);
#pragma unroll
                for (int j = 0; j < 8; ++j) xp[j] = __shfl_xor(xv[j], 8);
                const f32x2* cs = F.ROPE_R + (size_t)(n * BLK + tok) * 64 + (c & 7) * 8;
#pragma unroll
                for (int j = 0; j < 8; ++j) { const f32x2 t = cs[j]; y[j] = ((c < 8) ? (xv[j] * t.x - xp[j] * t.y) : (xv[j] * t.x + xp[j] * t.y)) * sc; }
                *p = pack8(y);
            }
        }
    }
}

__device__ __forceinline__ void ret_unit_naive(Frame& F, const float* beta, int b, int h) {
    LAS float* qs = (LAS float*)(F.lds + RING_OFF);
    LAS float* ks = qs + 16 * 128;
    LAS float* vs = ks + 16 * 128;
    LAS float* part = vs + 16 * 128;
    const int t = F.tid, e = t & 127, dq = t >> 7, d0 = dq * 32;
    const float gamma = 1.0f - exp2f(-5.0f - (float)h);
    float st[32];
#pragma unroll
    for (int i = 0; i < 32; ++i) st[i] = 0.f;
    const size_t rowbase = (size_t)b * SEQ;
    for (int tb = 0; tb < SEQ / 16; ++tb) {
        const int s0 = tb * 16;
        for (int p = t; p < 768; p += 512) {
            const int tok = p / 48, rem = p % 48, which = rem >> 4, c = rem & 15;
            const GAS v4u* src = (const GAS v4u*)(F.PROJ + (rowbase + s0 + tok) * INW + which * 512 + h * RD + c * 8);
            float xv[8]; unpack8(*src, xv);
            LAS float* dst = qs + which * (16 * 128) + tok * 128 + c * 8;
#pragma unroll
            for (int j = 0; j < 8; ++j) dst[j] = xv[j];
        }
        __syncthreads();
        for (int tok = 0; tok < 16; ++tok) {
            const float vv = vs[tok * 128 + e]; float acc = 0.f;
#pragma unroll
            for (int i = 0; i < 32; ++i) { st[i] = gamma * st[i] + ks[tok * 128 + d0 + i] * vv; acc += qs[tok * 128 + d0 + i] * st[i]; }
            part[(tok * 4 + dq) * 128 + e] = acc;
        }
        __syncthreads();
        {   const int tok = t >> 5, e4 = (t & 31) * 4; float o[4]; float sq = 0.f;
#pragma unroll
            for (int j = 0; j < 4; ++j) { o[j] = (part[(tok * 4 + 0) * 128 + e4 + j] + part[(tok * 4 + 1) * 128 + e4 + j]) + (part[(tok * 4 + 2) * 128 + e4 + j] + part[(tok * 4 + 3) * 128 + e4 + j]); sq += o[j] * o[j]; }
            sq += __shfl_xor(sq, 1); sq += __shfl_xor(sq, 2); sq += __shfl_xor(sq, 4); sq += __shfl_xor(sq, 8); sq += __shfl_xor(sq, 16);
            const float r = 1.0f / sqrtf(sq * (1.0f / RD) + EPS);
            const size_t row = rowbase + s0 + tok;
            const unsigned long long graw = *(const GAS unsigned long long*)(F.PROJ + row * INW + PC_RG + h * RD + e4);
            const unsigned g0 = (unsigned)graw, g1 = (unsigned)(graw >> 32);
            const float gv[4] = {bf_lo(g0), bf_hi(g0), bf_lo(g1), bf_hi(g1)};
            float y[4];
#pragma unroll
            for (int j = 0; j < 4; ++j) y[j] = o[j] * r * silu_f(gv[j]) * beta[h * RD + e4 + j];
            *(GAS unsigned long long*)(F.MIXB + row * D + h * RD + e4) = (unsigned long long)pk2(y[0], y[1]) | ((unsigned long long)pk2(y[2], y[3]) << 32);
        }
    }
    __syncthreads();
}

__device__ __forceinline__ void attn_unit_naive(Frame& F, const float* beta, int b, int h, int jj) {
    const int t = F.tid, s = jj * 512 + t, j = s >> 8;
    const size_t rowbase = (size_t)b * SEQ; const size_t row = rowbase + s;
    float q[64];
    {   const GAS v4u* qp = (const GAS v4u*)(F.PROJ + row * INW + PC_AQ + h * AD);
#pragma unroll
        for (int c = 0; c < 8; ++c) { float xv[8]; unpack8(qp[c], xv);
#pragma unroll
            for (int i = 0; i < 8; ++i) q[c * 8 + i] = xv[i]; }
    }
    float g[7];
#pragma unroll
    for (int n = 0; n < 7; ++n) {
        g[n] = -INFINITY;
        if (n < j) { const float* km = F.KMEAN + (size_t)((b * AH + h) * NBLK + n) * AD; float a = 0.f;
#pragma unroll
            for (int d = 0; d < 64; ++d) a += q[d] * km[d];
            g[n] = a; }
    }
    unsigned sel = 0;
#pragma unroll
    for (int n = 0; n < 7; ++n) {
        int rank = 0;
#pragma unroll
        for (int m = 0; m < 7; ++m) if (m != n) rank += ((g[m] > g[n]) || (g[m] == g[n] && m < n)) ? 1 : 0;
        if (n < j && rank < 3) sel |= 1u << n;
    }
    float mrun = -INFINITY, l = 0.f, o[64];
#pragma unroll
    for (int d = 0; d < 64; ++d) o[d] = 0.f;
    const int wave_last = (s | 63) & 255;
    for (int pass = 0; pass <= j; ++pass) {
        const int n = pass == 0 ? j : pass - 1;
        const bool blk_ok = pass == 0 ? true : (((sel >> n) & 1u) != 0u);
        if (!__any(blk_ok)) continue;
        const int kend = pass == 0 ? ((wave_last + 4) & ~3) : BLK;
        for (int kc = 0; kc < kend; kc += 4) {
            float sc[4]; float cmax = -INFINITY;
#pragma unroll
            for (int i = 0; i < 4; ++i) {
                const int key = n * BLK + kc + i;
                const GAS v4u* kp = (const GAS v4u*)(F.PROJ + (rowbase + key) * INW + PC_AK + h * AD);
                float a = 0.f;
#pragma unroll
                for (int c = 0; c < 8; ++c) { float xv[8]; unpack8(kp[c], xv);
#pragma unroll
                    for (int d = 0; d < 8; ++d) a += q[c * 8 + d] * xv[d]; }
                const bool ok = blk_ok && (pass != 0 || key <= s);
                sc[i] = ok ? a : -INFINITY; cmax = fmaxf(cmax, sc[i]);
                asm volatile("" ::: "memory");
            }
            const float mnew = fmaxf(mrun, cmax);
            if (mnew > -INFINITY) {
                const float alpha = __builtin_amdgcn_exp2f(mrun - mnew);
                l *= alpha;
#pragma unroll
                for (int d = 0; d < 64; ++d) o[d] *= alpha;
#pragma unroll
                for (int i = 0; i < 4; ++i) {
                    const int key = n * BLK + kc + i;
                    const float p = __builtin_amdgcn_exp2f(sc[i] - mnew); l += p;
                    const GAS v4u* vp = (const GAS v4u*)(F.PROJ + (rowbase + key) * INW + PC_AV + h * AD);
#pragma unroll
                    for (int c = 0; c < 8; ++c) { float xv[8]; unpack8(vp[c], xv);
#pragma unroll
                        for (int d = 0; d < 8; ++d) o[c * 8 + d] += p * xv[d]; }
                    asm volatile("" ::: "memory");
                }
                mrun = mnew;
            }
        }
    }
    const float il = 1.0f / l; float sq = 0.f;
#pragma unroll
    for (int d = 0; d < 64; ++d) { o[d] *= il; sq += o[d] * o[d]; }
    const float r = 1.0f / sqrtf(sq * (1.0f / AD) + EPS);
    GAS v4u* op = (GAS v4u*)(F.MIXB + row * D + 512 + h * AD);
#pragma unroll
    for (int c = 0; c < 8; ++c) { float y[8];
#pragma unroll
        for (int i = 0; i < 8; ++i) y[i] = o[c * 8 + i] * r * beta[512 * 0 + h * AD + c * 8 + i];
        op[c] = pack8(y); }
}

__global__ void __launch_bounds__(NWAVES * 64, 2) mk_fwd(Args args) {
    __shared__ __attribute__((aligned(16))) unsigned char lds[LDS_BYTES];
    Frame F;
    F.lds = (LAS unsigned char*)lds;
    F.MISC = (volatile LAS unsigned*)(F.lds + MISC_OFF);
    F.tid = threadIdx.x; F.lane = F.tid & 63; F.wave = __builtin_amdgcn_readfirstlane(F.tid >> 6);
    F.G = gridDim.x; { const int bx = blockIdx.x; F.vcu = (F.G % 8 == 0) ? (bx % 8) * (F.G / 8) + bx / 8 : bx; }
    unsigned char* ws = args.ws;
    F.ctl = (gu32*)(ws + WS_CTL);
    F.x = args.in[0]; F.out = args.out;
    F.W1A = (bf16*)(ws + WS_W1A); F.WD1 = (bf16*)(ws + WS_WD1); F.WIN = (bf16*)(ws + WS_WIN); F.WOUT = (bf16*)(ws + WS_WOUT); F.W2A = (bf16*)(ws + WS_W2A); F.WD2 = (bf16*)(ws + WS_WD2);
    F.XB = (bf16*)(ws + WS_XB); F.MIXB = (bf16*)(ws + WS_MIX); F.HB = (bf16*)(ws + WS_BIG); F.PROJ = (bf16*)(ws + WS_BIG);
    F.ROPE_R = (f32x2*)(ws + WS_ROPE_R); F.ROPE_A = (f32x2*)(ws + WS_ROPE_A);
    F.KMEAN = (float*)(ws + WS_KMEAN); F.RS0 = (float*)(ws + WS_RS0); F.SS1 = (float*)(ws + WS_SS1); F.SS2 = (float*)(ws + WS_SS2);
    for (int u = F.tid; u < (LDS_BYTES - LDSCTL_OFF) / 4; u += NWAVES * 64) ((LAS unsigned*)(F.lds + LDSCTL_OFF))[u] = 0u;
    __syncthreads();
    XcdBarrier bar; bar.bar = (unsigned*)(F.ctl + CW_BAR); bar.x = 0; bar.st = nullptr;
    if (!MK_PER_PHASE) bar = xcd_barrier_post((unsigned*)(F.ctl + CW_BAR), F.MISC + 8);
#define GRID_BAR() do { if (!MK_PER_PHASE) xcd_barrier(bar); } while (0)
    const int lo = args.ph_lo, hi = args.ph_hi;
#define IN(k) (lo <= (k) && (k) < hi)
#define BOTH(k) (IN(k) && IN((k) + 1))

    if (IN(0)) { p0_prologue(F, args); if (BOTH(0)) GRID_BAR(); }

    if (IN(1)) {
        pg8::Gemm g{F.XB, F.W1A, M, 2 * FF, D}; pg8::StaticOrder S; S.init(M, 2 * FF, F.G, (int)blockIdx.x);
        pg8::EpiSwiGLU<false> E{F.HB, FF, F.RS0};
        pg8::gemm_phase<pg8::EpiSwiGLU<false>, pg8::StaticOrder, PG8_ALIGN, PG8_SP2>(F.lds + RING_OFF, g, S, E);
        if (BOTH(1)) GRID_BAR();
    }
    if (IN(2)) {
        pg8::Gemm g{F.HB, F.WD1, M, D, FF}; pg8::StaticOrder S; S.init(M, D, F.G, (int)blockIdx.x);
        pg8::EpiResid<true, true> E{F.x, F.out, F.XB, F.SS1};
        pg8::gemm_phase<pg8::EpiResid<true, true>, pg8::StaticOrder, PG8_ALIGN, PG8_SP2>(F.lds + RING_OFF, g, S, E);
        if (BOTH(2)) GRID_BAR();
    }
    if (IN(3)) {
        pg8::Gemm g{F.XB, F.WIN, M, INW, D}; pg8::StaticOrder S; S.init(M, INW, F.G, (int)blockIdx.x);
        pg8::EpiProj E{F.PROJ, INW, F.SS1};
        pg8::gemm_phase<pg8::EpiProj, pg8::StaticOrder, PG8_ALIGN, PG8_SP2>(F.lds + RING_OFF, g, S, E);
        if (BOTH(3)) GRID_BAR();
    }
    if (IN(4)) {
        for (int u = F.vcu; u < BATCH * NBLK; u += F.G) prep_unit(F, args.in[8], args.in[9], u / NBLK, u % NBLK);
        if (BOTH(4)) GRID_BAR();
    }
    if (IN(5)) {
        for (int u = F.vcu; u < BATCH * RH; u += F.G) ret_unit_naive(F, args.in[7], u / RH, u % RH);
    }
    if (IN(6)) {
        for (int u = F.vcu; u < BATCH * AH * 4; u += F.G) { const int bh = u >> 2; attn_unit_naive(F, args.in[10], bh / AH, bh % AH, u & 3); }
        if (BOTH(6)) GRID_BAR();
    }
    if (IN(7)) {
        pg8::Gemm g{F.MIXB, F.WOUT, M, D, D}; pg8::StaticOrder S; S.init(M, D, F.G, (int)blockIdx.x);
        pg8::EpiResid<true, false> E{F.out, F.out, F.XB, F.SS2};
        pg8::gemm_phase<pg8::EpiResid<true, false>, pg8::StaticOrder, PG8_ALIGN, PG8_SP2>(F.lds + RING_OFF, g, S, E);
        if (BOTH(7)) GRID_BAR();
    }
    if (IN(8)) {
        pg8::Gemm g{F.XB, F.W2A, M, 2 * FF, D}; pg8::StaticOrder S; S.init(M, 2 * FF, F.G, (int)blockIdx.x);
        pg8::EpiSwiGLU<true> E{F.HB, FF, F.SS2};
        pg8::gemm_phase<pg8::EpiSwiGLU<true>, pg8::StaticOrder, PG8_ALIGN, PG8_SP2>(F.lds + RING_OFF, g, S, E);
        if (BOTH(8)) GRID_BAR();
    }
    if (IN(9)) {
        pg8::Gemm g{F.HB, F.WD2, M, D, FF}; pg8::StaticOrder S; S.init(M, D, F.G, (int)blockIdx.x);
        pg8::EpiResid<false, true> E{F.out, F.out, nullptr, nullptr};
        pg8::gemm_phase<pg8::EpiResid<false, true>, pg8::StaticOrder, PG8_ALIGN, PG8_SP2>(F.lds + RING_OFF, g, S, E);
    }
#undef IN
#undef BOTH
#undef GRID_BAR
}

extern "C" void kernel_launch(void* const* d_in, const int* in_sizes, int n_in, void* d_out, int out_size, void* d_ws, size_t ws_size, hipStream_t stream) {
    static int grid = 0;
    if (grid == 0) {
        if (n_in != 16 || in_sizes[0] != M * D || out_size != M * D || ws_size < WS_END) { fprintf(stderr, "kernel_launch: unexpected shapes (n_in %d, in0 %d, out %d, ws %zu); nothing launched\n", n_in, n_in > 0 ? in_sizes[0] : -1, out_size, ws_size); grid = -1; return; }
        int dev = 0, cus = 0, per_cu = 0;
        if (hipGetDevice(&dev) != hipSuccess || hipDeviceGetAttribute(&cus, hipDeviceAttributeMultiprocessorCount, dev) != hipSuccess) { fprintf(stderr, "kernel_launch: device query failed\n"); grid = -1; return; }
        if (hipOccupancyMaxActiveBlocksPerMultiprocessor(&per_cu, (const void*)mk_fwd, NWAVES * 64, 0) != hipSuccess || per_cu < 1)
            fprintf(stderr, "kernel_launch: note: occupancy query reports %d workgroups per CU\n", per_cu);
        (void)hipGetLastError();
        grid = cus;
    }
    if (grid < 0) return;
    if (hipMemsetAsync((char*)d_ws + WS_CTL, 0, CTL_ZERO_BYTES, stream) != hipSuccess) { fprintf(stderr, "kernel_launch: memset failed\n"); return; }
    Args a{};
    for (int i = 0; i < 16; ++i) a.in[i] = (const float*)d_in[i];
    a.out = (float*)d_out; a.ws = (unsigned char*)d_ws;
    for (int i = 0; i < 64; ++i) a.invf_r[i] = (float)std::pow(10000.0, -(double)i * 2.0 / 128.0);
    for (int i = 0; i < 8; ++i) a.invf_a[i] = (float)std::pow(500000.0, -(double)i * 2.0 / 16.0);
#if MK_PER_PHASE
    for (int p = 0; p < N_PHASES; ++p) { a.ph_lo = p; a.ph_hi = p + 1; a.li = p; hipLaunchKernelGGL(mk_fwd, dim3(grid), dim3(NWAVES * 64), 0, stream, a); }
#else
    a.ph_lo = 0; a.ph_hi = N_PHASES; a.li = 0;
    hipLaunchKernelGGL(mk_fwd, dim3(grid), dim3(NWAVES * 64), 0, stream, a);
#endif
    const hipError_t le = hipPeekAtLastError();
    if (le != hipSuccess) fprintf(stderr, "kernel_launch: launch failed: %s\n", hipGetErrorName(le));
}
```

```cpp
#include <hip/hip_runtime.h>
#include <cstdio>
#include <cstdint>
#include <cmath>
#ifndef MK_NT_P0
#define MK_NT_P0 0
#endif
#ifndef MK_NT_MIX
#define MK_NT_MIX 0
#endif
#if MK_NT_P0
#define P0_LDNT(p) __builtin_nontemporal_load(p)
#define P0_STNT(v, p) __builtin_nontemporal_store((v), (p))
#else
#define P0_LDNT(p) (*(p))
#define P0_STNT(v, p) (*(p) = (v))
#endif
#if MK_NT_MIX
#define MIX_STNT(v, p) __builtin_nontemporal_store((v), (p))
#else
#define MIX_STNT(v, p) (*(p) = (v))
#endif
__device__ __forceinline__ int mk_lane() { int l; asm volatile("v_mbcnt_lo_u32_b32 %0, -1, 0\n\tv_mbcnt_hi_u32_b32 %0, -1, %0" : "=v"(l)); return l; }
#ifndef MK_FP8_WOUT
#define MK_FP8_WOUT 0
#endif
namespace pg8 {
#define PG8_LAS __attribute__((address_space(3)))
typedef unsigned short bf16_t;
typedef short bf16x8 __attribute__((ext_vector_type(8)));
typedef float f32x4 __attribute__((ext_vector_type(4)));
typedef unsigned u32x4 __attribute__((ext_vector_type(4)));
constexpr int BM = 256, BK = 64, HALF = 128, HTB = HALF * BK * 2  , STAGE_BYTES = 8 * HTB, NXCD = 8, WGM = 8;

__host__ __device__ __forceinline__ int lds_byte(int r, int c) { const int st = (r >> 4) * 2 + (c >> 5), rr = r & 15, cc = c & 31, ob = rr * 64 + cc * 2; return st * 1024 + (ob ^ (((ob >> 9) & 1) << 5)); }
__host__ __device__ __forceinline__ void stage_rc(int b, int& R, int& C) { const int st = b / 1024, sb = b % 1024, swz = sb ^ (((sb >> 9) & 1) << 5); R = (st >> 1) * 16 + swz / 64; C = (st & 1) * 32 + (swz % 64) / 2; }
__host__ __device__ __forceinline__ unsigned a8_block_off(int wc, int R, int pz) { return (unsigned)(wc * 8192 + R * 32 + pz * 16); }
__host__ __device__ __forceinline__ int perm32(int rho) { const int n = rho >> 4, i = rho & 15; return 8 * (i >> 2) + 4 * n + (i & 3); }

struct Unit { int pm, pn; };
struct Gemm { const bf16_t* A; const bf16_t* Bt; int M, N, K; };

struct StaticOrder {
    int nM, nN, nwg, G, c;
    __host__ __device__ void init(int M, int N, int G_, int c_) { nM = M / BM; nN = N / BM; nwg = nM * nN; G = G_; c = c_; }
    __host__ __device__ bool next(int i, Unit& u) const {
        const long L = (long)i * G + c; if (L >= nwg) return false;
        int wgid = (int)L; { const int q = nwg / NXCD, r = nwg % NXCD, xcd = wgid % NXCD, off = wgid / NXCD; wgid = (xcd < r ? xcd * (q + 1) : r * (q + 1) + (xcd - r) * q) + off; }
        const int nig = WGM * nN, gid = wgid / nig, fm = gid * WGM, gsz = (nM - fm) < WGM ? (nM - fm) : WGM;
        u.pm = fm + ((wgid % nig) % gsz); u.pn = (wgid % nig) / gsz; return true;
    }
    __device__ __forceinline__ void a_ready(const Unit&) const {}
    __device__ __forceinline__ void done(const Unit&) const {}
};

__device__ __forceinline__ unsigned cvt_pk_bf16(float lo, float hi) { unsigned r; asm volatile("v_cvt_pk_bf16_f32 %0, %1, %2" : "=v"(r) : "v"(lo), "v"(hi)); return r; }
typedef int i32x8 __attribute__((ext_vector_type(8)));
typedef unsigned u32x2 __attribute__((ext_vector_type(2)));
__device__ __forceinline__ i32x8 cat8(const bf16x8 a, const bf16x8 b) { typedef int i32x4_ __attribute__((ext_vector_type(4))); const i32x4_ x = __builtin_bit_cast(i32x4_, a), y = __builtin_bit_cast(i32x4_, b); return (i32x8){x[0], x[1], x[2], x[3], y[0], y[1], y[2], y[3]}; }
__device__ __forceinline__ unsigned pk4_fp8(float a, float b, float c, float d) {
    a = __builtin_amdgcn_fmed3f(a, -448.f, 448.f); b = __builtin_amdgcn_fmed3f(b, -448.f, 448.f); c = __builtin_amdgcn_fmed3f(c, -448.f, 448.f); d = __builtin_amdgcn_fmed3f(d, -448.f, 448.f);
    int w = 0; w = __builtin_amdgcn_cvt_pk_fp8_f32(a, b, w, false); w = __builtin_amdgcn_cvt_pk_fp8_f32(c, d, w, true); return (unsigned)w; }
constexpr float W8_SCALE = 64.0f, H8_SCALE = 8.0f;
constexpr int SS_M = 65536;
__device__ __forceinline__ float rstd_ss16(const float* ss, int row) {
    float s = 0.f;
#pragma unroll
    for (int k = 0; k < 16; ++k) s += ss[(size_t)k * SS_M + row];
    return __builtin_amdgcn_rsqf(s * (1.0f / 1024.0f) + 1e-6f);
}
#define PG8_GAS __attribute__((address_space(1)))
#ifndef MK_NT
#define MK_NT 1
#endif
#ifndef MK_NT_BASE
#define MK_NT_BASE 0
#endif
#if MK_NT_BASE
#define PG8_LDNT_BASE(p) __builtin_nontemporal_load(p)
#else
#define PG8_LDNT_BASE(p) (*(p))
#endif
#ifndef MK_NT_X8
#define MK_NT_X8 1
#endif
#if MK_NT && MK_NT_X8
#define PG8_ST8(p, v) __builtin_nontemporal_store((v), (p))
#else
#define PG8_ST8(p, v) (*(p) = (v))
#endif
#if MK_NT
#define PG8_ST(p, v) __builtin_nontemporal_store((v), (p))
#else
#define PG8_ST(p, v) (*(p) = (v))
#endif
template <typename T> __device__ __forceinline__ PG8_GAS T* gas_at(const void* base, unsigned byte_off) { return (PG8_GAS T*)((PG8_GAS char*)base + byte_off); }
__device__ __forceinline__ void rstd8_ss16(const float* ss, int row0, int fq, float (&rr)[8]) {
    float q[8][4];
#pragma unroll
    for (int g = 0; g < 8; ++g)
#pragma unroll
        for (int j = 0; j < 4; ++j) q[g][j] = *gas_at<const float>(ss, ((unsigned)(4 * fq + j) * (unsigned)SS_M + (unsigned)(row0 + (g >> 2) * HALF + (g & 3) * 16)) * 4u);
    asm volatile("" ::: "memory");
#pragma unroll
    for (int g = 0; g < 8; ++g) { float s = (q[g][0] + q[g][1]) + (q[g][2] + q[g][3]); s += __shfl_xor(s, 16); s += __shfl_xor(s, 32); rr[g] = __builtin_amdgcn_rsqf(s * (1.0f / 1024.0f) + 1e-6f); }
}
constexpr int RTAB_SLOTS = 4;
struct RTab { const PG8_LAS float* tab; int pm0; };
template <bool SS16, class Sched> __device__ __forceinline__ RTab fill_rstd_table(PG8_LAS float* tab, const Sched& S, const float* src  , int tid) {
    Unit u; if (!S.next(0, u)) return RTab{nullptr, 0};
    const int pm0 = u.pm; int pml = pm0;
    for (int i = 1; S.next(i, u); ++i) pml = u.pm;
    const int ns = ((pml - pm0) >> 3) + 1;
    if (ns > RTAB_SLOTS || ((pml - pm0) & 7)) return RTab{nullptr, 0};
    const int r = tid >> 1, h = tid & 1;
    if (SS16) {
        float q[RTAB_SLOTS][8];
#pragma unroll
        for (int k = 0; k < RTAB_SLOTS; ++k) { const int pm = k < ns ? pm0 + 8 * k : pm0;
#pragma unroll
            for (int j = 0; j < 8; ++j) q[k][j] = *gas_at<const float>(src, ((unsigned)(h * 8 + j) * (unsigned)SS_M + (unsigned)(pm * BM + r)) * 4u); }
#pragma unroll
        for (int k = 0; k < RTAB_SLOTS; ++k) { float s = ((q[k][0] + q[k][1]) + (q[k][2] + q[k][3])) + ((q[k][4] + q[k][5]) + (q[k][6] + q[k][7])); s += __shfl_xor(s, 1);
            if (h == 0) tab[k * BM + r] = __builtin_amdgcn_rsqf(s * (1.0f / 1024.0f) + 1e-6f); }
    } else {
#pragma unroll
        for (int k = 0; k < RTAB_SLOTS / 2; ++k) { const int kk = 2 * k + h; const int pm = kk < ns ? pm0 + 8 * kk : pm0; tab[kk * BM + r] = *gas_at<const float>(src, (unsigned)(pm * BM + r) * 4u); }
    }
    __syncthreads();
    return RTab{tab, pm0};
}
__device__ __forceinline__ void rstd8_tab(const RTab& t, const Unit& u, int wr, int fr, float (&rr)[8]) {
    const PG8_LAS float* p = t.tab + ((u.pm - t.pm0) >> 3) * BM + wr * 64 + fr;
#pragma unroll
    for (int g = 0; g < 8; ++g) rr[g] = p[(g >> 2) * HALF + (g & 3) * 16];
}
__device__ __forceinline__ u32x4 pair_rows_f8(const u32x2 a, const u32x2 b, const int lane) {
    const int i0 = (((lane & 1) * 32 + ((lane >> 1) & 15)) * 4), i1 = i0 + 64; const bool hi = lane >= 32;
    const int ax0 = __builtin_amdgcn_ds_bpermute(i0, (int)a.x), ay0 = __builtin_amdgcn_ds_bpermute(i0, (int)a.y), ax1 = __builtin_amdgcn_ds_bpermute(i1, (int)a.x), ay1 = __builtin_amdgcn_ds_bpermute(i1, (int)a.y);
    const int bx0 = __builtin_amdgcn_ds_bpermute(i0, (int)b.x), by0 = __builtin_amdgcn_ds_bpermute(i0, (int)b.y), bx1 = __builtin_amdgcn_ds_bpermute(i1, (int)b.x), by1 = __builtin_amdgcn_ds_bpermute(i1, (int)b.y);
    u32x4 r; r.x = (unsigned)(hi ? bx0 : ax0); r.y = (unsigned)(hi ? by0 : ay0); r.z = (unsigned)(hi ? bx1 : ax1); r.w = (unsigned)(hi ? by1 : ay1); return r;
}
__device__ __forceinline__ u32x4 rows_linear_b16(const u32x4 w, const int lane) {
    const int src = ((lane & 3) * 16 + (lane >> 2)) * 4; u32x4 r;
    r.x = (unsigned)__builtin_amdgcn_ds_bpermute(src, (int)w.x); r.y = (unsigned)__builtin_amdgcn_ds_bpermute(src, (int)w.y); r.z = (unsigned)__builtin_amdgcn_ds_bpermute(src, (int)w.z); r.w = (unsigned)__builtin_amdgcn_ds_bpermute(src, (int)w.w); return r;
}
template <bool SS16, bool F8 = false, bool BLK = false, bool OUT8 = F8> struct EpiSwiGLU {
    static constexpr bool PERM = true, AFTER_DRAIN = false, BADJ = false; static constexpr int NSTORE = OUT8 ? 4 : 8;
    bf16_t* H; int ldh; const float* rs; RTab rt;
    __device__ __forceinline__ void operator()(const f32x4 (&acc)[2][2][4][2], const Unit& u, int wr, int wc, int fr, int fq) const {
        const int row0 = u.pm * BM + wr * 64 + fr; const int col0 = u.pn * HALF + wc * 32 + 8 * fq;
        float rr[8];
        if (rt.tab) rstd8_tab(rt, u, wr, fr, rr);
        else if (SS16) rstd8_ss16(rs, row0, fq, rr);
        else {
#pragma unroll
            for (int g = 0; g < 8; ++g) rr[g] = *gas_at<const float>(rs, (unsigned)(row0 + (g >> 2) * HALF + (g & 3) * 16) * 4u);
            asm volatile("" ::: "memory"); }
        u32x2 w8e = {0u, 0u};
#pragma unroll
        for (int ai = 0; ai < 2; ++ai)
#pragma unroll
            for (int m = 0; m < 4; ++m) {
                const int row = row0 + ai * HALF + m * 16;
                const float r = rr[ai * 4 + m] * (F8 ? 1.0f / W8_SCALE : 1.0f);
                const float t = -1.4426950408889634f * r, ir2 = __builtin_amdgcn_rcpf(r * r * (OUT8 ? H8_SCALE : 1.0f));
                f32x4 hq[2];
#pragma unroll
                for (int n = 0; n < 2; ++n) { const f32x4 gv = acc[ai][0][m][n], uv = acc[ai][1][m][n];
                    f32x4 e = gv * t; e[0] = __builtin_amdgcn_exp2f(e[0]); e[1] = __builtin_amdgcn_exp2f(e[1]); e[2] = __builtin_amdgcn_exp2f(e[2]); e[3] = __builtin_amdgcn_exp2f(e[3]);
                    f32x4 d = e * ir2 + ir2; d[0] = __builtin_amdgcn_rcpf(d[0]); d[1] = __builtin_amdgcn_rcpf(d[1]); d[2] = __builtin_amdgcn_rcpf(d[2]); d[3] = __builtin_amdgcn_rcpf(d[3]);
                    hq[n] = (gv * uv) * d; }
                if (OUT8) { u32x2 w8; w8.x = pk4_fp8(hq[0][0], hq[0][1], hq[0][2], hq[0][3]); w8.y = pk4_fp8(hq[1][0], hq[1][1], hq[1][2], hq[1][3]);
                    if ((m & 1) == 0) w8e = w8;
                    else { const int l_ = fq * 16 + fr; const u32x4 w16 = pair_rows_f8(w8e, w8, l_);
                        const int R = ai * HALF + wr * 64 + (m - 1 + (l_ >> 5)) * 16 + ((l_ >> 1) & 15);
                        if (BLK) PG8_ST(gas_at<u32x4>(H, (unsigned)(u.pm * (ldh >> 7) + u.pn) * 32768u + a8_block_off(wc, R, l_ & 1)), w16);
                        else *gas_at<u32x4>(H, (unsigned)(u.pm * BM + R) * (unsigned)ldh + (unsigned)(u.pn * HALF + wc * 32 + (l_ & 1) * 16)) = w16; } }
                else {
                u32x4 w; w.x = cvt_pk_bf16(hq[0][0], hq[0][1]); w.y = cvt_pk_bf16(hq[0][2], hq[0][3]); w.z = cvt_pk_bf16(hq[1][0], hq[1][1]); w.w = cvt_pk_bf16(hq[1][2], hq[1][3]);
                if (BLK) { const int l_ = fq * 16 + fr; const u32x4 wl = rows_linear_b16(w, l_);
                    PG8_ST(gas_at<u32x4>(H, (unsigned)(u.pm * (ldh >> 7) + u.pn) * 65536u + (unsigned)(wc * 16384 + (ai * HALF + wr * 64 + m * 16 + (l_ >> 2)) * 64 + (l_ & 3) * 16)), wl); }
                else *gas_at<u32x4>(H, ((unsigned)row * (unsigned)ldh + (unsigned)col0) * 2u) = w; }
            }
    }
};
template <bool BASE_BF, bool OUT_F32, bool OUT_BF, int ALPHA_MODE, bool OUT_F8 = false, bool F8BLK = true> struct EpiResid {
    static constexpr bool PERM = true, AFTER_DRAIN = false, BADJ = true; static constexpr int NSTORE = (OUT_F32 ? 32 : 0) + (OUT_BF ? 18 : 0) + (OUT_F8 ? 8 : 0);
    const float* basef; const bf16_t* baseb; float* outf; bf16_t* xb; float* ss; unsigned char* x8; PG8_LAS unsigned char* tb;
    __device__ __forceinline__ void operator()(const f32x4 (&acc)[2][2][4][2], const Unit& u, int wr, int wc, int fr, int fq) const {
        const int row0 = u.pm * BM + wr * 64 + fr; const int col0 = u.pn * BM + wc * 64 + 8 * fq; const float alpha = ALPHA_MODE == 0 ? 1.0f : (ALPHA_MODE == 1 ? 0.5f : (ALPHA_MODE == 2 ? 0.5f / (W8_SCALE * H8_SCALE) : 1.0f / W8_SCALE));
        const int l_ = fq * 16 + fr;
        u32x4 bb[2][4][2];
        if (BASE_BF) {
#pragma unroll
            for (int ai = 0; ai < 2; ++ai)
#pragma unroll
                for (int m = 0; m < 4; ++m)
#pragma unroll
                    for (int bj = 0; bj < 2; ++bj) bb[ai][m][bj] = PG8_LDNT_BASE(gas_at<const u32x4>(baseb, ((unsigned)(row0 + ai * HALF + m * 16) * 1024u + (unsigned)(col0 + bj * 32)) * 2u));
            asm volatile("" ::: "memory");
        }
#define PG8_TBROW(b, r) (tb + (r) * 144)
        auto emit = [&](const int ps) {
#pragma unroll
            for (int k = 0; k < 2; ++k) { const int r = (l_ >> 3) + 8 * k; const u32x4 o = *(const PG8_LAS u32x4*)(PG8_TBROW(ps, r) + (l_ & 7) * 16);
                if (OUT_F32) { const int pai = ps >> 3, pmm = (ps >> 1) & 3, pbj = ps & 1;
                    PG8_ST(gas_at<u32x4>(outf, ((unsigned)(u.pm * BM + pai * HALF + wr * 64 + pmm * 16 + r) * 1024u + (unsigned)(u.pn * BM + wc * 64 + pbj * 32)) * 4u + (unsigned)(l_ & 7) * 16u), o); }
                else { const int pai = ps >> 2, pmm = ps & 3;
                    PG8_ST(gas_at<u32x4>(xb, ((unsigned)(u.pm * BM + pai * HALF + wr * 64 + pmm * 16 + r) * 1024u + (unsigned)(u.pn * BM + wc * 64)) * 2u + (unsigned)(l_ & 7) * 16u), o); } }
        };
        u32x2 w8e[2] = {{0u, 0u}, {0u, 0u}}; float sqv[4] = {0.f, 0.f, 0.f, 0.f};
#pragma unroll
        for (int ai = 0; ai < 2; ++ai)
#pragma unroll
            for (int m = 0; m < 4; ++m) {
                const int row = row0 + ai * HALF + m * 16; const unsigned off = (unsigned)row * 1024u + (unsigned)col0; float sq = 0.f;
#pragma unroll
                for (int bj = 0; bj < 2; ++bj) {
                    f32x4 b0, b1;
                    if (BASE_BF) { const u32x4 r = bb[ai][m][bj];
                        b0 = (f32x4){__uint_as_float(r.x << 16), __uint_as_float(r.x & 0xffff0000u), __uint_as_float(r.y << 16), __uint_as_float(r.y & 0xffff0000u)};
                        b1 = (f32x4){__uint_as_float(r.z << 16), __uint_as_float(r.z & 0xffff0000u), __uint_as_float(r.w << 16), __uint_as_float(r.w & 0xffff0000u)}; }
                    else { b0 = *(const f32x4*)(basef + off + bj * 32); b1 = *(const f32x4*)(basef + off + bj * 32 + 4); }
                    const f32x4 v0 = b0 + acc[ai][bj][m][0] * alpha, v1 = b1 + acc[ai][bj][m][1] * alpha;
                    if (OUT_F32) {
                        const int st = ai * 8 + m * 2 + bj; PG8_LAS unsigned char* p = PG8_TBROW(st, fr) + fq * 32;
                        *(PG8_LAS f32x4*)p = v0; *(PG8_LAS f32x4*)(p + 16) = v1;
                        emit(st);
                    }
                    if (OUT_BF) {
                        u32x4 w; w.x = cvt_pk_bf16(v0[0], v0[1]); w.y = cvt_pk_bf16(v0[2], v0[3]); w.z = cvt_pk_bf16(v1[0], v1[1]); w.w = cvt_pk_bf16(v1[2], v1[3]);
                        *(PG8_LAS u32x4*)(PG8_TBROW(ai * 4 + m, fr) + bj * 64 + fq * 16) = w;
                        sq += (v0[0] * v0[0] + v0[1] * v0[1]) + (v0[2] * v0[2] + v0[3] * v0[3]) + (v1[0] * v1[0] + v1[1] * v1[1]) + (v1[2] * v1[2] + v1[3] * v1[3]);
                    }
                    if (OUT_F8) { u32x2 w8; w8.x = pk4_fp8(v0[0], v0[1], v0[2], v0[3]); w8.y = pk4_fp8(v1[0], v1[1], v1[2], v1[3]);
                        if ((m & 1) == 0) w8e[bj] = w8;
                        else { const u32x4 w16 = pair_rows_f8(w8e[bj], w8, l_);
                            const int R = ai * HALF + wr * 64 + (m - 1 + (l_ >> 5)) * 16 + ((l_ >> 1) & 15);
                            if (F8BLK) PG8_ST8(gas_at<u32x4>(x8, (unsigned)(u.pm * 8 + u.pn * 2 + (wc >> 1)) * 32768u + a8_block_off(2 * (wc & 1) + bj, R, l_ & 1)), w16);
                            else *gas_at<u32x4>(x8, (unsigned)(u.pm * BM + R) * 1024u + (unsigned)(u.pn * BM + wc * 64 + bj * 32 + (l_ & 1) * 16)) = w16; } }
                }
                if (OUT_BF) { emit(ai * 4 + m);
                    sq += __shfl_xor(sq, 16); sq += __shfl_xor(sq, 32); sqv[m] = sq;
                    if (m == 3) { const float v = fq == 0 ? sqv[0] : (fq == 1 ? sqv[1] : (fq == 2 ? sqv[2] : sqv[3]));
                        *gas_at<float>(ss, ((unsigned)(u.pn * 4 + wc) * (unsigned)SS_M + (unsigned)(u.pm * BM + ai * HALF + wr * 64 + l_)) * 4u) = v; } }
            }
#undef PG8_TBROW
    }
};
template <int ALPHA_MODE> struct EpiOutF32 {
    static constexpr bool PERM = false, AFTER_DRAIN = false, BADJ = false; static constexpr int NSTORE = 32;
    const bf16_t* baseb; float* outf;
    __device__ __forceinline__ void operator()(const f32x4 (&acc)[2][2][4][2], const Unit& u, int wr, int wc, int fr, int fq) const {
        const int row0 = u.pm * BM + wr * 64 + fr; const int col0 = u.pn * BM + wc * 32 + 4 * fq; const float alpha = ALPHA_MODE == 1 ? 0.5f : 0.5f / (W8_SCALE * H8_SCALE);
        u32x2 bb[2][4][2][2];
#pragma unroll
        for (int ai = 0; ai < 2; ++ai)
#pragma unroll
            for (int m = 0; m < 4; ++m)
#pragma unroll
                for (int bj = 0; bj < 2; ++bj)
#pragma unroll
                    for (int n = 0; n < 2; ++n) bb[ai][m][bj][n] = *gas_at<const u32x2>(baseb, ((unsigned)(row0 + ai * HALF + m * 16) * 1024u + (unsigned)(col0 + bj * HALF + 16 * n)) * 2u);
        asm volatile("" ::: "memory");
#pragma unroll
        for (int ai = 0; ai < 2; ++ai)
#pragma unroll
            for (int m = 0; m < 4; ++m) {
                const unsigned off = (unsigned)(row0 + ai * HALF + m * 16) * 1024u + (unsigned)col0;
#pragma unroll
                for (int bj = 0; bj < 2; ++bj)
#pragma unroll
                    for (int n = 0; n < 2; ++n) { const u32x2 r = bb[ai][m][bj][n];
                        const f32x4 b = {__uint_as_float(r.x << 16), __uint_as_float(r.x & 0xffff0000u), __uint_as_float(r.y << 16), __uint_as_float(r.y & 0xffff0000u)};
                        *gas_at<f32x4>(outf, (off + bj * HALF + 16 * n) * 4u) = b + acc[ai][bj][m][n] * alpha; }
            }
    }
};
__host__ __device__ __forceinline__ int att_dim(int bj, int fq, int n, int i) { return bj == 0 ? (fq < 2 ? (n == 0 ? 4 * fq + i : 8 + 4 * fq + i) : 8 * fq + 4 * n + i) : 32 + 8 * fq + 4 * n + i; }
__host__ __device__ __forceinline__ int win_orig_col(int c) {
    const int pn = c >> 8, w = c & 255, wc = w >> 6, bj = (w >> 5) & 1, fq = (w >> 3) & 3, n = (w >> 2) & 1, i = w & 3;
    if (pn < 4) { const int head = 2 * (pn & 1) + bj, g = 4 * wc + fq; return (pn < 2 ? 0 : 512) + head * 128 + (n == 0 ? 4 * g + i : 64 + 4 * g + i); }
    if (pn >= 8 && pn < 12) { const int head = 4 * (pn & 1) + wc; return (pn < 10 ? 2048 : 2560) + head * 64 + att_dim(bj, fq, n, i); }
    return c;
}
template <int MODE = 0, bool F8 = false> struct EpiProjFused {
    static constexpr bool PERM = true, AFTER_DRAIN = false, BADJ = true; static constexpr int NSTORE = 16;
    bf16_t* O; int ldo; const float* ss; const f32x4* rope_r; const f32x4* rope_a; const float* qnw; const float* knw; float* kmean; PG8_LAS unsigned char* tb; RTab rt;
    __device__ __forceinline__ void operator()(const f32x4 (&acc)[2][2][4][2], const Unit& u, int wr, int wc, int fr, int fq) const {
        const int pn = MODE == 1 ? u.pn + 8 : (MODE == 2 ? (u.pn < 8 ? u.pn : u.pn + 4) : (MODE == 3 ? (u.pn < 4 ? u.pn : u.pn + 2) : (MODE == 4 ? (u.pn < 2 ? u.pn + 4 : u.pn + 10) : u.pn))); const float dsc = F8 ? 1.0f / W8_SCALE : 1.0f;
#define PG8_EMIT_ROWS() do { const int l_ = fq * 16 + fr; _Pragma("unroll") for (int k_ = 0; k_ < 2; ++k_) { const u32x4 o_ = *(const PG8_LAS u32x4*)(tb + ((l_ >> 3) + 8 * k_) * 144 + (l_ & 7) * 16); \
        PG8_ST(gas_at<u32x4>(O, ((unsigned)(u.pm * BM + ai * HALF + wr * 64 + m * 16 + (l_ >> 3) + 8 * k_) * (unsigned)ldo + (unsigned)(pn * BM + wc * 64)) * 2u + (unsigned)(l_ & 7) * 16u), o_); } } while (0)
#define PG8_EPI_LANE() asm volatile("" : "+v"(fr), "+v"(fq)); const int row0 = u.pm * BM + wr * 64 + fr; const int col0 = pn * BM + wc * 64 + 8 * fq
        if (MODE != 1 && MODE != 4 && pn < 4) {
            PG8_EPI_LANE();
            const float sc = pn >= 2 ? 0.08838834764831845f : 1.0f; const int g = 4 * wc + fq;
            f32x4 cs[2][4][2];
#pragma unroll
            for (int m = 0; m < 4; ++m)
#pragma unroll
                for (int h = 0; h < 2; ++h) cs[0][m][h] = *gas_at<const f32x4>(rope_r, ((unsigned)((row0 + m * 16) & 2047) * 64u + 4u * (unsigned)g) * 8u + 16u * h);
            float rr[8];
            if (rt.tab) rstd8_tab(rt, u, wr, fr, rr); else rstd8_ss16(ss, row0, fq, rr);
            asm volatile("" ::: "memory");
#pragma unroll
            for (int gi = 0; gi < 8; ++gi) rr[gi] *= (sc * dsc);
#pragma unroll
            for (int m = 0; m < 4; ++m)
#pragma unroll
                for (int h = 0; h < 2; ++h) cs[1][m][h] = *gas_at<const f32x4>(rope_r, ((unsigned)((row0 + HALF + m * 16) & 2047) * 64u + 4u * (unsigned)g) * 8u + 16u * h);
            asm volatile("" ::: "memory");
#pragma unroll
            for (int ai = 0; ai < 2; ++ai)
#pragma unroll
                for (int m = 0; m < 4; ++m) {
                    const int row = row0 + ai * HALF + m * 16; const float r = rr[ai * 4 + m];
                    const f32x4 c01 = cs[ai][m][0], c23 = cs[ai][m][1];
                    const f32x4 cv = {c01[0], c01[2], c23[0], c23[2]}, sv = {c01[1], c01[3], c23[1], c23[3]};
#pragma unroll
                    for (int bj = 0; bj < 2; ++bj) { const f32x4 x1 = acc[ai][bj][m][0] * r, x2 = acc[ai][bj][m][1] * r;
                        const f32x4 v0 = x1 * cv - x2 * sv, v1 = x2 * cv + x1 * sv;
                        u32x4 w; w.x = cvt_pk_bf16(v0[0], v0[1]); w.y = cvt_pk_bf16(v0[2], v0[3]); w.z = cvt_pk_bf16(v1[0], v1[1]); w.w = cvt_pk_bf16(v1[2], v1[3]);
                        *(PG8_LAS u32x4*)(tb + fr * 144 + bj * 64 + fq * 16) = w; }
                    PG8_EMIT_ROWS();
                }
        } else if (MODE != 2 && MODE != 4 && pn >= 8 && pn < 12) {
            PG8_EPI_LANE();
            const bool isk = pn >= 10; const float* gw = isk ? knw : qnw;
            const float qs = isk ? 1.0f : 0.125f * 1.4426950408889634f;
            f32x4 gg[2][2], ca[4][2];
#pragma unroll
            for (int bj = 0; bj < 2; ++bj)
#pragma unroll
                for (int n = 0; n < 2; ++n) gg[bj][n] = *gas_at<const f32x4>(gw, (unsigned)att_dim(bj, fq, n, 0) * 4u);
            const unsigned cof = 4u * (unsigned)(fq & 1) * 8u;
#pragma unroll
            for (int m = 0; m < 4; ++m)
#pragma unroll
                for (int h = 0; h < 2; ++h) ca[m][h] = *gas_at<const f32x4>(rope_a, (unsigned)((row0 + m * 16) & 2047) * 64u + cof + 16u * h);
            float rr[8];
            if (rt.tab) rstd8_tab(rt, u, wr, fr, rr); else rstd8_ss16(ss, row0, fq, rr);
            asm volatile("" ::: "memory");
#pragma unroll
            for (int gi = 0; gi < 8; ++gi) rr[gi] *= dsc;
            f32x4 ksum[2][2];
#pragma unroll
            for (int bj = 0; bj < 2; ++bj)
#pragma unroll
                for (int n = 0; n < 2; ++n) ksum[bj][n] = (f32x4){0.f, 0.f, 0.f, 0.f};
#pragma unroll
            for (int ai = 0; ai < 2; ++ai)
#pragma unroll
                for (int m = 0; m < 4; ++m) {
                    const int row = row0 + ai * HALF + m * 16; const float r = rr[ai * 4 + m];
                    const f32x4 c01 = ca[m][0], c23 = ca[m][1];
                    if (ai == 0) {
#pragma unroll
                        for (int h = 0; h < 2; ++h) ca[m][h] = *gas_at<const f32x4>(rope_a, (unsigned)((row0 + HALF + m * 16) & 2047) * 64u + cof + 16u * h);
                    }
                    float sq = 0.f;
#pragma unroll
                    for (int bj = 0; bj < 2; ++bj)
#pragma unroll
                        for (int n = 0; n < 2; ++n) { const f32x4 a = acc[ai][bj][m][n]; sq += (a[0] * a[0] + a[1] * a[1]) + (a[2] * a[2] + a[3] * a[3]); }
                    sq += __shfl_xor(sq, 16); sq += __shfl_xor(sq, 32);
                    const float s = r * __builtin_amdgcn_rsqf(sq * (r * r) * (1.0f / 64.0f) + 1e-6f);
#pragma unroll
                    for (int bj = 0; bj < 2; ++bj) {
                        f32x4 y0 = acc[ai][bj][m][0] * s * gg[bj][0], y1 = acc[ai][bj][m][1] * s * gg[bj][1];
                        if (bj == 0 && fq < 2) {
                            const f32x4 cv = {c01[0], c01[2], c23[0], c23[2]}, sv = {c01[1], c01[3], c23[1], c23[3]};
                            const f32x4 x1 = y0, x2 = y1; y0 = x1 * cv - x2 * sv; y1 = x2 * cv + x1 * sv;
                        }
                        if (isk) { ksum[bj][0] += y0; ksum[bj][1] += y1; }
                        asm volatile("" : "+v"(ksum[bj][0]), "+v"(ksum[bj][1]));
                        const f32x4 v0 = y0 * qs, v1 = y1 * qs;
                        u32x4 w; w.x = cvt_pk_bf16(v0[0], v0[1]); w.y = cvt_pk_bf16(v0[2], v0[3]); w.z = cvt_pk_bf16(v1[0], v1[1]); w.w = cvt_pk_bf16(v1[2], v1[3]);
                        *(PG8_LAS u32x4*)(tb + fr * 144 + bj * 64 + fq * 16) = w;
                        asm volatile("" ::: "memory");
                    }
                    PG8_EMIT_ROWS();
                }
            if (isk) {
                const unsigned kmo = ((unsigned)(((u.pm >> 3) * 8 + 4 * (pn & 1) + wc) * 8 + (u.pm & 7)) * 64u + 8u * (unsigned)fq) * 4u;
#pragma unroll
                for (int bj = 0; bj < 2; ++bj)
#pragma unroll
                    for (int n = 0; n < 2; ++n)
#pragma unroll
                        for (int i = 0; i < 4; ++i) { float v = ksum[bj][n][i]; v += __shfl_xor(v, 1); v += __shfl_xor(v, 2); v += __shfl_xor(v, 4); v += __shfl_xor(v, 8);
                            if (fr == 0) __hip_atomic_fetch_add(gas_at<float>(kmean, kmo + (unsigned)(32 * bj + 4 * n + i) * 4u), v * (1.0f / 256.0f), __ATOMIC_RELAXED, __HIP_MEMORY_SCOPE_AGENT); }
            }
        } else {
            PG8_EPI_LANE();
            float rr[8]; if (rt.tab) rstd8_tab(rt, u, wr, fr, rr); else rstd8_ss16(ss, row0, fq, rr);
#pragma unroll
            for (int ai = 0; ai < 2; ++ai)
#pragma unroll
                for (int m = 0; m < 4; ++m) {
                    const int row = row0 + ai * HALF + m * 16; const float r = rr[ai * 4 + m] * dsc;
#pragma unroll
                    for (int bj = 0; bj < 2; ++bj) { const f32x4 v0 = acc[ai][bj][m][0] * r, v1 = acc[ai][bj][m][1] * r;
                        u32x4 w; w.x = cvt_pk_bf16(v0[0], v0[1]); w.y = cvt_pk_bf16(v0[2], v0[3]); w.z = cvt_pk_bf16(v1[0], v1[1]); w.w = cvt_pk_bf16(v1[2], v1[3]);
                        *(PG8_LAS u32x4*)(tb + fr * 144 + bj * 64 + fq * 16) = w; }
                    PG8_EMIT_ROWS();
                }
        }
#undef PG8_EPI_LANE
#undef PG8_EMIT_ROWS
    }
};

struct EpiNone {
    static constexpr bool PERM = true, AFTER_DRAIN = false, BADJ = false; static constexpr int NSTORE = 0;
    __device__ __forceinline__ void operator()(const f32x4 (&acc)[2][2][4][2], const Unit&, int, int, int, int) const {
#pragma unroll
        for (int a = 0; a < 2; ++a)
#pragma unroll
            for (int b = 0; b < 2; ++b)
#pragma unroll
                for (int m = 0; m < 4; ++m)
#pragma unroll
                    for (int n = 0; n < 2; ++n) asm volatile("" :: "v"(acc[a][b][m][n]));
    }
};
struct Row0Order : StaticOrder { __host__ __device__ bool next(int i, Unit& u) const { const bool r = StaticOrder::next(i, u); u.pm = 0; return r; } };
struct EpiProj {
    static constexpr bool PERM = true, AFTER_DRAIN = false, BADJ = false; static constexpr int NSTORE = 16;
    bf16_t* O; int ldo; const float* ss;
    __device__ __forceinline__ void operator()(const f32x4 (&acc)[2][2][4][2], const Unit& u, int wr, int wc, int fr, int fq) const {
        const int row0 = u.pm * BM + wr * 64 + fr; const int col0 = u.pn * BM + wc * 32 + 8 * fq;
#pragma unroll
        for (int ai = 0; ai < 2; ++ai)
#pragma unroll
            for (int m = 0; m < 4; ++m) {
                const int row = row0 + ai * HALF + m * 16; const float r = rstd_ss16(ss, row);
#pragma unroll
                for (int bj = 0; bj < 2; ++bj) { const f32x4 v0 = acc[ai][bj][m][0] * r, v1 = acc[ai][bj][m][1] * r;
                    u32x4 w; w.x = cvt_pk_bf16(v0[0], v0[1]); w.y = cvt_pk_bf16(v0[2], v0[3]); w.z = cvt_pk_bf16(v1[0], v1[1]); w.w = cvt_pk_bf16(v1[2], v1[3]);
                    *(u32x4*)(O + (size_t)row * ldo + col0 + bj * HALF) = w; }
            }
    }
};

#ifndef MK_RELAX
#define MK_RELAX 0
#endif
template <class Epi, class Sched, bool ALIGN_EPI = false, bool SP2 = false, bool FP8 = false, int ALAYOUT = 0>
__device__ __forceinline__ void gemm_phase(PG8_LAS unsigned char* lds, const Gemm g, const Sched& S, const Epi& E, const int wv  ) {
    int tid_ = wv * 64 + mk_lane(); asm volatile("" : "+v"(tid_));
    const int tid = tid_, wid = __builtin_amdgcn_readfirstlane(tid >> 6), lane = tid & 63, wr = wid >> 2, wc = wid & 3, fr = lane & 15, fq = lane >> 4;
    const int K = g.K, nt = FP8 ? K / (2 * BK) : K / BK;
    unsigned voffA[2], voffB[2];
#pragma unroll
    for (int i = 0; i < 2; ++i) { int R, C; stage_rc(tid * 16 + i * 8192, R, C); const int Rb = Epi::PERM ? ((R & ~31) + perm32(R & 31)) : R;
        voffA[i] = ALAYOUT == 2 ? (unsigned)((C >> 5) * 16384 + R * 64 + ((C >> 3) & 3) * 16) : ALAYOUT == 1 ? a8_block_off(C >> 4, R, (C >> 3) & 1) : (FP8 ? (unsigned)(R * K + C * 2) : (unsigned)(R * K + C) * 2u); const int Rb2 = Epi::BADJ ? 64 * (Rb >> 5) + (Rb & 31) : Rb; voffB[i] = FP8 ? (unsigned)(Rb2 * K + C * 2) : (unsigned)(Rb2 * K + C) * 2u; }
    const size_t kstep = (size_t)(BK * 2);
    const size_t hstep = FP8 ? (size_t)HALF * K : (size_t)HALF * K * 2;
    const size_t tstep = 2 * hstep;
    const size_t hstepB = Epi::BADJ ? hstep / 4 : hstep;
    const size_t kstepA = ALAYOUT != 0 ? (size_t)32768 : kstep, hstepA = ALAYOUT == 1 ? (size_t)4096 : (ALAYOUT == 2 ? (size_t)8192 : hstep);
    const unsigned ldsw = (unsigned)wid * 1024u;
    const int aoff = lds_byte(wr * 64 + fr, fq * 8), boff = lds_byte(wc * 32 + fr, fq * 8);
    const PG8_LAS unsigned char* ldsB = lds + 4 * HTB + boff; asm volatile("" : "+v"(ldsB));
#define PG8_SA(b, h) (((b) * 2 + (h)) * HTB)
#define PG8_SB(b, h) ((4 + (b) * 2 + (h)) * HTB)
#define PG8_STAGE(bufoff, gbase, voff) do { _Pragma("unroll") for (int _i = 0; _i < 2; ++_i) { unsigned vo_ = (voff)[_i]; asm volatile("" : "+v"(vo_)); \
        __builtin_amdgcn_global_load_lds((const unsigned*)((const char*)(gbase) + vo_), (PG8_LAS unsigned*)(lds + (bufoff) + ldsw + _i * 8192), 16, 0, 0); } } while (0)
#define PG8_LDA(dst, b, h) do { _Pragma("unroll") for (int m = 0; m < 4; ++m) _Pragma("unroll") for (int k = 0; k < 2; ++k) dst[m][k] = *(const PG8_LAS bf16x8*)(lds + PG8_SA(b, h) + aoff + m * 2048 + k * 1024); } while (0)
#define PG8_LDB(dst, b, h) do { _Pragma("unroll") for (int n = 0; n < 2; ++n) _Pragma("unroll") for (int k = 0; k < 2; ++k) dst[n][k] = *(const PG8_LAS bf16x8*)(ldsB + (PG8_SB(b, h) - 4 * HTB) + n * 2048 + k * 1024); } while (0)
#define PG8_MMA(ai, bj, At, Bt) do { __builtin_amdgcn_s_setprio(1); _Pragma("unroll") for (int m = 0; m < 4; ++m) _Pragma("unroll") for (int n = 0; n < 2; ++n) { \
        if constexpr (FP8) { acc[ai][bj][m][n] = __builtin_amdgcn_mfma_scale_f32_16x16x128_f8f6f4(cat8(Bt[n][0], Bt[n][1]), cat8(At[m][0], At[m][1]), acc[ai][bj][m][n], 0, 0, 0, 0, 0, 0); } \
        else { _Pragma("unroll") for (int k = 0; k < 2; ++k) acc[ai][bj][m][n] = __builtin_amdgcn_mfma_f32_16x16x32_bf16(Bt[n][k], At[m][k], acc[ai][bj][m][n], 0, 0, 0); } } __builtin_amdgcn_s_setprio(0); } while (0)
#define PG8_WAIT_V(n) asm volatile("s_waitcnt vmcnt(" #n ")" ::: "memory")
#define PG8_WAIT_L(n) asm volatile("s_waitcnt lgkmcnt(" #n ")" ::: "memory")
#define PG8_WAIT_V8X() do { if (rx) asm volatile("s_waitcnt vmcnt(%0)" :: "n"(8 + Epi::NSTORE) : "memory"); else asm volatile("s_waitcnt vmcnt(8)" ::: "memory"); } while (0)
#define PG8_BAR __builtin_amdgcn_s_barrier()
#define PG8_SCHED __builtin_amdgcn_sched_barrier(0)
    Unit cur, nxt; int ui = 0;
    if (!S.next(0, cur)) return;
    f32x4 acc[2][2][4][2];
#pragma unroll
    for (int a = 0; a < 2; ++a)
#pragma unroll
        for (int b = 0; b < 2; ++b)
#pragma unroll
            for (int m = 0; m < 4; ++m)
#pragma unroll
                for (int n = 0; n < 2; ++n) acc[a][b][m][n] = (f32x4){0.f, 0.f, 0.f, 0.f};
    bf16x8 At[4][2], B0[2][2], B1[2][2];
    const char* cA = (const char*)g.A + (size_t)cur.pm * tstep; const char* cB = (const char*)g.Bt + (size_t)cur.pn * tstep;
    S.a_ready(cur);
    if constexpr (SP2) {
        PG8_STAGE(PG8_SB(0, 0), cB, voffB); PG8_STAGE(PG8_SB(0, 1), cB + hstepB, voffB); PG8_STAGE(PG8_SA(0, 0), cA, voffA); PG8_STAGE(PG8_SA(0, 1), cA + hstepA, voffA);
        if (wr == 1) PG8_BAR;
        PG8_WAIT_V(2); PG8_BAR;
        PG8_STAGE(PG8_SB(1, 0), cB + kstep, voffB); PG8_STAGE(PG8_SA(1, 0), cA + kstepA, voffA); PG8_STAGE(PG8_SB(1, 1), cB + hstepB + kstep, voffB);
        PG8_WAIT_V(6); PG8_BAR;
    } else {
        PG8_STAGE(PG8_SB(0, 0), cB, voffB); PG8_STAGE(PG8_SA(0, 0), cA, voffA); PG8_STAGE(PG8_SB(0, 1), cB + hstepB, voffB); PG8_STAGE(PG8_SA(0, 1), cA + hstepA, voffA);
        if (wr == 1) PG8_BAR;
        PG8_WAIT_V(4); PG8_BAR;
        PG8_STAGE(PG8_SB(1, 0), cB + kstep, voffB); PG8_STAGE(PG8_SA(1, 0), cA + kstepA, voffA); PG8_STAGE(PG8_SB(1, 1), cB + hstepB + kstep, voffB);
        PG8_WAIT_V(6); PG8_BAR;
    }
    for (;;) {
        const bool has_next = S.next(ui + 1, nxt);
        const char* nA = has_next ? (const char*)g.A + (size_t)nxt.pm * tstep : cA; const char* nB = has_next ? (const char*)g.Bt + (size_t)nxt.pn * tstep : cB;
#pragma unroll 1
        for (int t = 0; t < nt; t += 2) {
            const bool last = (t == nt - 2); const bool rx = (t == 0) && (ui > 0) && (Epi::NSTORE > 0) && MK_RELAX;
            const char* a1 = cA + (size_t)(t + 1) * kstepA;
            const char* a2 = last ? nA : cA + (size_t)(t + 2) * kstepA; const char* b2 = last ? nB : cB + (size_t)(t + 2) * kstep;
            const char* a3 = a2 + kstepA; const char* b3 = b2 + kstep;
            if (last && has_next) S.a_ready(nxt);
            if constexpr (SP2) {
            PG8_LDB(B0, 0, 0); PG8_LDB(B1, 0, 1); PG8_SCHED; PG8_LDA(At, 0, 0); PG8_STAGE(PG8_SA(1, 1), a1 + hstepA, voffA);
            PG8_WAIT_V8X(); PG8_WAIT_L(0); PG8_BAR; PG8_MMA(0, 0, At, B0); PG8_MMA(0, 1, At, B1); PG8_BAR; PG8_SCHED;
            PG8_LDA(At, 0, 1); PG8_STAGE(PG8_SB(0, 0), b2, voffB); PG8_STAGE(PG8_SB(0, 1), b2 + hstepB, voffB); PG8_STAGE(PG8_SA(0, 0), a2, voffA);
            PG8_WAIT_V8X(); PG8_WAIT_L(0); PG8_BAR; PG8_MMA(1, 0, At, B0); PG8_MMA(1, 1, At, B1); PG8_BAR; PG8_SCHED;
            PG8_LDB(B0, 1, 0); PG8_LDB(B1, 1, 1); PG8_SCHED; PG8_LDA(At, 1, 0); PG8_STAGE(PG8_SA(0, 1), a2 + hstepA, voffA);
            PG8_WAIT_V(8); PG8_WAIT_L(0); PG8_BAR; PG8_MMA(0, 0, At, B0); PG8_MMA(0, 1, At, B1); PG8_BAR; PG8_SCHED;
            PG8_LDA(At, 1, 1); PG8_STAGE(PG8_SB(1, 0), b3, voffB); PG8_STAGE(PG8_SB(1, 1), b3 + hstepB, voffB); PG8_STAGE(PG8_SA(1, 0), a3, voffA);
            PG8_WAIT_V(8); PG8_WAIT_L(0); PG8_BAR; PG8_MMA(1, 0, At, B0); PG8_MMA(1, 1, At, B1); PG8_BAR; PG8_SCHED;
            } else {
            PG8_LDB(B0, 0, 0); PG8_SCHED; PG8_LDA(At, 0, 0); PG8_STAGE(PG8_SA(1, 1), a1 + hstepA, voffA);
            PG8_WAIT_L(8); PG8_BAR; PG8_WAIT_L(0); PG8_MMA(0, 0, At, B0); PG8_BAR; PG8_SCHED;
            PG8_LDB(B1, 0, 1); PG8_STAGE(PG8_SB(0, 0), b2, voffB);
            PG8_BAR; PG8_WAIT_L(0); PG8_MMA(0, 1, At, B1); PG8_BAR;
            PG8_LDA(At, 0, 1); PG8_STAGE(PG8_SA(0, 0), a2, voffA);
            PG8_BAR; PG8_WAIT_L(0); PG8_MMA(1, 0, At, B0); PG8_BAR; PG8_SCHED;
            PG8_STAGE(PG8_SB(0, 1), b2 + hstepB, voffB);
            PG8_WAIT_V(6); PG8_BAR; PG8_MMA(1, 1, At, B1); PG8_BAR;
            PG8_LDB(B0, 1, 0); PG8_SCHED; PG8_LDA(At, 1, 0); PG8_STAGE(PG8_SA(0, 1), a2 + hstepA, voffA);
            PG8_WAIT_L(8); PG8_BAR; PG8_WAIT_L(0); PG8_MMA(0, 0, At, B0); PG8_BAR; PG8_SCHED;
            PG8_LDB(B1, 1, 1); PG8_STAGE(PG8_SB(1, 0), b3, voffB);
            PG8_BAR; PG8_WAIT_L(0); PG8_MMA(0, 1, At, B1); PG8_BAR;
            PG8_LDA(At, 1, 1); PG8_STAGE(PG8_SA(1, 0), a3, voffA);
            PG8_BAR; PG8_WAIT_L(0); PG8_MMA(1, 0, At, B0); PG8_BAR; PG8_SCHED;
            PG8_STAGE(PG8_SB(1, 1), b3 + hstepB, voffB);
            PG8_WAIT_V(6); PG8_BAR; PG8_MMA(1, 1, At, B1); PG8_BAR;
            }
        }
        if constexpr (ALIGN_EPI) { if (wr == 0) PG8_BAR; }
        if constexpr (!Epi::AFTER_DRAIN) { const int le_ = mk_lane(); E(acc, cur, wr, wc, le_ & 15, le_ >> 4); S.done(cur); }
        if (!has_next) break;
#pragma unroll
        for (int a = 0; a < 2; ++a)
#pragma unroll
            for (int b = 0; b < 2; ++b)
#pragma unroll
                for (int m = 0; m < 4; ++m)
#pragma unroll
                    for (int n = 0; n < 2; ++n) acc[a][b][m][n] = (f32x4){0.f, 0.f, 0.f, 0.f};
        cur = nxt; cA = nA; cB = nB; ++ui;
        if constexpr (ALIGN_EPI) { if (wr == 1) PG8_BAR; }
    }
    PG8_WAIT_V(0);
    if constexpr (!ALIGN_EPI) { if (wr == 0) PG8_BAR; }
    PG8_BAR;
    if constexpr (Epi::AFTER_DRAIN) { E.fused(acc, cur, wr, wc, fr, fq, lds, wid, lane); S.done(cur); }
#undef PG8_SA
#undef PG8_SB
#undef PG8_STAGE
#undef PG8_LDA
#undef PG8_LDB
#undef PG8_MMA
#undef PG8_WAIT_V
#undef PG8_WAIT_V8X
#undef PG8_WAIT_L
#undef PG8_BAR
#undef PG8_SCHED
}
}
#include <hip/hip_bf16.h>
#ifndef ATTN_OUT_FP8
#define ATTN_OUT_FP8 MK_FP8_WOUT
#endif
#include <cmath>
namespace attn_body {
using bf16=__hip_bfloat16;
using bf16x8=__attribute__((ext_vector_type(8)))short;
using s16x4=__attribute__((ext_vector_type(4)))short;
using f32x16=__attribute__((ext_vector_type(16)))float;
using u32x4=__attribute__((ext_vector_type(4)))unsigned;
constexpr int BATCH=32,NHEAD=8,SEQ=2048,D=64,DM=3584,OP=1024;
constexpr int NW=8,QBLK=32,QB=QBLK*NW,KVBLK=64,NQB=SEQ/QB;
constexpr int ATTN_PITCH=DM, ATTN_UNIT_ROWS=QB;
__device__ __forceinline__ int crow(int r,int hi){return (r&3)+8*(r>>2)+4*hi;}
#define SBAR() __builtin_amdgcn_sched_barrier(0)
__device__ __forceinline__ void cmask(f32x16&p0,f32x16&p1,int jb,int qrel,int hi){
  const float NEG=-INFINITY; int kb=64*jb+4*hi;
  #pragma unroll
  for(int r=0;r<16;++r){int kv=kb+(r&3)+8*(r>>2); if(kv>qrel)p0[r]=NEG; if(kv+32>qrel)p1[r]=NEG;}
}

constexpr int NSLOT=3, SLOTB=8192;
constexpr int LDS_K=0, LDS_V=NSLOT*SLOTB, LDS_WS=2*NSLOT*SLOTB, LDS_OST=LDS_WS+NW*64*4, LDS_BYTES=LDS_OST+NW*4096;
constexpr float C2=0.125f*1.4426950408889634f;
__device__ __forceinline__ void glds16(const void*gsrc,unsigned lds_dst){unsigned keep;
  asm volatile("s_mov_b32 %0, m0\n\ts_mov_b32 m0, %2\n\ts_nop 0\n\tglobal_load_lds_dwordx4 %1, off\n\ts_mov_b32 m0, %0":"=&s"(keep):"v"(gsrc),"s"(lds_dst):"memory");}
__device__ __forceinline__ float max3f(float a,float b,float c){float r;asm("v_max3_f32 %0, %1, %2, %3":"=v"(r):"v"(a),"v"(b),"v"(c));return r;}
__device__ __forceinline__ float max2f(float a,float b){float r;asm("v_max_f32_e32 %0, %1, %2":"=v"(r):"v"(a),"v"(b));return r;}
__device__ __forceinline__ float fadd_s(float a,float b){float r;asm("v_add_f32_e32 %0, %1, %2":"=v"(r):"v"(a),"v"(b));return r;}
__device__ __forceinline__ float fsub_s(float a,float b){float r;asm("v_sub_f32_e32 %0, %1, %2":"=v"(r):"v"(a),"v"(b));return r;}
typedef float f32x2_t __attribute__((ext_vector_type(2))); typedef __bf16 bf16x2_t __attribute__((ext_vector_type(2)));
__device__ __forceinline__ unsigned cvtpk_s(float lo,float hi){f32x2_t v={lo,hi};bf16x2_t b=__builtin_convertvector(v,bf16x2_t);return __builtin_bit_cast(unsigned,b);}
#define WAIT_BAR(N) asm volatile("s_waitcnt vmcnt(" #N ") lgkmcnt(0)\n\ts_barrier":::"memory")

__device__ __forceinline__ void qkt(f32x16&p0,f32x16&p1,const char*Kslot,const bf16x8*qr,const f32x16&negm,int r32,int hi){
  const char*kb=Kslot+hi*1024+r32*16;
  #pragma unroll
  for(int d0=0;d0<4;++d0){
    const bf16x8 b0=*reinterpret_cast<const bf16x8*>(kb+d0*2048);
    const bf16x8 b1=*reinterpret_cast<const bf16x8*>(kb+d0*2048+512);
    if(d0==0){p0=__builtin_amdgcn_mfma_f32_32x32x16_bf16(b0,qr[0],negm,0,0,0);p1=__builtin_amdgcn_mfma_f32_32x32x16_bf16(b1,qr[0],negm,0,0,0);}
    else{p0=__builtin_amdgcn_mfma_f32_32x32x16_bf16(b0,qr[d0],p0,0,0,0);p1=__builtin_amdgcn_mfma_f32_32x32x16_bf16(b1,qr[d0],p1,0,0,0);}}
}
typedef __attribute__((address_space(3))) const char* lds_cptr;
typedef short v4i16_t __attribute__((ext_vector_type(4)));
__device__ __forceinline__ void kload8(bf16x8*kf,lds_cptr kp){
  kf[0]=*(const __attribute__((address_space(3))) bf16x8*)(kp);      kf[1]=*(const __attribute__((address_space(3))) bf16x8*)(kp+512);
  kf[2]=*(const __attribute__((address_space(3))) bf16x8*)(kp+2048); kf[3]=*(const __attribute__((address_space(3))) bf16x8*)(kp+2560);
  kf[4]=*(const __attribute__((address_space(3))) bf16x8*)(kp+4096); kf[5]=*(const __attribute__((address_space(3))) bf16x8*)(kp+4608);
  kf[6]=*(const __attribute__((address_space(3))) bf16x8*)(kp+6144); kf[7]=*(const __attribute__((address_space(3))) bf16x8*)(kp+6656);
}
__device__ __forceinline__ void kload2(bf16x8*kf,lds_cptr kp,int j){ kf[2*j]=*(const __attribute__((address_space(3))) bf16x8*)(kp+j*2048); kf[2*j+1]=*(const __attribute__((address_space(3))) bf16x8*)(kp+j*2048+512); }
__device__ __forceinline__ s16x4 vtr(lds_cptr p){ return __builtin_bit_cast(s16x4,__builtin_amdgcn_ds_read_tr16_b64_v4i16((__attribute__((address_space(3))) v4i16_t*)p)); }
__device__ __forceinline__ float rowmax(const f32x16&p0,const f32x16&p1){
  float a=max3f(p0[0],p0[1],p1[0]),b=max3f(p0[2],p0[3],p1[1]);a=max3f(a,p1[2],p1[3]);
  #pragma unroll
  for(int r=4;r<16;r+=4){a=max3f(a,p0[r],p0[r+1]);b=max3f(b,p0[r+2],p0[r+3]);a=max3f(a,p1[r],p1[r+1]);b=max3f(b,p1[r+2],p1[r+3]);}
  const float m=max2f(a,b);
  auto rr=__builtin_amdgcn_permlane32_swap(__float_as_uint(m),__float_as_uint(m),false,false);
  return max2f(__uint_as_float(rr[0]),__uint_as_float(rr[1]));
}
__device__ __forceinline__ void pv(f32x16*o,int vb,bf16x8 pa0,bf16x8 pa1,bf16x8 pa2,bf16x8 pa3){
  #pragma unroll
  for(int d0=0;d0<2;++d0){s16x4 lo[4],hi[4];
    #pragma unroll
    for(int ks=0;ks<4;++ks){
      asm volatile("ds_read_b64_tr_b16 %0,%1 offset:%c2":"=&v"(lo[ks]):"v"(vb),"i"(d0*4096+ks*1024):"memory");
      asm volatile("ds_read_b64_tr_b16 %0,%1 offset:%c2":"=&v"(hi[ks]):"v"(vb),"i"(d0*4096+ks*1024+512):"memory");}
    asm volatile("s_waitcnt lgkmcnt(0)":::"memory");SBAR();
    #define PK(k) (bf16x8){lo[k][0],lo[k][1],lo[k][2],lo[k][3],hi[k][0],hi[k][1],hi[k][2],hi[k][3]}
    o[d0]=__builtin_amdgcn_mfma_f32_32x32x16_bf16(pa0,PK(0),o[d0],0,0,0);
    o[d0]=__builtin_amdgcn_mfma_f32_32x32x16_bf16(pa1,PK(1),o[d0],0,0,0);
    o[d0]=__builtin_amdgcn_mfma_f32_32x32x16_bf16(pa2,PK(2),o[d0],0,0,0);
    o[d0]=__builtin_amdgcn_mfma_f32_32x32x16_bf16(pa3,PK(3),o[d0],0,0,0);
    #undef PK
  }
}

#ifndef ATTN_STORE16
#define ATTN_STORE16(p,v) (*(__attribute__((address_space(1))) u32x4*)(p)=(v))
#endif
template<int THRL> __device__ __forceinline__ void attn_unit(int b,int h,int qb,const bf16*Q,const bf16*K,const bf16*V,bf16*O,const float*kmean,const float*beta,char*shm,const int wv){
  int tid_o=wv*64+mk_lane(); asm volatile("":"+v"(tid_o));
  const int tid=tid_o,lane=tid&63,r32=lane&31,hi=lane>>5; const int wid=__builtin_amdgcn_readfirstlane(tid>>6);
  const long rowbase=(long)b*SEQ; const int q0=qb*QB;
  const int hoff=(h>>2)*256+(h&3)*64;
  const bf16*Qw=Q+(rowbase+q0+wid*QBLK)*DM+hoff;
  const bf16*Kh=K+rowbase*DM+hoff,*Vh=V+rowbase*DM+h*D;
  const unsigned lds0=(unsigned)(uintptr_t)shm;
  float*wsf=(float*)(shm+LDS_WS)+wid*64;
  const bf16*ksrc=Kh+(long)lane*DM+wid*8;
  const bf16*vsrc=Vh+(long)(16*(wid&3)+(lane>>2))*DM+(wid>>2)*32+(lane&3)*8;
  const unsigned kdst=lds0+LDS_K+wid*1024, vdst=lds0+LDS_V+wid*1024;
  #define DMA_K(t,slot) glds16(ksrc+(long)(t)*KVBLK*DM,(unsigned)__builtin_amdgcn_readfirstlane(kdst+(slot)))
  #define DMA_V(t,slot) glds16(vsrc+(long)(t)*KVBLK*DM,(unsigned)__builtin_amdgcn_readfirstlane(vdst+(slot)))
  const int vb0=(int)(lds0+LDS_V)+((lane>>4)&1)*32+(lane&3)*8+(4*hi+((lane&15)>>2))*64;
  const char*Kbase=shm+LDS_K; bf16x8 kf[8];
  const lds_cptr shm3=(lds_cptr)shm; const lds_cptr kp0=shm3+LDS_K+hi*1024+r32*16; const lds_cptr vp0=shm3+LDS_V+((lane>>4)&1)*32+(lane&3)*8+(4*hi+((lane&15)>>2))*64;
  const int NT=(q0+QB)/KVBLK;
  DMA_K(0,0);DMA_V(0,0);DMA_K(1,SLOTB);
  bf16x8 qr[4];
  #pragma unroll
  for(int d0=0;d0<4;++d0)qr[d0]=*reinterpret_cast<const bf16x8*>(&Qw[(long)r32*DM+d0*16+hi*8]);
  unsigned selbits=(2u<<qb)-1u;
  if(qb>3){
    float g[7];
    #pragma unroll
    for(int n=0;n<7;++n){ g[n]=-INFINITY;
      if(n<qb){ const float*km=kmean+((long)(b*NHEAD+h)*8+n)*64+hi*8; float a=0.f;
        #pragma unroll
        for(int d0=0;d0<4;++d0){ const float4 k0=*reinterpret_cast<const float4*>(km+d0*16),k1=*reinterpret_cast<const float4*>(km+d0*16+4); const bf16x8 qq=qr[d0];
          a+=__uint_as_float((unsigned)(unsigned short)qq[0]<<16)*k0.x+__uint_as_float((unsigned)(unsigned short)qq[1]<<16)*k0.y+__uint_as_float((unsigned)(unsigned short)qq[2]<<16)*k0.z+__uint_as_float((unsigned)(unsigned short)qq[3]<<16)*k0.w
            +__uint_as_float((unsigned)(unsigned short)qq[4]<<16)*k1.x+__uint_as_float((unsigned)(unsigned short)qq[5]<<16)*k1.y+__uint_as_float((unsigned)(unsigned short)qq[6]<<16)*k1.z+__uint_as_float((unsigned)(unsigned short)qq[7]<<16)*k1.w; }
        a+=__shfl_xor(a,32); g[n]=a; } }
    selbits=1u<<qb;
    #pragma unroll
    for(int n=0;n<7;++n){ int rank=0;
      #pragma unroll
      for(int m2=0;m2<7;++m2) if(m2!=n) rank+=((g[m2]>g[n])||(g[m2]==g[n]&&m2<n))?1:0;
      if(n<qb&&rank<3) selbits|=1u<<n; }
  }
  #define MWORD(t) ((unsigned)(((int)(selbits<<(31-((t)>>2))))>>31))
  float mhat=0.f,l_reg=0.f;f32x16 o[2];f32x16 negm; { float zf; asm volatile("v_mov_b32 %0, 0":"=v"(zf));
    _Pragma("unroll") for(int r=0;r<16;++r){o[0][r]=zf;o[1][r]=zf;negm[r]=zf;} } asm volatile("":"+v"(negm));
  const int qrel=wid*QBLK+r32;
  #define CMASK(P0,P1,t) do{int jb_=(t)-(NT-4); if(jb_>=0)cmask(P0,P1,jb_,qrel,hi);}while(0)
  bool resc=false;
  #define START(P0,P1) do{ const float rm=(selbits&1u)?rowmax(P0,P1):0.f; resc=false; \
    { const float dl=rm; mhat=fadd_s(mhat,dl); \
      _Pragma("unroll") for(int r=0;r<16;++r){P0[r]=fsub_s(P0[r],dl);P1[r]=fsub_s(P1[r],dl);} \
      _Pragma("unroll") for(int r=0;r<16;++r)negm[r]=-mhat; asm volatile("":"+v"(negm)); } \
    _Pragma("unroll") for(int r=0;r<16;++r)P0[r]=__builtin_amdgcn_exp2f(P0[r]); }while(0)
  #define RESC() do{ if(resc){ asm volatile("s_waitcnt lgkmcnt(0)":::"memory"); \
      _Pragma("unroll") for(int d_=0;d_<2;++d_) _Pragma("unroll") for(int r=0;r<16;++r)o[d_][r]*=wsf[crow(r,hi)]; } }while(0)
  f32x16 pA0,pA1,pB0,pB1;
  int sl_prev=0,sl_cur=0,sl_next=SLOTB;
  #define ROT() do{sl_prev=sl_cur;sl_cur=sl_next;sl_next=(sl_next==(NSLOT-1)*SLOTB)?0:sl_next+SLOTB;}while(0)
  DMA_K(2,2*SLOTB);
  WAIT_BAR(3);
  qkt(pA0,pA1,Kbase,qr,negm,r32,hi);asm volatile("s_nop 15\n\ts_nop 7":"+v"(pA0),"+v"(pA1));CMASK(pA0,pA1,0);
  START(pA0,pA1);
  _Pragma("unroll") for(int r=0;r<16;++r)pA1[r]=__builtin_amdgcn_exp2f(pA1[r]);
  WAIT_BAR(0);
  DMA_K(3,0);DMA_V(1,SLOTB);
  ROT();
  kload8(kf,kp0+sl_cur);
  WAIT_BAR(2);
  s16x4 vlo[8],vhi[8]; u32x4 pw0,pw1,pw2,pw3;
  #define PKW(P,B) (cvtpk_s(P[B],P[B+1])&mwp_)
  #define PAF(k) __builtin_bit_cast(bf16x8,pw##k)
  #define VFR(i) (bf16x8){vlo[i][0],vlo[i][1],vlo[i][2],vlo[i][3],vhi[i][0],vhi[i][1],vhi[i][2],vhi[i][3]}
  #define PIN(x) asm volatile("":"+v"(x))
  #define MX3(a,b,c) __builtin_fmaxf(__builtin_fmaxf((a),(b)),(c))
  #define GAPA(MF,A0,A1,A2,A3,W0,W1,PW) do{ MF; sacc+=A0; sacc+=A1; sacc+=A2; sacc+=A3; PIN(sacc); W0; W1; PIN(PW); SBAR(); }while(0)
  #define EX(v) __builtin_amdgcn_exp2f(v)
  #define GAPB(MF,X,B) do{ MF; X[B]=EX(X[B]); X[B+1]=EX(X[B+1]); X[B+2]=EX(X[B+2]); X[B+3]=EX(X[B+3]); PIN(X); SBAR(); }while(0)
  #define VRD(i) do{ vlo[i]=vtr(vp_+(((i)>>2)*4096+((i)&3)*1024)); vhi[i]=vtr(vp_+(((i)>>2)*4096+((i)&3)*1024+512)); }while(0)
  #define KRD(G,j) do{ if(G){ kload2(kf,kp0+sl_next,j); SBAR(); } }while(0)
  #define STEP(C0,C1,P0,P1,t,GK,GV,GL) do{ SBAR(); \
    const unsigned mwp_=MWORD((t)-1), mwc_=MWORD(t); \
    const lds_cptr vp_=vp0+sl_prev; \
    VRD(0); SBAR(); float sacc=(P0[0]+P0[1]); \
    GAPA(C0=__builtin_amdgcn_mfma_f32_32x32x16_bf16(kf[0],qr[0],negm,0,0,0), P0[2],P0[3],P0[4],P0[5],     pw0[0]=PKW(P0,0), pw0[1]=PKW(P0,2), pw0); \
    VRD(4); SBAR(); GAPA(C1=__builtin_amdgcn_mfma_f32_32x32x16_bf16(kf[1],qr[0],negm,0,0,0), P0[6],P0[7],P0[8],P0[9],     pw0[2]=PKW(P0,4), pw0[3]=PKW(P0,6), pw0); \
    VRD(1); SBAR(); GAPA(C0=__builtin_amdgcn_mfma_f32_32x32x16_bf16(kf[2],qr[1],C0,0,0,0),   P0[10],P0[11],P0[12],P0[13], pw1[0]=PKW(P0,8), pw1[1]=PKW(P0,10), pw1); \
    VRD(5); SBAR(); GAPA(C1=__builtin_amdgcn_mfma_f32_32x32x16_bf16(kf[3],qr[1],C1,0,0,0),   P0[14],P0[15],P1[0],P1[1],   pw1[2]=PKW(P0,12),pw1[3]=PKW(P0,14), pw1); \
    VRD(2); SBAR(); GAPA(C0=__builtin_amdgcn_mfma_f32_32x32x16_bf16(kf[4],qr[2],C0,0,0,0),   P1[2],P1[3],P1[4],P1[5],     pw2[0]=PKW(P1,0), pw2[1]=PKW(P1,2), pw2); \
    VRD(6); SBAR(); GAPA(C1=__builtin_amdgcn_mfma_f32_32x32x16_bf16(kf[5],qr[2],C1,0,0,0),   P1[6],P1[7],P1[8],P1[9],     pw2[2]=PKW(P1,4), pw2[3]=PKW(P1,6), pw2); \
    VRD(3); SBAR(); GAPA(C0=__builtin_amdgcn_mfma_f32_32x32x16_bf16(kf[6],qr[3],C0,0,0,0),   P1[10],P1[11],P1[12],P1[13], pw3[0]=PKW(P1,8), pw3[1]=PKW(P1,10), pw3); \
    VRD(7); SBAR(); GAPA(C1=__builtin_amdgcn_mfma_f32_32x32x16_bf16(kf[7],qr[3],C1,0,0,0),   P1[14],P1[15],0.f,0.f,       pw3[2]=PKW(P1,12),pw3[3]=PKW(P1,14), pw3); \
    l_reg+=(mwp_?sacc:0.f); \
    if(GK){DMA_K((t)+3,sl_cur);} if(GV){DMA_V((t)+1,sl_next);} \
    CMASK(C0,C1,t); \
    { float a=MX3(C0[0],C0[1],C1[0]),b=MX3(C0[2],C0[3],C1[1]); a=MX3(a,C1[2],C1[3]); \
      _Pragma("unroll") for(int r=4;r<16;r+=4){a=MX3(a,C0[r],C0[r+1]);b=MX3(b,C0[r+2],C0[r+3]);a=MX3(a,C1[r],C1[r+1]);b=MX3(b,C1[r+2],C1[r+3]);} \
      float rm=__builtin_fmaxf(a,b); { auto rr=__builtin_amdgcn_permlane32_swap(__float_as_uint(rm),__float_as_uint(rm),false,false); rm=__builtin_fmaxf(__uint_as_float(rr[0]),__uint_as_float(rr[1])); } \
      rm=mwc_?rm:-INFINITY; resc=false; \
      if(__builtin_expect(__any(rm>(float)THRL),0)){ const float dl=__builtin_fmaxf(rm,0.f); mhat+=dl; \
        _Pragma("unroll") for(int r=0;r<16;++r){C0[r]-=dl;C1[r]-=dl;} \
        _Pragma("unroll") for(int r=0;r<16;++r)negm[r]=-mhat; asm volatile("":"+v"(negm)); \
        const float f=__builtin_amdgcn_exp2f(-dl); l_reg*=f; if(hi==0)wsf[r32]=f; resc=true; } } \
    SBAR(); \
    GAPB(o[0]=__builtin_amdgcn_mfma_f32_32x32x16_bf16(PAF(0),VFR(0),o[0],0,0,0), C0,0); \
    GAPB(o[1]=__builtin_amdgcn_mfma_f32_32x32x16_bf16(PAF(0),VFR(4),o[1],0,0,0), C0,4); \
    KRD(GL,0); GAPB(o[0]=__builtin_amdgcn_mfma_f32_32x32x16_bf16(PAF(1),VFR(1),o[0],0,0,0), C0,8); \
    KRD(GL,1); GAPB(o[1]=__builtin_amdgcn_mfma_f32_32x32x16_bf16(PAF(1),VFR(5),o[1],0,0,0), C0,12); \
    KRD(GL,2); GAPB(o[0]=__builtin_amdgcn_mfma_f32_32x32x16_bf16(PAF(2),VFR(2),o[0],0,0,0), C1,0); \
    KRD(GL,3); GAPB(o[1]=__builtin_amdgcn_mfma_f32_32x32x16_bf16(PAF(2),VFR(6),o[1],0,0,0), C1,4); \
    GAPB(o[0]=__builtin_amdgcn_mfma_f32_32x32x16_bf16(PAF(3),VFR(3),o[0],0,0,0), C1,8); \
    GAPB(o[1]=__builtin_amdgcn_mfma_f32_32x32x16_bf16(PAF(3),VFR(7),o[1],0,0,0), C1,12); \
    }while(0)
  int t=1;
  #undef CMASK
  #define CMASK(P0,P1,t) do{}while(0)
  for(;t+5<NT;t+=2){
    STEP(pB0,pB1,pA0,pA1,t,true,true,true);     WAIT_BAR(2); RESC(); ROT();
    STEP(pA0,pA1,pB0,pB1,t+1,true,true,true);   WAIT_BAR(2); RESC(); ROT();
  }
  #undef CMASK
  #define CMASK(P0,P1,t) do{int jb_=(t)-(NT-4); if(jb_>=0)cmask(P0,P1,jb_,qrel,hi);}while(0)
  #define ENDW(tt) do{ if((tt)+3<NT){WAIT_BAR(2);} else if((tt)+2<NT){WAIT_BAR(1);} else {WAIT_BAR(0);} }while(0)
  for(;t+1<NT;t+=2){
    STEP(pB0,pB1,pA0,pA1,t,(t+3<NT),(t+1<NT),(t+1<NT));       ENDW(t);   RESC(); ROT();
    STEP(pA0,pA1,pB0,pB1,t+1,(t+4<NT),(t+2<NT),(t+2<NT));     ENDW(t+1); RESC(); ROT();
  }
  STEP(pB0,pB1,pA0,pA1,NT-1,false,false,false); RESC();
  { const unsigned mwp_=0xffffffffu; float sacc=pB0[0]+pB0[1]; _Pragma("unroll") for(int r=2;r<16;++r)sacc+=pB0[r]; _Pragma("unroll") for(int r=0;r<16;++r)sacc+=pB1[r]; l_reg+=sacc;
    pw0=(u32x4){PKW(pB0,0),PKW(pB0,2),PKW(pB0,4),PKW(pB0,6)};pw1=(u32x4){PKW(pB0,8),PKW(pB0,10),PKW(pB0,12),PKW(pB0,14)};pw2=(u32x4){PKW(pB1,0),PKW(pB1,2),PKW(pB1,4),PKW(pB1,6)};pw3=(u32x4){PKW(pB1,8),PKW(pB1,10),PKW(pB1,12),PKW(pB1,14)};
    SBAR(); pv(o,vb0+sl_cur,PAF(0),PAF(1),PAF(2),PAF(3)); }
  #undef PKW
  #undef PAF
  #undef VFR
  #undef PIN
  #undef MX3
  #undef GAPA
  #undef GAPB
  #undef EX
  #undef VRD
  #undef KRD
  #undef STEP
  #undef ENDW
  {auto rr=__builtin_amdgcn_permlane32_swap(__float_as_uint(l_reg),__float_as_uint(l_reg),false,false);l_reg=__uint_as_float(rr[0])+__uint_as_float(rr[1]);}
  if(hi==0)wsf[32+r32]=l_reg;asm volatile("s_waitcnt lgkmcnt(0)":::"memory");
  float rli[16];
  #pragma unroll
  for(int r=0;r<16;++r)rli[r]=__builtin_amdgcn_rcpf(wsf[32+crow(r,hi)]);
  bf16*Ow=O+(rowbase+q0+wid*QBLK)*OP+h*D;
  typedef float f4g_ __attribute__((ext_vector_type(4)));
  const f4g_ bg0=*(const __attribute__((address_space(1))) f4g_*)(beta+h*D+(lane&7)*8), bg1=*(const __attribute__((address_space(1))) f4g_*)(beta+h*D+(lane&7)*8+4);
  { bf16*stg=(bf16*)(shm+LDS_OST)+wid*2048;
    #pragma unroll
    for(int r=0;r<16;++r){const int orow=crow(r,hi);
      #pragma unroll
      for(int d0=0;d0<2;++d0)stg[orow*64+d0*32+r32]=__float2bfloat16(o[d0][r]*rli[r]);}
    asm volatile("s_waitcnt lgkmcnt(0)":::"memory");
    int lane_e=lane; asm volatile("":"+v"(lane_e));
    #pragma unroll
    for(int i=0;i<4;++i){const int row=i*8+(lane_e>>3),ch=lane_e&7; const u32x4 v=*(const u32x4*)(stg+row*64+ch*8);
      float f[8]; f[0]=__uint_as_float(v.x<<16);f[1]=__uint_as_float(v.x&0xffff0000u);f[2]=__uint_as_float(v.y<<16);f[3]=__uint_as_float(v.y&0xffff0000u);f[4]=__uint_as_float(v.z<<16);f[5]=__uint_as_float(v.z&0xffff0000u);f[6]=__uint_as_float(v.w<<16);f[7]=__uint_as_float(v.w&0xffff0000u);
      float sq=((f[0]*f[0]+f[1]*f[1])+(f[2]*f[2]+f[3]*f[3]))+((f[4]*f[4]+f[5]*f[5])+(f[6]*f[6]+f[7]*f[7]));
      sq+=__shfl_xor(sq,1);sq+=__shfl_xor(sq,2);sq+=__shfl_xor(sq,4);
      const float rn=1.0f/sqrtf(sq*(1.0f/64.0f)+1e-6f);
      const float4 b0=make_float4(bg0[0],bg0[1],bg0[2],bg0[3]),b1=make_float4(bg1[0],bg1[1],bg1[2],bg1[3]);
#if ATTN_OUT_FP8
      { typedef unsigned u32x2_t __attribute__((ext_vector_type(2))); u32x2_t w8; w8.x=pg8::pk4_fp8(f[0]*rn*b0.x,f[1]*rn*b0.y,f[2]*rn*b0.z,f[3]*rn*b0.w); w8.y=pg8::pk4_fp8(f[4]*rn*b1.x,f[5]*rn*b1.y,f[6]*rn*b1.z,f[7]*rn*b1.w);
        MIX_STNT(w8,(__attribute__((address_space(1))) u32x2_t*)((unsigned char*)O+((rowbase+q0+wid*QBLK+row)*OP+h*D+ch*8))); }
#else
      u32x4 w; w.x=cvtpk_s(f[0]*rn*b0.x,f[1]*rn*b0.y);w.y=cvtpk_s(f[2]*rn*b0.z,f[3]*rn*b0.w);w.z=cvtpk_s(f[4]*rn*b1.x,f[5]*rn*b1.y);w.w=cvtpk_s(f[6]*rn*b1.z,f[7]*rn*b1.w);
      ATTN_STORE16(Ow+(long)row*OP+ch*8,w);
#endif
      } }
  asm volatile("s_waitcnt lgkmcnt(0)\n\ts_barrier":::"memory");
  #undef MWORD
  #undef DMA_K
  #undef DMA_V
  #undef CMASK
  #undef START
  #undef RESC
  #undef ROT
}
constexpr int ATTN_LDS_BYTES=LDS_BYTES;
struct AttnTensors { const bf16* Q; const bf16* K; const bf16* V; bf16* O; const float* kmean; const float* beta; };
struct AttnUnit { int bh; int qb; };
struct StaticOrder {
  int vcu,G;
  __device__ __forceinline__ explicit StaticOrder(int grid,int vcu_):vcu(vcu_),G(grid){}
  __device__ __forceinline__ bool next(int i,AttnUnit&u)const{
    if(G==256){ const int p=vcu>>1;
#ifndef MK_DEAL
#define MK_DEAL 22
#endif
#if MK_DEAL == 23
      if(vcu&1){ if(i>=12)return false; if(i<8){u.bh=2*p;u.qb=7-i;} else {u.bh=2*p+1; const int k=i-8; u.qb=(k==0)?5:(k==1)?3:(k==2)?1:0;} }
      else { if(i>=4)return false; u.bh=2*p+1; u.qb=(i==0)?7:(i==1)?6:(i==2)?4:2; }
#elif MK_DEAL == 24
      if(vcu&1){ if(i>=12)return false; if(i<8){u.bh=2*p;u.qb=7-i;} else {u.bh=2*p+1; const int k=i-8; u.qb=(k==0)?4:(k==1)?3:(k==2)?1:0;} }
      else { if(i>=4)return false; u.bh=2*p+1; u.qb=(i==0)?7:(i==1)?6:(i==2)?5:2; }
#elif MK_DEAL == 21
      if(vcu&1){ if(i>=12)return false; if(i<8){u.bh=2*p;u.qb=7-i;} else {u.bh=2*p+1; const int k=i-8; u.qb=(k==0)?5:(k==1)?3:(k==2)?2:1;} }
      else { if(i>=4)return false; u.bh=2*p+1; u.qb=(i==0)?7:(i==1)?6:(i==2)?4:0; }
#else
      if(vcu&1){ if(i>=12)return false; if(i<8){u.bh=2*p;u.qb=7-i;} else {u.bh=2*p+1; const int k=i-8; u.qb=(k==0)?5:(k==1)?3:(k==2)?2:0;} }
      else { if(i>=4)return false; u.bh=2*p+1; u.qb=(i==0)?7:(i==1)?6:(i==2)?4:1; }
#endif
      return true; }
    const int bh=vcu+(i>>3)*G; if(bh>=BATCH*NHEAD)return false; u.bh=bh; u.qb=7-(i&7); return true; }
  __device__ __forceinline__ void a_ready(const AttnUnit&)const{}
  __device__ __forceinline__ void done(const AttnUnit&)const{}
};
template<class Sched,int THRL=8> __device__ __forceinline__ void attn_phase(char*lds,const AttnTensors&T,const Sched&S,const int wv){
  AttnUnit u;
  for(int i=0;S.next(i,u);++i){ S.a_ready(u); attn_unit<THRL>(u.bh/NHEAD,u.bh%NHEAD,u.qb,T.Q,T.K,T.V,T.O,T.kmean,T.beta,lds,wv); S.done(u); }
}
#undef SBAR
#undef WAIT_BAR
}
#ifndef RET_OUT_FP8
#define RET_OUT_FP8 MK_FP8_WOUT
#define RGAS __attribute__((address_space(1)))
#ifndef MK_NT_RET
#define MK_NT_RET 0
#endif
#if MK_NT_RET
#define RET_LDNT(p) __builtin_nontemporal_load(p)
#else
#define RET_LDNT(p) (*(p))
#endif
#endif
namespace ret_body {
typedef short bf16x8 __attribute__((ext_vector_type(8)));
typedef short s16x4 __attribute__((ext_vector_type(4)));
typedef float f32x16 __attribute__((ext_vector_type(16)));
typedef unsigned u32x4 __attribute__((ext_vector_type(4)));
typedef unsigned u32x2 __attribute__((ext_vector_type(2)));
typedef float f32x4r __attribute__((ext_vector_type(4)));
#define RLAS __attribute__((address_space(3)))
constexpr int SEQ = 2048, INW = 3584, OP = 1024, PC_RQ = 0, PC_RK = 512, PC_RV = 1024, PC_RG = 1536;
constexpr int R0 = 0, R1 = 32768, R2 = 65536, R3 = 98304, RBETA = 131072 + 1024, RDEC = RBETA + 512, RET_LDS_END = RDEC + 512;
__device__ __forceinline__ int sw_off(int row, int ch) { return 256 * row + 16 * (ch ^ (((row & 3) << 2) | ((row >> 2) & 3))); }
__device__ __forceinline__ bf16x8 ld_row(const RLAS unsigned char* base, int row, int ch) { return *(const RLAS bf16x8*)(base + sw_off(row, ch)); }
__device__ __forceinline__ s16x4 tr4(const RLAS unsigned char* p) { typedef short v4i16_t __attribute__((ext_vector_type(4))); return __builtin_bit_cast(s16x4, __builtin_amdgcn_ds_read_tr16_b64_v4i16((RLAS v4i16_t*)p)); }
__device__ __forceinline__ bf16x8 ld_tr(const RLAS unsigned char* base, int k0, int c0ch, int lane) {
    const int g = lane >> 4, i = lane & 15, q = i >> 2, p = i & 3;
    const int row = k0 + 8 * (g >> 1) + q, ch = c0ch + 2 * (g & 1) + (p >> 1);
    const s16x4 lo = tr4(base + sw_off(row, ch) + 8 * (p & 1)), hi = tr4(base + sw_off(row + 4, ch) + 8 * (p & 1));
    return (bf16x8){lo[0], lo[1], lo[2], lo[3], hi[0], hi[1], hi[2], hi[3]};
}
__device__ __forceinline__ unsigned cvtpk(float lo, float hi) { typedef float f32x2_t __attribute__((ext_vector_type(2))); typedef __bf16 bf16x2_t __attribute__((ext_vector_type(2)));
    f32x2_t v = {lo, hi}; bf16x2_t b = __builtin_convertvector(v, bf16x2_t); return __builtin_bit_cast(unsigned, b); }
__device__ __forceinline__ float bflo(unsigned u) { return __uint_as_float(u << 16); }
__device__ __forceinline__ float bfhi(unsigned u) { return __uint_as_float(u & 0xffff0000u); }
#define RMFMA(a, b, c) __builtin_amdgcn_mfma_f32_32x32x16_bf16(a, b, c, 0, 0, 0)
#define OPQ1(a) asm volatile("" : "+v"(a))
#define OPQ2(a, b) asm volatile("" : "+v"(a), "+v"(b))

__device__ __forceinline__ void ret_unit(const unsigned short* PROJ, unsigned short* MIX, const float* beta_g, int b, int h, RLAS unsigned char* lds, const int w  ) {
#define LANE_IDX() const int lane = mk_lane(), tid = w * 64 + lane, l31 = lane & 31, hi = lane >> 5; (void)tid; (void)l31; (void)hi
    const int qi = w & 3, pb = w >> 2;
    const float gamma = 1.0f - exp2f(-5.0f - (float)h), lg = log2f(gamma);
    RLAS unsigned char* r0 = lds + R0; RLAS unsigned char* r1 = lds + R1; RLAS unsigned char* r2 = lds + R2; RLAS unsigned char* r3 = lds + R3;
    RLAS float* betas = (RLAS float*)(lds + RBETA); RLAS float* dtab = (RLAS float*)(lds + RDEC);
    { LANE_IDX(); for (int i = tid; i < 32768 / 16; i += 512) ((RLAS u32x4*)r3)[i] = (u32x4){0u, 0u, 0u, 0u};
      if (tid < 128) { betas[tid] = beta_g[h * 128 + tid]; dtab[tid] = __builtin_amdgcn_exp2f((float)tid * lg); } }
    f32x16 st[2];
#pragma unroll
    for (int j = 0; j < 2; ++j)
#pragma unroll
        for (int r = 0; r < 16; ++r) st[j][r] = 0.f;
    const float cd = exp2f(128.0f * lg);
    u32x4 gq[4], gk[4], gv[4];
#define RET_LOAD(cc) do { LANE_IDX(); const int lrow = tid >> 2, lcb = (tid & 3) * 4; const unsigned short* p = PROJ + ((size_t)b * SEQ + (cc) * 128 + lrow) * INW + h * 128 + lcb * 8; \
        const unsigned short* pqk = PROJ + ((size_t)b * SEQ + (cc) * 128 + lrow) * INW + (h >> 1) * 256 + (tid & 3) * 64 + (h & 1) * 32;     \
        _Pragma("unroll") for (int i = 0; i < 4; ++i) { gq[i] = RET_LDNT((const RGAS u32x4*)(pqk + PC_RQ + i * 8)); gk[i] = RET_LDNT((const RGAS u32x4*)(pqk + PC_RK + i * 8)); gv[i] = RET_LDNT((const RGAS u32x4*)(p + PC_RV + i * 8)); } } while (0)
    RET_LOAD(0);
#pragma unroll 1
    for (int c = 0; c < 16; ++c) {
        const size_t grow = (size_t)b * SEQ + c * 128;
        float lgc = lg; asm volatile("" : "+v"(lgc));
        {
            LANE_IDX(); const int lrow = tid >> 2, lcb = (tid & 3) * 4;
#pragma unroll
            for (int i = 0; i < 4; ++i) { *(RLAS u32x4*)(r0 + sw_off(lrow, lcb + i)) = gq[i]; *(RLAS u32x4*)(r1 + sw_off(lrow, lcb + i)) = gk[i]; *(RLAS u32x4*)(r2 + sw_off(lrow, lcb + i)) = gv[i]; }
        }
        __syncthreads();
        f32x16 ao[2], as[2];
        { LANE_IDX();
        float zf; asm volatile("v_mov_b32 %0, 0" : "=v"(zf));
#pragma unroll
        for (int j = 0; j < 2; ++j)
#pragma unroll
            for (int r = 0; r < 16; ++r) { ao[j][r] = zf; as[j][r] = zf; }
#pragma unroll 2
        for (int ks = 0; ks < 8; ++ks) {
            const bf16x8 bq = ld_row(r0, 32 * qi + l31, 2 * ks + hi);
#pragma unroll
            for (int j = 0; j < 2; ++j) { const bf16x8 a = ld_row(r3, 32 * (2 * pb + j) + l31, 2 * ks + hi); ao[j] = RMFMA(a, bq, ao[j]); }
#pragma unroll
            for (int j = 0; j < 2; ++j) if (2 * pb + j <= qi) { const bf16x8 a = ld_row(r1, 32 * (2 * pb + j) + l31, 2 * ks + hi); as[j] = RMFMA(a, bq, as[j]); }
        }
        const float qdec = __builtin_amdgcn_exp2f((float)(32 * qi + l31 + 1) * lgc);
#pragma unroll
        for (int j = 0; j < 2; ++j)
#pragma unroll
            for (int r = 0; r < 16; ++r) ao[j][r] *= qdec;
        }
        __syncthreads();
        { LANE_IDX();
#pragma unroll
        for (int j = 0; j < 2; ++j) if (2 * pb + j <= qi) {
            const int kb = 2 * pb + j, q = 32 * qi + l31;
#pragma unroll
            for (int g4 = 0; g4 < 4; ++g4) { float pv[4];
#pragma unroll
                for (int i = 0; i < 4; ++i) { const int key = 32 * kb + 8 * g4 + 4 * hi + i, diff = q - key; pv[i] = diff >= 0 ? as[j][4 * g4 + i] * dtab[diff >= 0 ? diff : 0] : 0.f; }
                u32x2 wv; wv.x = cvtpk(pv[0], pv[1]); wv.y = cvtpk(pv[2], pv[3]);
                *(RLAS u32x2*)(r0 + sw_off(q, 4 * kb + g4) + 8 * hi) = wv; }
        }
        }
        __syncthreads();
        if (c + 1 < 16) RET_LOAD(c + 1);
        u32x4 grg[4];
        { LANE_IDX(); const int lrow = tid >> 2, seg = tid & 3; const unsigned short* gp = PROJ + (grow + lrow) * INW + PC_RG + h * 128 + 32 * seg;
#pragma unroll
          for (int i = 0; i < 4; ++i) grg[i] = RET_LDNT((const RGAS u32x4*)(gp + 8 * i)); }
        { LANE_IDX();
#pragma unroll 2
        for (int ks = 0; ks < 8; ++ks) if (ks < 2 * qi + 2) {
            const bf16x8 bp = ld_row(r0, 32 * qi + l31, 2 * ks + hi);
#pragma unroll
            for (int j = 0; j < 2; ++j) { const bf16x8 a = ld_tr(r2, 16 * ks, 4 * (2 * pb + j), lane); ao[j] = RMFMA(a, bp, ao[j]); }
        }
#pragma unroll
        for (int j = 0; j < 2; ++j)
#pragma unroll
            for (int r = 0; r < 16; ++r) st[j][r] *= cd;
#pragma unroll 2
        for (int ks = 0; ks < 8; ++ks) {
            const bf16x8 ak = ld_tr(r1, 16 * ks, 4 * qi, lane);
            float kf[8];
            const f32x4r d0 = *(const RLAS f32x4r*)(dtab + 120 - 16 * ks - 8 * hi), d1 = *(const RLAS f32x4r*)(dtab + 124 - 16 * ks - 8 * hi);
            const float dk[8] = {d1[3], d1[2], d1[1], d1[0], d0[3], d0[2], d0[1], d0[0]};
#pragma unroll
            for (int i = 0; i < 8; ++i) kf[i] = __uint_as_float((unsigned)(unsigned short)ak[i] << 16) * dk[i];
            u32x4 aw; aw.x = cvtpk(kf[0], kf[1]); aw.y = cvtpk(kf[2], kf[3]); aw.z = cvtpk(kf[4], kf[5]); aw.w = cvtpk(kf[6], kf[7]);
            const bf16x8 a = __builtin_bit_cast(bf16x8, aw);
#pragma unroll
            for (int j = 0; j < 2; ++j) { const bf16x8 bv = ld_tr(r2, 16 * ks, 4 * (2 * pb + j), lane); st[j] = RMFMA(a, bv, st[j]); }
        }
        }
        __syncthreads();
        { LANE_IDX();
#pragma unroll
        for (int j = 0; j < 2; ++j) { const int eb = 2 * pb + j;
#pragma unroll
            for (int g4 = 0; g4 < 4; ++g4) {
                u32x2 wo; wo.x = cvtpk(ao[j][4 * g4 + 0], ao[j][4 * g4 + 1]); wo.y = cvtpk(ao[j][4 * g4 + 2], ao[j][4 * g4 + 3]);
                *(RLAS u32x2*)(r1 + sw_off(32 * qi + l31, 4 * eb + g4) + 8 * hi) = wo;
                u32x2 ws; ws.x = cvtpk(st[j][4 * g4 + 0], st[j][4 * g4 + 1]); ws.y = cvtpk(st[j][4 * g4 + 2], st[j][4 * g4 + 3]);
                *(RLAS u32x2*)(r3 + sw_off(32 * eb + l31, 4 * qi + g4) + 8 * hi) = ws; }
        }
        }
        __syncthreads();
        {
            LANE_IDX(); const int lrow = tid >> 2, seg = tid & 3; float o[32]; float sq = 0.f;
#pragma unroll
            for (int i = 0; i < 4; ++i) { const u32x4 v = *(const RLAS u32x4*)(r1 + sw_off(lrow, 4 * seg + i));
                o[8 * i + 0] = bflo(v.x); o[8 * i + 1] = bfhi(v.x); o[8 * i + 2] = bflo(v.y); o[8 * i + 3] = bfhi(v.y); o[8 * i + 4] = bflo(v.z); o[8 * i + 5] = bfhi(v.z); o[8 * i + 6] = bflo(v.w); o[8 * i + 7] = bfhi(v.w); }
#pragma unroll
            for (int i = 0; i < 32; ++i) sq += o[i] * o[i];
            sq += __shfl_xor(sq, 1); sq += __shfl_xor(sq, 2);
            const float rn = 1.0f / sqrtf(sq * (1.0f / 128.0f) + 1e-6f);
            unsigned short* op = MIX + (grow + lrow) * OP + h * 128 + 32 * seg;
#pragma unroll
            for (int i = 0; i < 4; ++i) { const u32x4 gr = grg[i];
                const float gg[8] = {bflo(gr.x), bfhi(gr.x), bflo(gr.y), bfhi(gr.y), bflo(gr.z), bfhi(gr.z), bflo(gr.w), bfhi(gr.w)};
                float y[8];
#pragma unroll
                for (int k = 0; k < 8; ++k) { const float g1 = gg[k]; const float sg = g1 * __builtin_amdgcn_rcpf(1.0f + __builtin_amdgcn_exp2f(-1.4426950408889634f * g1)); y[k] = o[8 * i + k] * rn * sg * betas[32 * seg + 8 * i + k]; }
#if RET_OUT_FP8
                { u32x2 w8; w8.x = pg8::pk4_fp8(y[0], y[1], y[2], y[3]); w8.y = pg8::pk4_fp8(y[4], y[5], y[6], y[7]);
                  MIX_STNT(w8, (__attribute__((address_space(1))) u32x2*)((unsigned char*)MIX + (grow + lrow) * OP + h * 128 + 32 * seg + 8 * i)); }
                if (i == 1) __builtin_amdgcn_sched_barrier(0); }
#else
                u32x4 wv; wv.x = cvtpk(y[0], y[1]); wv.y = cvtpk(y[2], y[3]); wv.z = cvtpk(y[4], y[5]); wv.w = cvtpk(y[6], y[7]);
                *(u32x4*)(op + 8 * i) = wv;
                if (i == 1) __builtin_amdgcn_sched_barrier(0); }
#endif
        }
        __syncthreads();
    }
}
#undef RET_LOAD
#undef LANE_IDX
#undef RMFMA
#undef OPQ1
#undef OPQ2
#undef RLAS
}
#define GAS __attribute__((address_space(1)))
#define LAS __attribute__((address_space(3)))
typedef unsigned short bf16;
typedef unsigned v4u __attribute__((ext_vector_type(4)));
typedef float f32x4 __attribute__((ext_vector_type(4)));
typedef short bf16x8 __attribute__((ext_vector_type(8)));
typedef GAS unsigned gu32;
typedef GAS unsigned long long gu64;
#define RLX_AGENT __ATOMIC_RELAXED, __HIP_MEMORY_SCOPE_AGENT
#define LDS_WAIT() asm volatile("s_waitcnt lgkmcnt(0)" ::: "memory")
#define VM_WAIT() asm volatile("s_waitcnt vmcnt(0)" ::: "memory")
__device__ __forceinline__ unsigned long long rt() { return __builtin_amdgcn_s_memrealtime(); }
__device__ __forceinline__ unsigned f2bf(float f) { unsigned u = __builtin_bit_cast(unsigned, f); return (u + 0x7fffu + ((u >> 16) & 1u)) >> 16; }
__device__ __forceinline__ unsigned pk2(float lo, float hi) { return f2bf(lo) | (f2bf(hi) << 16); }

#define XB_TMO      128
#define XB_XCNT(j)  (256  + 64 * (j))
#define XB_XSUB(j)  (1280 + 64 * (j))
#define XB_XGEN(j)  (2304 + 64 * (j))
#define XB_TOP      3328
#define XB_TOPGEN   3392
#define XCD_BAR_WORDS 3456
#define XB_SPIN_CAP (1u << 18)

__device__ __forceinline__ unsigned xb_ld(unsigned* p)              { return __hip_atomic_load(p, __ATOMIC_RELAXED, __HIP_MEMORY_SCOPE_AGENT); }
__device__ __forceinline__ unsigned xb_add(unsigned* p, unsigned v) { return __hip_atomic_fetch_add(p, v, __ATOMIC_RELAXED, __HIP_MEMORY_SCOPE_AGENT); }
__device__ __forceinline__ unsigned xb_xcc_id() { return (unsigned)__builtin_amdgcn_s_getreg((3 << 11) | 20) & 0xFu; }
#define XB_SPIN(cond, bar) do { unsigned _sp = 0; while (cond) { __builtin_amdgcn_s_sleep(1); \
    if ((++_sp & 255u) == 0u) { if (xb_ld(&(bar)[XB_TMO])) break; if (_sp > XB_SPIN_CAP) { atomicAdd(&(bar)[XB_TMO], 1u); break; } } } } while (0)

struct XcdBarrier {
    unsigned* bar; unsigned x;
    bool t0;
    volatile LAS unsigned* st;
};

__device__ __forceinline__ XcdBarrier xcd_barrier_post(unsigned* bar, volatile LAS unsigned* st) {
    XcdBarrier b; b.bar = bar; b.x = xb_xcc_id(); b.st = st; b.t0 = (threadIdx.x == 0);
    if (b.t0) (void)xb_add(&bar[XB_XCNT(b.x)], 1u);
    return b;
}
__device__ __forceinline__ void xcd_barrier_complete(unsigned* bar, unsigned x, unsigned& nloc, unsigned& nx) {
    const unsigned G = gridDim.x * gridDim.y * gridDim.z;
    unsigned sum, cnt, mine, sp = 0u;
    for (;;) {
        sum = 0u; cnt = 0u; mine = 0u;
#pragma unroll
        for (unsigned j = 0; j < 16; ++j) { const unsigned c = xb_ld(&bar[XB_XCNT(j)]); sum += c; cnt += (c > 0u) ? 1u : 0u; mine = (j == x) ? c : mine; }
        if (sum == G) break;
        __builtin_amdgcn_s_sleep(1);
        if ((++sp & 255u) == 0u) { if (xb_ld(&bar[XB_TMO])) break; if (sp > XB_SPIN_CAP) { atomicAdd(&bar[XB_TMO], 1u); break; } }
    }
    nloc = mine > 0u ? mine : 1u; nx = cnt > 0u ? cnt : 1u;
}

__device__ __forceinline__ void xcd_barrier(const XcdBarrier& b) {
    asm volatile("s_waitcnt vmcnt(0)" ::: "memory");
    __syncthreads();
    if (b.t0) {
        unsigned* bar = b.bar;
        __builtin_amdgcn_s_waitcnt(0);
        unsigned nloc = b.st[0], nx = b.st[1];
        if (nloc == 0u) { xcd_barrier_complete(bar, b.x, nloc, nx); b.st[0] = nloc; b.st[1] = nx; }
        const unsigned old = xb_add(&bar[XB_XSUB(b.x)], 1u);
        const unsigned gen = old / nloc;
        if (old + 1u == (gen + 1u) * nloc) {
            __builtin_amdgcn_fence(__ATOMIC_RELEASE, "agent");
            asm volatile("s_waitcnt vmcnt(0)" ::: "memory");
            const unsigned og = xb_add(&bar[XB_TOP], 1u);
            const unsigned tg = og / nx;
            if (og + 1u == (tg + 1u) * nx) xb_add(&bar[XB_TOPGEN], 1u);
            else XB_SPIN(xb_ld(&bar[XB_TOPGEN]) == tg, bar);
            __builtin_amdgcn_fence(__ATOMIC_ACQUIRE, "agent");
            xb_add(&bar[XB_XGEN(b.x)], 1u);
            asm volatile("s_waitcnt vmcnt(0)" ::: "memory");
        } else {
            XB_SPIN(xb_ld(&bar[XB_XGEN(b.x)]) == gen, bar);
            __builtin_amdgcn_fence(__ATOMIC_ACQUIRE, "agent");
            asm volatile("s_waitcnt vmcnt(0)" ::: "memory");
        }
    }
    __syncthreads();
}

#define LB_SUB(j) (64 * (j))
#define LB_GEN(j) (1024 + 64 * (j))
#define LB_WORDS 2048
__device__ __forceinline__ void xcc_local_barrier(const XcdBarrier& b, unsigned* lbar) {
    asm volatile("s_waitcnt vmcnt(0)" ::: "memory");
    __syncthreads();
    if (b.t0) {
        __builtin_amdgcn_s_waitcnt(0);
        unsigned nloc = b.st[0]; if (nloc == 0u) nloc = 1u;
        const unsigned old = xb_add(&lbar[LB_SUB(b.x)], 1u);
        const unsigned gen = old / nloc;
        if (old + 1u == (gen + 1u) * nloc) xb_add(&lbar[LB_GEN(b.x)], 1u);
        else XB_SPIN(xb_ld(&lbar[LB_GEN(b.x)]) == gen, b.bar);
        __builtin_amdgcn_fence(__ATOMIC_ACQUIRE, "agent");
        asm volatile("s_waitcnt vmcnt(0)" ::: "memory");
    }
    __syncthreads();
}

#ifndef PG8_SP2
#define PG8_SP2 true
#endif
#ifndef PG8_ALIGN
#define PG8_ALIGN true
#endif
#ifndef MK_DUP
#define MK_DUP (-1)
#endif
#ifndef MK_FP8
#define MK_FP8 1
#endif
#ifndef MK_FP8_P1
#define MK_FP8_P1 1
#endif
#ifndef MK_FP8_P2
#define MK_FP8_P2 1
#endif
#ifndef MK_STAGGER
#define MK_STAGGER 0
#endif
#ifndef MK_FP8_WIN
#define MK_FP8_WIN 0
#endif
#ifndef MK_LOCAL_BAR
#define MK_LOCAL_BAR 0
#endif
#ifndef MK_XSTAG_TICKS
#define MK_XSTAG_TICKS 0
#endif
#ifndef MK_PER_PHASE
#define MK_PER_PHASE 0
#endif

constexpr int NWAVES = 8;
constexpr int BATCH = 32, SEQ = 2048, D = 1024, M = BATCH * SEQ;
static_assert(pg8::SS_M == M, "row-statistics pitch");
constexpr int FF = 2816, INW = 3584;
constexpr int RH = 4, RD = 128, AH = 8, AD = 64, NBLK = 8, BLK = 256;
constexpr int PC_RQ = 0, PC_RK = 512, PC_RV = 1024, PC_RG = 1536, PC_AQ = 2048, PC_AK = 2560, PC_AV = 3072;
constexpr float EPS = 1e-6f;
constexpr float C2 = 0.125f * 1.4426950408889634f;
constexpr int N_PHASES = 10;

constexpr size_t MiB = 1u << 20;
constexpr size_t WS_CTL = 0, CTL_ZERO_BYTES = 1 * MiB;
constexpr size_t WS_W1A = 2 * MiB, WS_WD1 = 14 * MiB, WS_WIN = 20 * MiB, WS_WOUT = 27 * MiB, WS_W2A = 29 * MiB, WS_WD2 = 40 * MiB;
constexpr size_t WS_ROPE_R = 46 * MiB, WS_ROPE_A = 47 * MiB, WS_KMEAN = 47 * MiB + 512 * 1024, WS_RS0 = 48 * MiB, WS_SS1 = 49 * MiB, WS_SS2 = 53 * MiB;
constexpr size_t WS_XB = 64 * MiB, WS_MIX = 192 * MiB, WS_BIG = 320 * MiB, WS_XB8 = 768 * MiB, WS_END = 832 * MiB;
static_assert(WS_W1A + (size_t)2 * FF * D * 2 <= WS_WD1 && WS_WD1 + (size_t)D * FF * 2 <= WS_WIN && WS_WIN + (size_t)INW * D * 2 <= WS_WOUT && WS_WOUT + (size_t)D * D * 2 <= WS_W2A &&
              WS_W2A + (size_t)2 * FF * D * 2 <= WS_WD2 && WS_WD2 + (size_t)D * FF * 2 <= WS_ROPE_R && WS_ROPE_R + (size_t)SEQ * 64 * 8 <= WS_ROPE_A && WS_ROPE_A + (size_t)SEQ * 8 * 8 <= WS_KMEAN &&
              WS_KMEAN + (size_t)BATCH * AH * NBLK * AD * 4 <= WS_RS0 && WS_RS0 + (size_t)M * 4 <= WS_SS1 && WS_SS1 + (size_t)M * 64 <= WS_SS2 && WS_SS2 + (size_t)M * 64 <= WS_XB &&
              WS_XB + (size_t)M * D * 2 <= WS_MIX && WS_MIX + (size_t)M * D * 2 <= WS_BIG && WS_BIG + (size_t)M * INW * 2 <= WS_XB8 && WS_XB8 + (size_t)M * D <= WS_END, "d_ws map");
constexpr int CW_TMO = 0, CW_CODE = 1;
constexpr int CW_BAR = 4096, CW_LBAR = 8192, CW_XTAB = 12288;

constexpr int RING_OFF = 0, RING_BYTES = 131072;
constexpr int LDSCTL_OFF = RING_BYTES, MISC_OFF = LDSCTL_OFF + 320;
constexpr int LDS_BYTES = 155648;
constexpr int TB_OFF = 136192;
constexpr int RTAB_OFF = 132096;
static_assert(MISC_OFF + 128 <= RTAB_OFF && RTAB_OFF + 4 * 256 * 4 <= TB_OFF && TB_OFF + 8 * 2304 <= LDS_BYTES, "LDS map");


typedef float f32x2 __attribute__((ext_vector_type(2)));
struct Frame {
    LAS unsigned char* lds;
    volatile LAS unsigned* MISC;
    gu32* ctl;
    int tid, lane, wave;
    int vcu, G;
    const float* x; float* out;
    bf16 *W1A, *WD1, *WIN, *WOUT, *W2A, *WD2;
    bf16 *XB, *MIXB, *HB, *PROJ;
    unsigned char *XB8, *H8, *W2A8, *WD28, *WIN8;
    f32x2 *ROPE_R, *ROPE_A;
    float *KMEAN, *RS0, *SS1, *SS2;
};
__device__ __forceinline__ float bf_lo(unsigned u) { return __uint_as_float(u << 16); }
__device__ __forceinline__ float bf_hi(unsigned u) { return __uint_as_float(u & 0xffff0000u); }
__device__ __forceinline__ void unpack8(const v4u r, float (&x)[8]) { x[0] = bf_lo(r.x); x[1] = bf_hi(r.x); x[2] = bf_lo(r.y); x[3] = bf_hi(r.y); x[4] = bf_lo(r.z); x[5] = bf_hi(r.z); x[6] = bf_lo(r.w); x[7] = bf_hi(r.w); }
__device__ __forceinline__ v4u pack8(const float (&y)[8]) { v4u o; o.x = pk2(y[0], y[1]); o.y = pk2(y[2], y[3]); o.z = pk2(y[4], y[5]); o.w = pk2(y[6], y[7]); return o; }
__device__ __forceinline__ float wave_sum(float v) {
#pragma unroll
    for (int o = 1; o < 64; o <<= 1) v += __shfl_xor(v, o);
    return v;
}
__device__ __forceinline__ float silu_f(float g) { return g * __builtin_amdgcn_rcpf(1.0f + __builtin_amdgcn_exp2f(-1.4426950408889634f * g)); }

template <bool WINMAP = false> __device__ __forceinline__ void p0_transpose_item(const float* W, int K, int N, bf16* WT, int k0, int n0, int dst_row0, const float* kscale, LAS float* scr, int lane) {
    const int scol = WINMAP ? pg8::win_orig_col(n0 + (lane & 31)) : n0 + (lane & 31);
    float wv[32];
#pragma unroll
    for (int i = 0; i < 32; ++i) wv[i] = P0_LDNT((const GAS float*)W + (size_t)(k0 + 2 * i + (lane >> 5)) * N + scol);
#pragma unroll
    for (int i = 0; i < 32; ++i) { const int kk = 2 * i + (lane >> 5); const float sc = kscale ? kscale[k0 + kk] : 1.0f; scr[kk * 33 + (lane & 31)] = wv[i] * sc; }
    LDS_WAIT(); asm volatile("" ::: "memory");
    const int c = lane & 7;
#pragma unroll
    for (int j = 0; j < 4; ++j) { const int n = (lane >> 3) + 8 * j; const LAS float* s = scr + (8 * c) * 33 + n;
        v4u o; o.x = pk2(s[0 * 33], s[1 * 33]); o.y = pk2(s[2 * 33], s[3 * 33]); o.z = pk2(s[4 * 33], s[5 * 33]); o.w = pk2(s[6 * 33], s[7 * 33]);
        P0_STNT(o, (GAS v4u*)(WT + (size_t)(dst_row0 + n) * K + k0 + 8 * c)); }
    LDS_WAIT(); asm volatile("" ::: "memory");
}
template <bool WINMAP = false> __device__ __forceinline__ void p0_transpose_item_f8(const float* W, int K, int N, unsigned char* WT, int k0, int n0, int dst_row0, const float* kscale, float mul, LAS float* scr, int lane) {
    const int scol = WINMAP ? pg8::win_orig_col(n0 + (lane & 31)) : n0 + (lane & 31);
    float wv[32];
#pragma unroll
    for (int i = 0; i < 32; ++i) wv[i] = P0_LDNT((const GAS float*)W + (size_t)(k0 + 2 * i + (lane >> 5)) * N + scol);
#pragma unroll
    for (int i = 0; i < 32; ++i) { const int kk = 2 * i + (lane >> 5); const float sc = (kscale ? kscale[k0 + kk] : 1.0f) * mul; scr[kk * 33 + (lane & 31)] = wv[i] * sc; }
    LDS_WAIT(); asm volatile("" ::: "memory");
    const int c = lane & 7;
#pragma unroll
    for (int j = 0; j < 4; ++j) { const int n = (lane >> 3) + 8 * j; const LAS float* s = scr + (8 * c) * 33 + n;
        pg8::u32x2 o; o.x = pg8::pk4_fp8(s[0 * 33], s[1 * 33], s[2 * 33], s[3 * 33]); o.y = pg8::pk4_fp8(s[4 * 33], s[5 * 33], s[6 * 33], s[7 * 33]);
        P0_STNT(o, (GAS pg8::u32x2*)(WT + (size_t)(dst_row0 + n) * K + k0 + 8 * c)); }
    LDS_WAIT(); asm volatile("" ::: "memory");
}
__device__ __forceinline__ void x_row_to_bf16(Frame& F, const float* xrow, bf16* orow, float* rs) {
    const GAS f32x4* xr = (const GAS f32x4*)xrow + F.lane;
    f32x4 v[4]; float s = 0.f;
#pragma unroll
    for (int j = 0; j < 4; ++j) { v[j] = xr[64 * j]; s += (v[j].x * v[j].x + v[j].y * v[j].y) + (v[j].z * v[j].z + v[j].w * v[j].w); }
    const float tot = wave_sum(s);
    if (F.lane == 0) *rs = 1.0f / sqrtf(tot * (1.f / D) + EPS);
    GAS unsigned long long* o8 = (GAS unsigned long long*)orow + F.lane;
#pragma unroll
    for (int j = 0; j < 4; ++j) o8[64 * j] = (unsigned long long)pk2(v[j].x, v[j].y) | ((unsigned long long)pk2(v[j].z, v[j].w) << 32);
}
__device__ __forceinline__ void x_rows2_to_bf16(Frame& F, const float* xrow, bf16* orow, float* rs, size_t estride, int rstride, unsigned char* o8row = nullptr) {
    const GAS f32x4* xr = (const GAS f32x4*)xrow + F.lane; const GAS f32x4* xr2 = (const GAS f32x4*)(xrow + estride) + F.lane;
    f32x4 v[4], v2[4]; float s = 0.f, s2 = 0.f;
#pragma unroll
    for (int j = 0; j < 4; ++j) { v[j] = P0_LDNT(xr + 64 * j); v2[j] = P0_LDNT(xr2 + 64 * j); }
#pragma unroll
    for (int j = 0; j < 4; ++j) { s += (v[j].x * v[j].x + v[j].y * v[j].y) + (v[j].z * v[j].z + v[j].w * v[j].w); s2 += (v2[j].x * v2[j].x + v2[j].y * v2[j].y) + (v2[j].z * v2[j].z + v2[j].w * v2[j].w); }
    const float tot = wave_sum(s), tot2 = wave_sum(s2);
    if (F.lane == 0) { rs[0] = 1.0f / sqrtf(tot * (1.f / D) + EPS); rs[rstride] = 1.0f / sqrtf(tot2 * (1.f / D) + EPS); }
    GAS unsigned long long* o8 = (GAS unsigned long long*)orow + F.lane; GAS unsigned long long* o82 = (GAS unsigned long long*)(orow + estride) + F.lane;
    if (MK_FP8_P1) {
        GAS unsigned* q8 = (GAS unsigned*)o8row + F.lane; GAS unsigned* q82 = (GAS unsigned*)(o8row + estride) + F.lane;
#pragma unroll
        for (int j = 0; j < 4; ++j) { q8[64 * j] = pg8::pk4_fp8(v[j].x, v[j].y, v[j].z, v[j].w); q82[64 * j] = pg8::pk4_fp8(v2[j].x, v2[j].y, v2[j].z, v2[j].w); }
    }
#pragma unroll
    for (int j = 0; j < 4; ++j) { P0_STNT((unsigned long long)pk2(v[j].x, v[j].y) | ((unsigned long long)pk2(v[j].z, v[j].w) << 32), o8 + 64 * j); P0_STNT((unsigned long long)pk2(v2[j].x, v2[j].y) | ((unsigned long long)pk2(v2[j].z, v2[j].w) << 32), o82 + 64 * j); }
}
struct Args { const float* in[16]; float* out; unsigned char* ws; float invf_r[64]; float invf_a[8]; int ph_lo, ph_hi, li, pad; };
__device__ __forceinline__ void p0_prologue(Frame& F, const Args& args) {
    LAS float* scr = (LAS float*)(F.lds + RING_OFF + F.wave * 16384);
    const int gw = F.vcu * NWAVES + F.wave, NGW = F.G * NWAVES;
    constexpr int I_GU = (D / 64) * (FF / 32), I_DN = (FF / 64) * (D / 32), I_IN = (D / 64) * (INW / 32), I_OUT = (D / 64) * (D / 32);
    constexpr int NITEMS = 2 * (2 * I_GU + I_DN) + I_IN + I_OUT;
    for (int it = gw; it < NITEMS; it += NGW) {
        int r = it;
#pragma unroll
        for (int f = 0; f < 2; ++f) {
            const float* nw = args.in[f == 0 ? 1 : 12]; const float* wg = args.in[f == 0 ? 2 : 13]; const float* wu = args.in[f == 0 ? 3 : 14]; const float* wd = args.in[f == 0 ? 4 : 15];
            bf16* WA = f == 0 ? F.W1A : F.W2A; bf16* WD = f == 0 ? F.WD1 : F.WD2;
            if (r >= 0 && r < I_GU) { const int nblk = FF / 32, kb = r / nblk, nb = r % nblk, n0 = 32 * nb; const int dr = 256 * (n0 / 128) + (n0 % 128);
                if (f == 1 && MK_FP8) p0_transpose_item_f8(wg, D, FF, F.W2A8, 64 * kb, n0, dr, nw, pg8::W8_SCALE, scr, F.lane); else if (f == 0 && MK_FP8_P1) p0_transpose_item_f8(wg, D, FF, (unsigned char*)F.W1A, 64 * kb, n0, dr, nw, pg8::W8_SCALE, scr, F.lane); else p0_transpose_item(wg, D, FF, WA, 64 * kb, n0, dr, nw, scr, F.lane); r = -1; } else if (r >= 0) r -= I_GU;
            if (r >= 0 && r < I_GU) { const int nblk = FF / 32, kb = r / nblk, nb = r % nblk, n0 = 32 * nb; const int dr = 256 * (n0 / 128) + 128 + (n0 % 128);
                if (f == 1 && MK_FP8) p0_transpose_item_f8(wu, D, FF, F.W2A8, 64 * kb, n0, dr, nw, pg8::W8_SCALE, scr, F.lane); else if (f == 0 && MK_FP8_P1) p0_transpose_item_f8(wu, D, FF, (unsigned char*)F.W1A, 64 * kb, n0, dr, nw, pg8::W8_SCALE, scr, F.lane); else p0_transpose_item(wu, D, FF, WA, 64 * kb, n0, dr, nw, scr, F.lane); r = -1; } else if (r >= 0) r -= I_GU;
            if (r >= 0 && r < I_DN) { const int nblk = D / 32, kb = r / nblk, nb = r % nblk, n0 = 32 * nb;
                if (f == 1 && MK_FP8) p0_transpose_item_f8(wd, FF, D, F.WD28, 64 * kb, n0, n0, nullptr, pg8::W8_SCALE, scr, F.lane); else if (f == 0 && MK_FP8_P2) p0_transpose_item_f8(wd, FF, D, (unsigned char*)F.WD1, 64 * kb, n0, n0, nullptr, pg8::W8_SCALE, scr, F.lane); else p0_transpose_item(wd, FF, D, WD, 64 * kb, n0, n0, nullptr, scr, F.lane); r = -1; } else if (r >= 0) r -= I_DN;
        }
        if (r >= 0 && r < I_IN) { const int nblk = INW / 32, kb = r / nblk, nb = r % nblk, n0 = 32 * nb, tile = n0 >> 8;
            if (MK_FP8_WIN == 2) {
                if (tile == 4 || tile == 5 || tile == 12 || tile == 13) p0_transpose_item_f8<true>(args.in[6], D, INW, F.WIN8, 64 * kb, n0, (tile < 8 ? tile - 4 : tile - 10) * 256 + (n0 & 255), args.in[5], pg8::W8_SCALE, scr, F.lane);
                else p0_transpose_item<true>(args.in[6], D, INW, F.WIN + 524288, 64 * kb, n0, (tile < 4 ? tile : tile - 2) * 256 + (n0 & 255), args.in[5], scr, F.lane);
            } else
            if (MK_FP8_WIN && (tile < 8 || tile >= 12)) p0_transpose_item_f8<true>(args.in[6], D, INW, F.WIN8, 64 * kb, n0, tile < 8 ? n0 : n0 - 1024, args.in[5], pg8::W8_SCALE, scr, F.lane);
            else p0_transpose_item<true>(args.in[6], D, INW, F.WIN, 64 * kb, n0, n0, args.in[5], scr, F.lane);
            r = -1; } else if (r >= 0) r -= I_IN;
        if (r >= 0 && r < I_OUT) { const int nblk = D / 32, kb = r / nblk, nb = r % nblk, n0 = 32 * nb;
            if (MK_FP8_WOUT) p0_transpose_item_f8(args.in[11], D, D, (unsigned char*)F.WOUT, 64 * kb, n0, n0, nullptr, pg8::W8_SCALE, scr, F.lane); else p0_transpose_item(args.in[11], D, D, F.WOUT, 64 * kb, n0, n0, nullptr, scr, F.lane); r = -1; }
    }
    if (M % (2 * NGW) == 0) { for (int m = gw; m < M; m += 2 * NGW) x_rows2_to_bf16(F, F.x + (size_t)m * D, F.XB + (size_t)m * D, F.RS0 + m, (size_t)NGW * D, NGW, F.XB8 + (size_t)m * D); }
    else { for (int m = gw; m < M; m += NGW) x_row_to_bf16(F, F.x + (size_t)m * D, F.XB + (size_t)m * D, F.RS0 + m); }
    const int gt = F.vcu * (NWAVES * 64) + F.tid, NGT = F.G * NWAVES * 64;
    for (int idx = gt; idx < BATCH * AH * NBLK * AD; idx += NGT) F.KMEAN[idx] = 0.f;
    for (int idx = gt; idx < SEQ * 72; idx += NGT) {
        const int pos = idx / 72, i = idx % 72;
        float invf = 0.f;
#pragma unroll
        for (int k = 0; k < 64; ++k) invf = (i == k) ? args.invf_r[k] : invf;
#pragma unroll
        for (int k = 0; k < 8; ++k) invf = (i == 64 + k) ? args.invf_a[k] : invf;
        const float ang = (float)pos * invf;
        double rv = (double)ang * 0.15915494309189535; rv -= floor(rv);
        const float a = (float)(rv * 6.283185307179586);
        f32x2 cs; cs.x = cosf(a); cs.y = sinf(a);
        if (i < 64) F.ROPE_R[pos * 64 + i] = cs; else F.ROPE_A[pos * 8 + (i - 64)] = cs;
    }
}

__global__ void __launch_bounds__(NWAVES * 64, 2) mk_fwd(Args args) {
    __shared__ __attribute__((aligned(16))) unsigned char lds[LDS_BYTES];
    Frame F;
    F.lds = (LAS unsigned char*)lds;
    F.MISC = (volatile LAS unsigned*)(F.lds + MISC_OFF);
    F.wave = __builtin_amdgcn_readfirstlane((int)threadIdx.x >> 6); F.lane = mk_lane(); F.tid = F.wave * 64 + F.lane;
    F.G = gridDim.x; { const int bx = blockIdx.x; F.vcu = (F.G % 8 == 0) ? (bx % 8) * (F.G / 8) + bx / 8 : bx; }
    unsigned char* ws = args.ws;
    F.ctl = (gu32*)(ws + WS_CTL);
    F.x = args.in[0]; F.out = args.out;
#define FRAME_PTRS() do { unsigned char* ws = args.ws; asm volatile("" : "+s"(ws)); F.lane = mk_lane(); F.tid = F.wave * 64 + F.lane; \
    F.W1A = (bf16*)(ws + WS_W1A); F.WD1 = (bf16*)(ws + WS_WD1); F.WIN = (bf16*)(ws + WS_WIN); F.WOUT = (bf16*)(ws + WS_WOUT); F.W2A = (bf16*)(ws + WS_W2A); F.WD2 = (bf16*)(ws + WS_WD2); \
    F.XB8 = ws + WS_XB8; F.H8 = ws + WS_BIG; F.W2A8 = ws + WS_W2A; F.WD28 = ws + WS_WD2; F.WIN8 = ws + WS_WIN; \
    F.XB = (bf16*)(ws + WS_XB); F.MIXB = (bf16*)(ws + WS_MIX); F.HB = (bf16*)(ws + WS_BIG); F.PROJ = (bf16*)(ws + WS_BIG); \
    F.ROPE_R = (f32x2*)(ws + WS_ROPE_R); F.ROPE_A = (f32x2*)(ws + WS_ROPE_A); \
    F.KMEAN = (float*)(ws + WS_KMEAN); F.RS0 = (float*)(ws + WS_RS0); F.SS1 = (float*)(ws + WS_SS1); F.SS2 = (float*)(ws + WS_SS2); } while (0)
    FRAME_PTRS();
    for (int u = F.tid; u < (LDS_BYTES - LDSCTL_OFF) / 4; u += NWAVES * 64) ((LAS unsigned*)(F.lds + LDSCTL_OFF))[u] = 0u;
    __syncthreads();
    XcdBarrier bar; bar.bar = (unsigned*)(F.ctl + CW_BAR); bar.x = 0; bar.st = nullptr; bar.t0 = false;
    if (!MK_PER_PHASE) bar = xcd_barrier_post((unsigned*)(F.ctl + CW_BAR), F.MISC + 8);
    if (!MK_PER_PHASE && MK_LOCAL_BAR && F.tid == 0) __hip_atomic_store(F.ctl + CW_XTAB + blockIdx.x, bar.x + 1u, RLX_AGENT);
#define GRID_BAR() do { if (!MK_PER_PHASE) { unsigned char* w_ = args.ws; asm volatile("" : "+s"(w_)); XcdBarrier b_; b_.bar = (unsigned*)w_ + CW_BAR; b_.x = xb_xcc_id(); b_.st = F.MISC + 8; b_.t0 = (F.wave == 0) && (mk_lane() == 0); \
        if (MK_LOCAL_BAR && F.MISC[12] != 0u) xcc_local_barrier(b_, (unsigned*)w_ + CW_LBAR); else xcd_barrier(b_); } } while (0)
#ifndef MK_STAG4
#define MK_STAG4 0
#endif
#ifndef MK_STAG7
#define MK_STAG7 750
#endif
#ifndef MK_STAG9
#define MK_STAG9 1400
#endif
#define STAGGER4(ticks) do { const unsigned long long w_ = (unsigned long long)(ticks) * (MK_STAG4 == 1 ? (blockIdx.x & 3) : (MK_STAG4 == 2 ? ((blockIdx.x >> 3) & 1) : 0)); if (w_) { const unsigned long long t0_ = rt(); while (rt() - t0_ < w_) __builtin_amdgcn_s_sleep(8); } } while (0)
#define STAGGER(ticks) do { if (MK_STAGGER && (F.vcu & 1)) { const unsigned long long t0_ = rt(); while (rt() - t0_ < (unsigned long long)(ticks)) __builtin_amdgcn_s_sleep(8); } } while (0)
    const int lo = args.ph_lo, hi = args.ph_hi;
#define IN(k) (lo <= (k) && (k) < hi)
#define BOTH(k) (IN(k) && IN((k) + 1))

#if MK_DUP == 0
    if (IN(0)) { FRAME_PTRS(); p0_prologue(F, args); GRID_BAR(); }
#endif
    if (IN(0)) { FRAME_PTRS(); p0_prologue(F, args); if (BOTH(0)) GRID_BAR(); }
    if (!MK_PER_PHASE && MK_LOCAL_BAR && IN(0) && BOTH(0)) {
        bool ok = true;
        if (F.tid < F.G) { const unsigned v = __hip_atomic_load(F.ctl + CW_XTAB + F.tid, RLX_AGENT), r0 = __hip_atomic_load(F.ctl + CW_XTAB + (F.tid & 7), RLX_AGENT); ok = (v != 0u) && (v == r0); }
        const bool local_ok = (__syncthreads_and(ok ? 1 : 0) != 0) && F.G == 256;
        if (F.tid == 0) F.MISC[12] = local_ok ? 1u : 0u;
        __syncthreads();
        if (local_ok && MK_XSTAG_TICKS > 0) { const unsigned long long t0_ = rt(), w_ = (unsigned long long)MK_XSTAG_TICKS * (blockIdx.x & 7); while (rt() - t0_ < w_) __builtin_amdgcn_s_sleep(8); }
    }

#if MK_DUP == 1
    if (IN(1)) { FRAME_PTRS();
#if MK_FP8_P1
        pg8::Gemm g{(const pg8::bf16_t*)F.XB8, (const pg8::bf16_t*)F.W1A, M, 2 * FF, D}; pg8::StaticOrder S; S.init(M, 2 * FF, F.G, (int)blockIdx.x);
#else
        pg8::Gemm g{F.XB, F.W1A, M, 2 * FF, D}; pg8::StaticOrder S; S.init(M, 2 * FF, F.G, (int)blockIdx.x);
#endif
        const pg8::RTab rt_ = pg8::fill_rstd_table<false>((LAS float*)(F.lds + RTAB_OFF), S, F.RS0, F.tid);
        pg8::EpiSwiGLU<false, MK_FP8_P1 != 0, true, MK_FP8_P2 != 0> E{F.HB, FF, F.RS0, rt_};
        pg8::gemm_phase<pg8::EpiSwiGLU<false, MK_FP8_P1 != 0, true, MK_FP8_P2 != 0>, pg8::StaticOrder, PG8_ALIGN, PG8_SP2, MK_FP8_P1 != 0>(F.lds + RING_OFF, g, S, E, F.wave);
        GRID_BAR();
    }
#endif
    if (IN(1)) { FRAME_PTRS(); STAGGER(1300);
#if MK_FP8_P1
        pg8::Gemm g{(const pg8::bf16_t*)F.XB8, (const pg8::bf16_t*)F.W1A, M, 2 * FF, D}; pg8::StaticOrder S; S.init(M, 2 * FF, F.G, (int)blockIdx.x);
#else
        pg8::Gemm g{F.XB, F.W1A, M, 2 * FF, D}; pg8::StaticOrder S; S.init(M, 2 * FF, F.G, (int)blockIdx.x);
#endif
        const pg8::RTab rt_ = pg8::fill_rstd_table<false>((LAS float*)(F.lds + RTAB_OFF), S, F.RS0, F.tid);
        pg8::EpiSwiGLU<false, MK_FP8_P1 != 0, true, MK_FP8_P2 != 0> E{F.HB, FF, F.RS0, rt_};
        pg8::gemm_phase<pg8::EpiSwiGLU<false, MK_FP8_P1 != 0, true, MK_FP8_P2 != 0>, pg8::StaticOrder, PG8_ALIGN, PG8_SP2, MK_FP8_P1 != 0>(F.lds + RING_OFF, g, S, E, F.wave);
        if (BOTH(1)) GRID_BAR();
    }
#if MK_DUP == 2 || MK_DUP == 22
    if (IN(2)) { FRAME_PTRS();
        pg8::Gemm g{F.HB, F.WD1, M, D, FF}; pg8::StaticOrder S; S.init(M, D, F.G, (int)blockIdx.x);
#if MK_DUP == 22
        pg8::EpiNone E{};
        pg8::gemm_phase<pg8::EpiNone, pg8::StaticOrder, PG8_ALIGN, PG8_SP2, false, 2>(F.lds + RING_OFF, g, S, E, F.wave);
#else
#ifndef MK_EDBG
#define MK_EDBG 0
#endif
        pg8::EpiResid<true, false, true, 1, MK_FP8_WIN != 0> E{nullptr, F.XB, nullptr, (bf16*)(args.ws + WS_MIX), (float*)(args.ws + ((size_t)736 << 20)), args.ws + ((size_t)672 << 20), F.lds + TB_OFF + F.wave * 2304};
#if MK_FP8_P2
        pg8::gemm_phase<pg8::EpiResid<true, false, true, 2, MK_FP8_WIN != 0>, pg8::StaticOrder, PG8_ALIGN, PG8_SP2, true, 1>(F.lds + RING_OFF, g, S, E, F.wave);
#else
        pg8::gemm_phase<pg8::EpiResid<true, false, true, 1, MK_FP8_WIN != 0>, pg8::StaticOrder, PG8_ALIGN, PG8_SP2, false, 2>(F.lds + RING_OFF, g, S, E, F.wave);
#endif
#endif
        GRID_BAR();
    }
#endif
    if (IN(2)) { FRAME_PTRS();
        pg8::Gemm g{F.HB, F.WD1, M, D, FF}; pg8::StaticOrder S; S.init(M, D, F.G, (int)blockIdx.x);
#if MK_FP8_P2
        pg8::EpiResid<true, false, true, 2, MK_FP8_WIN != 0> E{nullptr, F.XB, nullptr, F.XB, F.SS1, F.XB8, F.lds + TB_OFF + F.wave * 2304};
#else
        pg8::EpiResid<true, false, true, 1, MK_FP8_WIN != 0> E{nullptr, F.XB, nullptr, F.XB, F.SS1, F.XB8, F.lds + TB_OFF + F.wave * 2304};
#endif
#if MK_FP8_P2
        pg8::gemm_phase<pg8::EpiResid<true, false, true, 2, MK_FP8_WIN != 0>, pg8::StaticOrder, PG8_ALIGN, PG8_SP2, true, 1>(F.lds + RING_OFF, g, S, E, F.wave);
#else
        pg8::gemm_phase<pg8::EpiResid<true, false, true, 1, MK_FP8_WIN != 0>, pg8::StaticOrder, PG8_ALIGN, PG8_SP2, false, 2>(F.lds + RING_OFF, g, S, E, F.wave);
#endif
        if (BOTH(2)) GRID_BAR();
    }
#if MK_DUP == 33
    if (IN(3)) { FRAME_PTRS();
        pg8::Gemm g{F.XB, F.WIN, M, INW, D}; pg8::StaticOrder S; S.init(M, INW, F.G, (int)blockIdx.x); pg8::EpiNone E{};
        pg8::gemm_phase<pg8::EpiNone, pg8::StaticOrder, PG8_ALIGN, PG8_SP2>(F.lds + RING_OFF, g, S, E, F.wave);
        GRID_BAR();
    }
#endif
#if MK_DUP == 3
    if (IN(3)) { FRAME_PTRS();
#if MK_FP8_WIN
        {   pg8::Gemm g{F.XB, F.WIN + (size_t)2048 * D, M, 1024, D}; pg8::StaticOrder S; S.init(M, 1024, F.G, (int)blockIdx.x);
            pg8::EpiProjFused<1, false> E{F.PROJ, INW, F.SS1, (const pg8::f32x4*)F.ROPE_R, (const pg8::f32x4*)F.ROPE_A, args.in[8], args.in[9], F.KMEAN, F.lds + TB_OFF + F.wave * 2304, pg8::RTab{nullptr, 0}};
            pg8::gemm_phase<pg8::EpiProjFused<1, false>, pg8::StaticOrder, PG8_ALIGN, PG8_SP2>(F.lds + RING_OFF, g, S, E, F.wave); }
        {   pg8::Gemm g{(const pg8::bf16_t*)F.XB8, (const pg8::bf16_t*)F.WIN8, M, 2560, D}; pg8::StaticOrder S; S.init(M, 2560, F.G, (int)blockIdx.x);
            const pg8::RTab rt_ = pg8::fill_rstd_table<true>((LAS float*)(F.lds + RTAB_OFF), S, F.SS1, F.tid);
            pg8::EpiProjFused<2, true> E{F.PROJ, INW, F.SS1, (const pg8::f32x4*)F.ROPE_R, (const pg8::f32x4*)F.ROPE_A, args.in[8], args.in[9], F.KMEAN, F.lds + TB_OFF + F.wave * 2304, rt_};
            pg8::gemm_phase<pg8::EpiProjFused<2, true>, pg8::StaticOrder, PG8_ALIGN, PG8_SP2, true, 1>(F.lds + RING_OFF, g, S, E, F.wave); }
#else
        pg8::Gemm g{F.XB, F.WIN, M, INW, D}; pg8::StaticOrder S; S.init(M, INW, F.G, (int)blockIdx.x);
        const pg8::RTab rt_ = pg8::fill_rstd_table<true>((LAS float*)(F.lds + RTAB_OFF), S, F.SS1, F.tid);
        pg8::EpiProjFused<0, false> E{F.PROJ, INW, F.SS1, (const pg8::f32x4*)F.ROPE_R, (const pg8::f32x4*)F.ROPE_A, args.in[8], args.in[9], F.KMEAN, F.lds + TB_OFF + F.wave * 2304, rt_};
        pg8::gemm_phase<pg8::EpiProjFused<0, false>, pg8::StaticOrder, PG8_ALIGN, PG8_SP2>(F.lds + RING_OFF, g, S, E, F.wave);
#endif
        GRID_BAR();
    }
#endif
    if (IN(3)) { FRAME_PTRS(); STAGGER(1500);
#if MK_FP8_WIN == 2
        {   pg8::Gemm g{F.XB, F.WIN + 524288, M, 2560, D}; pg8::StaticOrder S; S.init(M, 2560, F.G, (int)blockIdx.x);
            const pg8::RTab rt_ = pg8::fill_rstd_table<true>((LAS float*)(F.lds + RTAB_OFF), S, F.SS1, F.tid);
            pg8::EpiProjFused<3, false> E{F.PROJ, INW, F.SS1, (const pg8::f32x4*)F.ROPE_R, (const pg8::f32x4*)F.ROPE_A, args.in[8], args.in[9], F.KMEAN, F.lds + TB_OFF + F.wave * 2304, rt_};
            pg8::gemm_phase<pg8::EpiProjFused<3, false>, pg8::StaticOrder, PG8_ALIGN, PG8_SP2>(F.lds + RING_OFF, g, S, E, F.wave); }
        {   pg8::Gemm g{(const pg8::bf16_t*)F.XB8, (const pg8::bf16_t*)F.WIN8, M, 1024, D}; pg8::StaticOrder S; S.init(M, 1024, F.G, (int)blockIdx.x);
            const pg8::RTab rt_ = pg8::fill_rstd_table<true>((LAS float*)(F.lds + RTAB_OFF), S, F.SS1, F.tid);
            pg8::EpiProjFused<4, true> E{F.PROJ, INW, F.SS1, (const pg8::f32x4*)F.ROPE_R, (const pg8::f32x4*)F.ROPE_A, args.in[8], args.in[9], F.KMEAN, F.lds + TB_OFF + F.wave * 2304, rt_};
            pg8::gemm_phase<pg8::EpiProjFused<4, true>, pg8::StaticOrder, PG8_ALIGN, PG8_SP2, true, 1>(F.lds + RING_OFF, g, S, E, F.wave); }
#elif MK_FP8_WIN
        {   pg8::Gemm g{F.XB, F.WIN + (size_t)2048 * D, M, 1024, D}; pg8::StaticOrder S; S.init(M, 1024, F.G, (int)blockIdx.x);
            pg8::EpiProjFused<1, false> E{F.PROJ, INW, F.SS1, (const pg8::f32x4*)F.ROPE_R, (const pg8::f32x4*)F.ROPE_A, args.in[8], args.in[9], F.KMEAN, F.lds + TB_OFF + F.wave * 2304, pg8::RTab{nullptr, 0}};
            pg8::gemm_phase<pg8::EpiProjFused<1, false>, pg8::StaticOrder, PG8_ALIGN, PG8_SP2>(F.lds + RING_OFF, g, S, E, F.wave); }
        {   pg8::Gemm g{(const pg8::bf16_t*)F.XB8, (const pg8::bf16_t*)F.WIN8, M, 2560, D}; pg8::StaticOrder S; S.init(M, 2560, F.G, (int)blockIdx.x);
            const pg8::RTab rt_ = pg8::fill_rstd_table<true>((LAS float*)(F.lds + RTAB_OFF), S, F.SS1, F.tid);
            pg8::EpiProjFused<2, true> E{F.PROJ, INW, F.SS1, (const pg8::f32x4*)F.ROPE_R, (const pg8::f32x4*)F.ROPE_A, args.in[8], args.in[9], F.KMEAN, F.lds + TB_OFF + F.wave * 2304, rt_};
            pg8::gemm_phase<pg8::EpiProjFused<2, true>, pg8::StaticOrder, PG8_ALIGN, PG8_SP2, true, 1>(F.lds + RING_OFF, g, S, E, F.wave); }
#else
        pg8::Gemm g{F.XB, F.WIN, M, INW, D}; pg8::StaticOrder S; S.init(M, INW, F.G, (int)blockIdx.x);
        const pg8::RTab rt_ = pg8::fill_rstd_table<true>((LAS float*)(F.lds + RTAB_OFF), S, F.SS1, F.tid);
        pg8::EpiProjFused<0, false> E{F.PROJ, INW, F.SS1, (const pg8::f32x4*)F.ROPE_R, (const pg8::f32x4*)F.ROPE_A, args.in[8], args.in[9], F.KMEAN, F.lds + TB_OFF + F.wave * 2304, rt_};
        pg8::gemm_phase<pg8::EpiProjFused<0, false>, pg8::StaticOrder, PG8_ALIGN, PG8_SP2>(F.lds + RING_OFF, g, S, E, F.wave);
#endif
        if (BOTH(3)) GRID_BAR();
    }
    if (IN(4)) { FRAME_PTRS();
    }
#if MK_DUP == 5
    if (IN(5)) { FRAME_PTRS();
        static_assert(ret_body::RET_LDS_END <= LDS_BYTES && ret_body::RBETA >= MISC_OFF + 128, "retention body LDS vs frame");
        if (F.G == 256) { if (!(F.vcu & 1)) { const int u = F.vcu >> 1; ret_body::ret_unit(F.PROJ, F.MIXB, args.in[7], u / RH, u % RH, F.lds, F.wave); } }
        else for (int u = F.vcu; u < BATCH * RH; u += F.G) ret_body::ret_unit(F.PROJ, F.MIXB, args.in[7], u / RH, u % RH, F.lds, F.wave);
        GRID_BAR();
    }
#endif
    if (IN(5)) { FRAME_PTRS();
        static_assert(ret_body::RET_LDS_END <= LDS_BYTES && ret_body::RBETA >= MISC_OFF + 128, "retention body LDS vs frame");
        if (F.G == 256) { if (!(F.vcu & 1)) { const int u = F.vcu >> 1; ret_body::ret_unit(F.PROJ, F.MIXB, args.in[7], u / RH, u % RH, F.lds, F.wave); } }
        else for (int u = F.vcu; u < BATCH * RH; u += F.G) ret_body::ret_unit(F.PROJ, F.MIXB, args.in[7], u / RH, u % RH, F.lds, F.wave);
    }
#if MK_DUP == 6
    if (IN(6)) { FRAME_PTRS();
        static_assert(attn_body::ATTN_LDS_BYTES <= RING_BYTES, "attention body LDS vs frame");
        const attn_body::AttnTensors AT{(const attn_body::bf16*)(F.PROJ + PC_AQ), (const attn_body::bf16*)(F.PROJ + PC_AK), (const attn_body::bf16*)(F.PROJ + PC_AV), (attn_body::bf16*)(MK_FP8_WOUT ? (bf16*)((unsigned char*)F.MIXB + 512) : F.MIXB + 512), F.KMEAN, args.in[10]};
        const attn_body::StaticOrder SA((int)F.G, F.vcu);
        attn_body::attn_phase<attn_body::StaticOrder>((char*)lds + RING_OFF, AT, SA, F.wave);
        GRID_BAR();
    }
#endif
    if (IN(6)) { FRAME_PTRS();
        static_assert(attn_body::ATTN_LDS_BYTES <= RING_BYTES, "attention body LDS vs frame");
        const attn_body::AttnTensors AT{(const attn_body::bf16*)(F.PROJ + PC_AQ), (const attn_body::bf16*)(F.PROJ + PC_AK), (const attn_body::bf16*)(F.PROJ + PC_AV), (attn_body::bf16*)(MK_FP8_WOUT ? (bf16*)((unsigned char*)F.MIXB + 512) : F.MIXB + 512), F.KMEAN, args.in[10]};
        const attn_body::StaticOrder SA((int)F.G, F.vcu);
        attn_body::attn_phase<attn_body::StaticOrder>((char*)lds + RING_OFF, AT, SA, F.wave);
        if (BOTH(6)) GRID_BAR();
    }
    if (IN(7)) { FRAME_PTRS(); STAGGER4(MK_STAG7);
#if MK_FP8_WOUT
        pg8::Gemm g{F.MIXB, F.WOUT, M, D, D}; pg8::StaticOrder S; S.init(M, D, F.G, (int)blockIdx.x);
        pg8::EpiResid<true, false, true, 3, MK_FP8 != 0> E{nullptr, F.XB, nullptr, F.XB, F.SS2, F.XB8, F.lds + TB_OFF + F.wave * 2304};
        pg8::gemm_phase<pg8::EpiResid<true, false, true, 3, MK_FP8 != 0>, pg8::StaticOrder, PG8_ALIGN, PG8_SP2, true>(F.lds + RING_OFF, g, S, E, F.wave);
#else
        pg8::Gemm g{F.MIXB, F.WOUT, M, D, D}; pg8::StaticOrder S; S.init(M, D, F.G, (int)blockIdx.x);
        pg8::EpiResid<true, false, true, 0, MK_FP8 != 0> E{nullptr, F.XB, nullptr, F.XB, F.SS2, F.XB8, F.lds + TB_OFF + F.wave * 2304};
        pg8::gemm_phase<pg8::EpiResid<true, false, true, 0, MK_FP8 != 0>, pg8::StaticOrder, PG8_ALIGN, PG8_SP2>(F.lds + RING_OFF, g, S, E, F.wave);
#endif
        if (BOTH(7)) GRID_BAR();
    }
#if MK_DUP == 8
    if (IN(8)) { FRAME_PTRS();
#if MK_FP8
        pg8::Gemm g{(const pg8::bf16_t*)F.XB8, (const pg8::bf16_t*)F.W2A8, M, 2 * FF, D}; pg8::StaticOrder S; S.init(M, 2 * FF, F.G, (int)blockIdx.x);
        const pg8::RTab rt_ = pg8::fill_rstd_table<true>((LAS float*)(F.lds + RTAB_OFF), S, F.SS2, F.tid);
        pg8::EpiSwiGLU<true, true, true> E{(pg8::bf16_t*)F.H8, FF, F.SS2, rt_};
        pg8::gemm_phase<pg8::EpiSwiGLU<true, true, true>, pg8::StaticOrder, PG8_ALIGN, PG8_SP2, true, 1>(F.lds + RING_OFF, g, S, E, F.wave);
#else
        pg8::Gemm g{F.XB, F.W2A, M, 2 * FF, D}; pg8::StaticOrder S; S.init(M, 2 * FF, F.G, (int)blockIdx.x);
        pg8::EpiSwiGLU<true> E{F.HB, FF, F.SS2, pg8::RTab{nullptr, 0}};
        pg8::gemm_phase<pg8::EpiSwiGLU<true>, pg8::StaticOrder, PG8_ALIGN, PG8_SP2>(F.lds + RING_OFF, g, S, E, F.wave);
#endif
        GRID_BAR();
    }
#endif
    if (IN(8)) { FRAME_PTRS(); STAGGER(750);
#if MK_FP8
        pg8::Gemm g{(const pg8::bf16_t*)F.XB8, (const pg8::bf16_t*)F.W2A8, M, 2 * FF, D}; pg8::StaticOrder S; S.init(M, 2 * FF, F.G, (int)blockIdx.x);
        const pg8::RTab rt_ = pg8::fill_rstd_table<true>((LAS float*)(F.lds + RTAB_OFF), S, F.SS2, F.tid);
        pg8::EpiSwiGLU<true, true, true> E{(pg8::bf16_t*)F.H8, FF, F.SS2, rt_};
        pg8::gemm_phase<pg8::EpiSwiGLU<true, true, true>, pg8::StaticOrder, PG8_ALIGN, PG8_SP2, true, 1>(F.lds + RING_OFF, g, S, E, F.wave);
#else
        pg8::Gemm g{F.XB, F.W2A, M, 2 * FF, D}; pg8::StaticOrder S; S.init(M, 2 * FF, F.G, (int)blockIdx.x);
        pg8::EpiSwiGLU<true> E{F.HB, FF, F.SS2, pg8::RTab{nullptr, 0}};
        pg8::gemm_phase<pg8::EpiSwiGLU<true>, pg8::StaticOrder, PG8_ALIGN, PG8_SP2>(F.lds + RING_OFF, g, S, E, F.wave);
#endif
        if (BOTH(8)) GRID_BAR();
    }
#if defined(MK_PROBE) && (MK_PROBE == 90 || MK_PROBE == 91)
    if (IN(8)) { FRAME_PTRS();
        const unsigned long long t0 = __builtin_amdgcn_s_memtime(), r0 = __builtin_amdgcn_s_memrealtime();
#if MK_PROBE == 90
        { pg8::Gemm g{(const pg8::bf16_t*)F.XB8, (const pg8::bf16_t*)F.W2A8, M, 2 * FF, D}; pg8::StaticOrder S; S.init(M, 2 * FF, F.G, (int)blockIdx.x); pg8::EpiNone E{};
        pg8::gemm_phase<pg8::EpiNone, pg8::StaticOrder, PG8_ALIGN, PG8_SP2, true, 1>(F.lds + RING_OFF, g, S, E, F.wave); }
#else
        { pg8::Gemm g{F.XB, F.W1A, M, 2 * FF, D}; pg8::StaticOrder S; S.init(M, 2 * FF, F.G, (int)blockIdx.x); pg8::EpiNone E{};
        pg8::gemm_phase<pg8::EpiNone, pg8::StaticOrder, PG8_ALIGN, PG8_SP2>(F.lds + RING_OFF, g, S, E, F.wave); }
#endif
        const unsigned long long t1 = __builtin_amdgcn_s_memtime(), r1 = __builtin_amdgcn_s_memrealtime();
        if (blockIdx.x == 0) { const unsigned long long ticks = 5000ull * (t1 - t0) / (r1 - r0);
            while (__builtin_amdgcn_s_memrealtime() - r1 < ticks) __builtin_amdgcn_s_sleep(32); }
        GRID_BAR();
    }
#elif defined(MK_PROBE)
    if (IN(8)) { FRAME_PTRS();
#if MK_PROBE == 81
        pg8::Gemm g{(const pg8::bf16_t*)F.XB8, (const pg8::bf16_t*)F.W2A8, M, 2 * FF, D}; pg8::StaticOrder S; S.init(M, 2 * FF, F.G, (int)blockIdx.x); pg8::EpiNone E{};
        pg8::gemm_phase<pg8::EpiNone, pg8::StaticOrder, PG8_ALIGN, PG8_SP2, true, 1>(F.lds + RING_OFF, g, S, E, F.wave);
#elif MK_PROBE == 82
        pg8::Gemm g{(const pg8::bf16_t*)(args.ws + (512u << 10)), (const pg8::bf16_t*)F.W2A8, M, 2 * FF, D}; pg8::Row0Order S; S.init(M, 2 * FF, F.G, (int)blockIdx.x); pg8::EpiNone E{};
        pg8::gemm_phase<pg8::EpiNone, pg8::Row0Order, PG8_ALIGN, PG8_SP2, true>(F.lds + RING_OFF, g, S, E, F.wave);
#elif MK_PROBE == 83
        pg8::Gemm g{(const pg8::bf16_t*)F.XB8, (const pg8::bf16_t*)F.W2A8, M, 2 * FF, D}; pg8::Row0Order S; S.init(M, 2 * FF, F.G, (int)blockIdx.x); pg8::EpiNone E{};
        pg8::gemm_phase<pg8::EpiNone, pg8::Row0Order, PG8_ALIGN, PG8_SP2, true, 1>(F.lds + RING_OFF, g, S, E, F.wave);
#elif MK_PROBE == 11
        pg8::Gemm g{F.XB, F.W1A, M, 2 * FF, D}; pg8::StaticOrder S; S.init(M, 2 * FF, F.G, (int)blockIdx.x); pg8::EpiNone E{};
        pg8::gemm_phase<pg8::EpiNone, pg8::StaticOrder, PG8_ALIGN, PG8_SP2>(F.lds + RING_OFF, g, S, E, F.wave);
#endif
        GRID_BAR();
    }
#endif
    if (IN(9)) { FRAME_PTRS(); STAGGER4(MK_STAG9);
#if MK_FP8
        pg8::Gemm g{(const pg8::bf16_t*)F.H8, (const pg8::bf16_t*)F.WD28, M, D, FF}; pg8::StaticOrder S; S.init(M, D, F.G, (int)blockIdx.x);
        pg8::EpiResid<true, true, false, 2> E{nullptr, F.XB, F.out, nullptr, nullptr, nullptr, F.lds + TB_OFF + F.wave * 2304};
        pg8::gemm_phase<pg8::EpiResid<true, true, false, 2>, pg8::StaticOrder, PG8_ALIGN, PG8_SP2, true, 1>(F.lds + RING_OFF, g, S, E, F.wave);
#else
        pg8::Gemm g{F.HB, F.WD2, M, D, FF}; pg8::StaticOrder S; S.init(M, D, F.G, (int)blockIdx.x);
        pg8::EpiResid<true, true, false, 1> E{nullptr, F.XB, F.out, nullptr, nullptr, nullptr, F.lds + TB_OFF + F.wave * 2304};
        pg8::gemm_phase<pg8::EpiResid<true, true, false, 1>, pg8::StaticOrder, PG8_ALIGN, PG8_SP2>(F.lds + RING_OFF, g, S, E, F.wave);
#endif
    }
#undef IN
#undef BOTH
#undef GRID_BAR
}

extern "C" void kernel_launch(void* const* d_in, const int* in_sizes, int n_in, void* d_out, int out_size, void* d_ws, size_t ws_size, hipStream_t stream) {
    static int grid = 0;
    if (grid == 0) {
        if (n_in != 16 || in_sizes[0] != M * D || out_size != M * D || ws_size < WS_END) { fprintf(stderr, "kernel_launch: unexpected shapes (n_in %d, in0 %d, out %d, ws %zu); nothing launched\n", n_in, n_in > 0 ? in_sizes[0] : -1, out_size, ws_size); grid = -1; return; }
        int dev = 0, cus = 0, per_cu = 0;
        if (hipGetDevice(&dev) != hipSuccess || hipDeviceGetAttribute(&cus, hipDeviceAttributeMultiprocessorCount, dev) != hipSuccess) { fprintf(stderr, "kernel_launch: device query failed\n"); grid = -1; return; }
        if (hipOccupancyMaxActiveBlocksPerMultiprocessor(&per_cu, (const void*)mk_fwd, NWAVES * 64, 0) != hipSuccess || per_cu < 1)
            fprintf(stderr, "kernel_launch: note: occupancy query reports %d workgroups per CU\n", per_cu);
        (void)hipGetLastError();
        grid = cus;
    }
    if (grid < 0) return;
    if (hipMemsetAsync((char*)d_ws + WS_CTL, 0, CTL_ZERO_BYTES, stream) != hipSuccess) { fprintf(stderr, "kernel_launch: memset failed\n"); return; }
    Args a{};
    for (int i = 0; i < 16; ++i) a.in[i] = (const float*)d_in[i];
    a.out = (float*)d_out; a.ws = (unsigned char*)d_ws;
    for (int i = 0; i < 64; ++i) a.invf_r[i] = (float)std::pow(10000.0, -(double)i * 2.0 / 128.0);
    for (int i = 0; i < 8; ++i) a.invf_a[i] = (float)std::pow(500000.0, -(double)i * 2.0 / 16.0);
#if MK_PER_PHASE
    for (int p = 0; p < N_PHASES; ++p) { a.ph_lo = p; a.ph_hi = p + 1; a.li = p; hipLaunchKernelGGL(mk_fwd, dim3(grid), dim3(NWAVES * 64), 0, stream, a); }
#else
    a.ph_lo = 0; a.ph_hi = N_PHASES; a.li = 0;
    hipLaunchKernelGGL(mk_fwd, dim3(grid), dim3(NWAVES * 64), 0, stream, a);
#endif
    const hipError_t le = hipPeekAtLastError();
    if (le != hipSuccess) fprintf(stderr, "kernel_launch: launch failed: %s\n", hipGetErrorName(le));
}
```

```cpp
#include <hip/hip_runtime.h>
#include <cstdio>
#include <cstdint>
#include <cmath>
#ifndef MK_NT_P0
#define MK_NT_P0 0
#endif
#ifndef MK_NT_MIX
#define MK_NT_MIX 0
#endif
#if MK_NT_P0
#define P0_LDNT(p) __builtin_nontemporal_load(p)
#define P0_STNT(v, p) __builtin_nontemporal_store((v), (p))
#else
#define P0_LDNT(p) (*(p))
#define P0_STNT(v, p) (*(p) = (v))
#endif
#if MK_NT_MIX
#define MIX_STNT(v, p) __builtin_nontemporal_store((v), (p))
#else
#define MIX_STNT(v, p) (*(p) = (v))
#endif
__device__ __forceinline__ int mk_lane() { int l; asm volatile("v_mbcnt_lo_u32_b32 %0, -1, 0\n\tv_mbcnt_hi_u32_b32 %0, -1, %0" : "=v"(l)); return l; }
#ifndef MK_FP8_WOUT
#define MK_FP8_WOUT 0
#endif
#define MK_FP8_WOUT 1
namespace pg8 {
#define PG8_LAS __attribute__((address_space(3)))
typedef unsigned short bf16_t;
typedef short bf16x8 __attribute__((ext_vector_type(8)));
typedef float f32x4 __attribute__((ext_vector_type(4)));
typedef unsigned u32x4 __attribute__((ext_vector_type(4)));
constexpr int BM = 256, BK = 64, HALF = 128, HTB = HALF * BK * 2  , STAGE_BYTES = 8 * HTB, NXCD = 8, WGM = 8;

__host__ __device__ __forceinline__ int lds_byte(int r, int c) { const int st = (r >> 4) * 2 + (c >> 5), rr = r & 15, cc = c & 31, ob = rr * 64 + cc * 2; return st * 1024 + (ob ^ (((ob >> 9) & 1) << 5)); }
__host__ __device__ __forceinline__ void stage_rc(int b, int& R, int& C) { const int st = b / 1024, sb = b % 1024, swz = sb ^ (((sb >> 9) & 1) << 5); R = (st >> 1) * 16 + swz / 64; C = (st & 1) * 32 + (swz % 64) / 2; }
__host__ __device__ __forceinline__ unsigned a8_block_off(int wc, int R, int pz) { return (unsigned)(wc * 8192 + R * 32 + pz * 16); }
__host__ __device__ __forceinline__ int perm32(int rho) { const int n = rho >> 4, i = rho & 15; return 8 * (i >> 2) + 4 * n + (i & 3); }

struct Unit { int pm, pn; };
struct Gemm { const bf16_t* A; const bf16_t* Bt; int M, N, K; };

struct StaticOrder {
    int nM, nN, nwg, G, c;
    __host__ __device__ void init(int M, int N, int G_, int c_) { nM = M / BM; nN = N / BM; nwg = nM * nN; G = G_; c = c_; }
    __host__ __device__ bool next(int i, Unit& u) const {
        const long L = (long)i * G + c; if (L >= nwg) return false;
        int wgid = (int)L; { const int q = nwg / NXCD, r = nwg % NXCD, xcd = wgid % NXCD, off = wgid / NXCD; wgid = (xcd < r ? xcd * (q + 1) : r * (q + 1) + (xcd - r) * q) + off; }
        const int nig = WGM * nN, gid = wgid / nig, fm = gid * WGM, gsz = (nM - fm) < WGM ? (nM - fm) : WGM;
        u.pm = fm + ((wgid % nig) % gsz); u.pn = (wgid % nig) / gsz; return true;
    }
    __device__ __forceinline__ void a_ready(const Unit&) const {}
    __device__ __forceinline__ void done(const Unit&) const {}
};

__device__ __forceinline__ unsigned cvt_pk_bf16(float lo, float hi) { unsigned r; asm volatile("v_cvt_pk_bf16_f32 %0, %1, %2" : "=v"(r) : "v"(lo), "v"(hi)); return r; }
typedef int i32x8 __attribute__((ext_vector_type(8)));
typedef unsigned u32x2 __attribute__((ext_vector_type(2)));
__device__ __forceinline__ i32x8 cat8(const bf16x8 a, const bf16x8 b) { typedef int i32x4_ __attribute__((ext_vector_type(4))); const i32x4_ x = __builtin_bit_cast(i32x4_, a), y = __builtin_bit_cast(i32x4_, b); return (i32x8){x[0], x[1], x[2], x[3], y[0], y[1], y[2], y[3]}; }
__device__ __forceinline__ unsigned pk4_fp8(float a, float b, float c, float d) {
    a = __builtin_amdgcn_fmed3f(a, -448.f, 448.f); b = __builtin_amdgcn_fmed3f(b, -448.f, 448.f); c = __builtin_amdgcn_fmed3f(c, -448.f, 448.f); d = __builtin_amdgcn_fmed3f(d, -448.f, 448.f);
    int w = 0; w = __builtin_amdgcn_cvt_pk_fp8_f32(a, b, w, false); w = __builtin_amdgcn_cvt_pk_fp8_f32(c, d, w, true); return (unsigned)w; }
constexpr float W8_SCALE = 64.0f, H8_SCALE = 8.0f;
constexpr int SS_M = 65536;
__device__ __forceinline__ float rstd_ss16(const float* ss, int row) {
    float s = 0.f;
#pragma unroll
    for (int k = 0; k < 16; ++k) s += ss[(size_t)k * SS_M + row];
    return __builtin_amdgcn_rsqf(s * (1.0f / 1024.0f) + 1e-6f);
}
#define PG8_GAS __attribute__((address_space(1)))
#ifndef MK_NT
#define MK_NT 1
#endif
#ifndef MK_NT_BASE
#define MK_NT_BASE 0
#endif
#if MK_NT_BASE
#define PG8_LDNT_BASE(p) __builtin_nontemporal_load(p)
#else
#define PG8_LDNT_BASE(p) (*(p))
#endif
#ifndef MK_NT_X8
#define MK_NT_X8 1
#endif
#if MK_NT && MK_NT_X8
#define PG8_ST8(p, v) __builtin_nontemporal_store((v), (p))
#else
#define PG8_ST8(p, v) (*(p) = (v))
#endif
#if MK_NT
#define PG8_ST(p, v) __builtin_nontemporal_store((v), (p))
#else
#define PG8_ST(p, v) (*(p) = (v))
#endif
template <typename T> __device__ __forceinline__ PG8_GAS T* gas_at(const void* base, unsigned byte_off) { return (PG8_GAS T*)((PG8_GAS char*)base + byte_off); }
__device__ __forceinline__ void rstd8_ss16(const float* ss, int row0, int fq, float (&rr)[8]) {
    float q[8][4];
#pragma unroll
    for (int g = 0; g < 8; ++g)
#pragma unroll
        for (int j = 0; j < 4; ++j) q[g][j] = *gas_at<const float>(ss, ((unsigned)(4 * fq + j) * (unsigned)SS_M + (unsigned)(row0 + (g >> 2) * HALF + (g & 3) * 16)) * 4u);
    asm volatile("" ::: "memory");
#pragma unroll
    for (int g = 0; g < 8; ++g) { float s = (q[g][0] + q[g][1]) + (q[g][2] + q[g][3]); s += __shfl_xor(s, 16); s += __shfl_xor(s, 32); rr[g] = __builtin_amdgcn_rsqf(s * (1.0f / 1024.0f) + 1e-6f); }
}
constexpr int RTAB_SLOTS = 4;
struct RTab { const PG8_LAS float* tab; int pm0; };
template <bool SS16, class Sched> __device__ __forceinline__ RTab fill_rstd_table(PG8_LAS float* tab, const Sched& S, const float* src  , int tid) {
    Unit u; if (!S.next(0, u)) return RTab{nullptr, 0};
    const int pm0 = u.pm; int pml = pm0;
    for (int i = 1; S.next(i, u); ++i) pml = u.pm;
    const int ns = ((pml - pm0) >> 3) + 1;
    if (ns > RTAB_SLOTS || ((pml - pm0) & 7)) return RTab{nullptr, 0};
    const int r = tid >> 1, h = tid & 1;
    if (SS16) {
        float q[RTAB_SLOTS][8];
#pragma unroll
        for (int k = 0; k < RTAB_SLOTS; ++k) { const int pm = k < ns ? pm0 + 8 * k : pm0;
#pragma unroll
            for (int j = 0; j < 8; ++j) q[k][j] = *gas_at<const float>(src, ((unsigned)(h * 8 + j) * (unsigned)SS_M + (unsigned)(pm * BM + r)) * 4u); }
#pragma unroll
        for (int k = 0; k < RTAB_SLOTS; ++k) { float s = ((q[k][0] + q[k][1]) + (q[k][2] + q[k][3])) + ((q[k][4] + q[k][5]) + (q[k][6] + q[k][7])); s += __shfl_xor(s, 1);
            if (h == 0) tab[k * BM + r] = __builtin_amdgcn_rsqf(s * (1.0f / 1024.0f) + 1e-6f); }
    } else {
#pragma unroll
        for (int k = 0; k < RTAB_SLOTS / 2; ++k) { const int kk = 2 * k + h; const int pm = kk < ns ? pm0 + 8 * kk : pm0; tab[kk * BM + r] = *gas_at<const float>(src, (unsigned)(pm * BM + r) * 4u); }
    }
    __syncthreads();
    return RTab{tab, pm0};
}
__device__ __forceinline__ void rstd8_tab(const RTab& t, const Unit& u, int wr, int fr, float (&rr)[8]) {
    const PG8_LAS float* p = t.tab + ((u.pm - t.pm0) >> 3) * BM + wr * 64 + fr;
#pragma unroll
    for (int g = 0; g < 8; ++g) rr[g] = p[(g >> 2) * HALF + (g & 3) * 16];
}
__device__ __forceinline__ u32x4 pair_rows_f8(const u32x2 a, const u32x2 b, const int lane) {
    const int i0 = (((lane & 1) * 32 + ((lane >> 1) & 15)) * 4), i1 = i0 + 64; const bool hi = lane >= 32;
    const int ax0 = __builtin_amdgcn_ds_bpermute(i0, (int)a.x), ay0 = __builtin_amdgcn_ds_bpermute(i0, (int)a.y), ax1 = __builtin_amdgcn_ds_bpermute(i1, (int)a.x), ay1 = __builtin_amdgcn_ds_bpermute(i1, (int)a.y);
    const int bx0 = __builtin_amdgcn_ds_bpermute(i0, (int)b.x), by0 = __builtin_amdgcn_ds_bpermute(i0, (int)b.y), bx1 = __builtin_amdgcn_ds_bpermute(i1, (int)b.x), by1 = __builtin_amdgcn_ds_bpermute(i1, (int)b.y);
    u32x4 r; r.x = (unsigned)(hi ? bx0 : ax0); r.y = (unsigned)(hi ? by0 : ay0); r.z = (unsigned)(hi ? bx1 : ax1); r.w = (unsigned)(hi ? by1 : ay1); return r;
}
__device__ __forceinline__ u32x4 rows_linear_b16(const u32x4 w, const int lane) {
    const int src = ((lane & 3) * 16 + (lane >> 2)) * 4; u32x4 r;
    r.x = (unsigned)__builtin_amdgcn_ds_bpermute(src, (int)w.x); r.y = (unsigned)__builtin_amdgcn_ds_bpermute(src, (int)w.y); r.z = (unsigned)__builtin_amdgcn_ds_bpermute(src, (int)w.z); r.w = (unsigned)__builtin_amdgcn_ds_bpermute(src, (int)w.w); return r;
}
template <bool SS16, bool F8 = false, bool BLK = false, bool OUT8 = F8> struct EpiSwiGLU {
    static constexpr bool PERM = true, AFTER_DRAIN = false, BADJ = false; static constexpr int NSTORE = OUT8 ? 4 : 8;
    bf16_t* H; int ldh; const float* rs; RTab rt;
    __device__ __forceinline__ void operator()(const f32x4 (&acc)[2][2][4][2], const Unit& u, int wr, int wc, int fr, int fq) const {
        const int row0 = u.pm * BM + wr * 64 + fr; const int col0 = u.pn * HALF + wc * 32 + 8 * fq;
        float rr[8];
        if (rt.tab) rstd8_tab(rt, u, wr, fr, rr);
        else if (SS16) rstd8_ss16(rs, row0, fq, rr);
        else {
#pragma unroll
            for (int g = 0; g < 8; ++g) rr[g] = *gas_at<const float>(rs, (unsigned)(row0 + (g >> 2) * HALF + (g & 3) * 16) * 4u);
            asm volatile("" ::: "memory"); }
        u32x2 w8e = {0u, 0u};
#pragma unroll
        for (int ai = 0; ai < 2; ++ai)
#pragma unroll
            for (int m = 0; m < 4; ++m) {
                const int row = row0 + ai * HALF + m * 16;
                const float r = rr[ai * 4 + m] * (F8 ? 1.0f / W8_SCALE : 1.0f);
                const float t = -1.4426950408889634f * r, ir2 = __builtin_amdgcn_rcpf(r * r * (OUT8 ? H8_SCALE : 1.0f));
                f32x4 hq[2];
#pragma unroll
                for (int n = 0; n < 2; ++n) { const f32x4 gv = acc[ai][0][m][n], uv = acc[ai][1][m][n];
                    f32x4 e = gv * t; e[0] = __builtin_amdgcn_exp2f(e[0]); e[1] = __builtin_amdgcn_exp2f(e[1]); e[2] = __builtin_amdgcn_exp2f(e[2]); e[3] = __builtin_amdgcn_exp2f(e[3]);
                    f32x4 d = e * ir2 + ir2; d[0] = __builtin_amdgcn_rcpf(d[0]); d[1] = __builtin_amdgcn_rcpf(d[1]); d[2] = __builtin_amdgcn_rcpf(d[2]); d[3] = __builtin_amdgcn_rcpf(d[3]);
                    hq[n] = (gv * uv) * d; }
                if (OUT8) { u32x2 w8; w8.x = pk4_fp8(hq[0][0], hq[0][1], hq[0][2], hq[0][3]); w8.y = pk4_fp8(hq[1][0], hq[1][1], hq[1][2], hq[1][3]);
                    if ((m & 1) == 0) w8e = w8;
                    else { const int l_ = fq * 16 + fr; const u32x4 w16 = pair_rows_f8(w8e, w8, l_);
                        const int R = ai * HALF + wr * 64 + (m - 1 + (l_ >> 5)) * 16 + ((l_ >> 1) & 15);
                        if (BLK) PG8_ST(gas_at<u32x4>(H, (unsigned)(u.pm * (ldh >> 7) + u.pn) * 32768u + a8_block_off(wc, R, l_ & 1)), w16);
                        else *gas_at<u32x4>(H, (unsigned)(u.pm * BM + R) * (unsigned)ldh + (unsigned)(u.pn * HALF + wc * 32 + (l_ & 1) * 16)) = w16; } }
                else {
                u32x4 w; w.x = cvt_pk_bf16(hq[0][0], hq[0][1]); w.y = cvt_pk_bf16(hq[0][2], hq[0][3]); w.z = cvt_pk_bf16(hq[1][0], hq[1][1]); w.w = cvt_pk_bf16(hq[1][2], hq[1][3]);
                if (BLK) { const int l_ = fq * 16 + fr; const u32x4 wl = rows_linear_b16(w, l_);
                    PG8_ST(gas_at<u32x4>(H, (unsigned)(u.pm * (ldh >> 7) + u.pn) * 65536u + (unsigned)(wc * 16384 + (ai * HALF + wr * 64 + m * 16 + (l_ >> 2)) * 64 + (l_ & 3) * 16)), wl); }
                else *gas_at<u32x4>(H, ((unsigned)row * (unsigned)ldh + (unsigned)col0) * 2u) = w; }
            }
    }
};
template <bool BASE_BF, bool OUT_F32, bool OUT_BF, int ALPHA_MODE, bool OUT_F8 = false, bool F8BLK = true> struct EpiResid {
    static constexpr bool PERM = true, AFTER_DRAIN = false, BADJ = true; static constexpr int NSTORE = (OUT_F32 ? 32 : 0) + (OUT_BF ? 18 : 0) + (OUT_F8 ? 8 : 0);
    const float* basef; const bf16_t* baseb; float* outf; bf16_t* xb; float* ss; unsigned char* x8; PG8_LAS unsigned char* tb;
    __device__ __forceinline__ void operator()(const f32x4 (&acc)[2][2][4][2], const Unit& u, int wr, int wc, int fr, int fq) const {
        const int row0 = u.pm * BM + wr * 64 + fr; const int col0 = u.pn * BM + wc * 64 + 8 * fq; const float alpha = ALPHA_MODE == 0 ? 1.0f : (ALPHA_MODE == 1 ? 0.5f : (ALPHA_MODE == 2 ? 0.5f / (W8_SCALE * H8_SCALE) : 1.0f / W8_SCALE));
        const int l_ = fq * 16 + fr;
        u32x4 bb[2][4][2];
        if (BASE_BF) {
#pragma unroll
            for (int ai = 0; ai < 2; ++ai)
#pragma unroll
                for (int m = 0; m < 4; ++m)
#pragma unroll
                    for (int bj = 0; bj < 2; ++bj) bb[ai][m][bj] = PG8_LDNT_BASE(gas_at<const u32x4>(baseb, ((unsigned)(row0 + ai * HALF + m * 16) * 1024u + (unsigned)(col0 + bj * 32)) * 2u));
            asm volatile("" ::: "memory");
        }
#define PG8_TBROW(b, r) (tb + (r) * 144)
        auto emit = [&](const int ps) {
#pragma unroll
            for (int k = 0; k < 2; ++k) { const int r = (l_ >> 3) + 8 * k; const u32x4 o = *(const PG8_LAS u32x4*)(PG8_TBROW(ps, r) + (l_ & 7) * 16);
                if (OUT_F32) { const int pai = ps >> 3, pmm = (ps >> 1) & 3, pbj = ps & 1;
                    PG8_ST(gas_at<u32x4>(outf, ((unsigned)(u.pm * BM + pai * HALF + wr * 64 + pmm * 16 + r) * 1024u + (unsigned)(u.pn * BM + wc * 64 + pbj * 32)) * 4u + (unsigned)(l_ & 7) * 16u), o); }
                else { const int pai = ps >> 2, pmm = ps & 3;
                    PG8_ST(gas_at<u32x4>(xb, ((unsigned)(u.pm * BM + pai * HALF + wr * 64 + pmm * 16 + r) * 1024u + (unsigned)(u.pn * BM + wc * 64)) * 2u + (unsigned)(l_ & 7) * 16u), o); } }
        };
        u32x2 w8e[2] = {{0u, 0u}, {0u, 0u}}; float sqv[4] = {0.f, 0.f, 0.f, 0.f};
#pragma unroll
        for (int ai = 0; ai < 2; ++ai)
#pragma unroll
            for (int m = 0; m < 4; ++m) {
                const int row = row0 + ai * HALF + m * 16; const unsigned off = (unsigned)row * 1024u + (unsigned)col0; float sq = 0.f;
#pragma unroll
                for (int bj = 0; bj < 2; ++bj) {
                    f32x4 b0, b1;
                    if (BASE_BF) { const u32x4 r = bb[ai][m][bj];
                        b0 = (f32x4){__uint_as_float(r.x << 16), __uint_as_float(r.x & 0xffff0000u), __uint_as_float(r.y << 16), __uint_as_float(r.y & 0xffff0000u)};
                        b1 = (f32x4){__uint_as_float(r.z << 16), __uint_as_float(r.z & 0xffff0000u), __uint_as_float(r.w << 16), __uint_as_float(r.w & 0xffff0000u)}; }
                    else { b0 = *(const f32x4*)(basef + off + bj * 32); b1 = *(const f32x4*)(basef + off + bj * 32 + 4); }
                    const f32x4 v0 = b0 + acc[ai][bj][m][0] * alpha, v1 = b1 + acc[ai][bj][m][1] * alpha;
                    if (OUT_F32) {
                        const int st = ai * 8 + m * 2 + bj; PG8_LAS unsigned char* p = PG8_TBROW(st, fr) + fq * 32;
                        *(PG8_LAS f32x4*)p = v0; *(PG8_LAS f32x4*)(p + 16) = v1;
                        emit(st);
                    }
                    if (OUT_BF) {
                        u32x4 w; w.x = cvt_pk_bf16(v0[0], v0[1]); w.y = cvt_pk_bf16(v0[2], v0[3]); w.z = cvt_pk_bf16(v1[0], v1[1]); w.w = cvt_pk_bf16(v1[2], v1[3]);
                        *(PG8_LAS u32x4*)(PG8_TBROW(ai * 4 + m, fr) + bj * 64 + fq * 16) = w;
                        sq += (v0[0] * v0[0] + v0[1] * v0[1]) + (v0[2] * v0[2] + v0[3] * v0[3]) + (v1[0] * v1[0] + v1[1] * v1[1]) + (v1[2] * v1[2] + v1[3] * v1[3]);
                    }
                    if (OUT_F8) { u32x2 w8; w8.x = pk4_fp8(v0[0], v0[1], v0[2], v0[3]); w8.y = pk4_fp8(v1[0], v1[1], v1[2], v1[3]);
                        if ((m & 1) == 0) w8e[bj] = w8;
                        else { const u32x4 w16 = pair_rows_f8(w8e[bj], w8, l_);
                            const int R = ai * HALF + wr * 64 + (m - 1 + (l_ >> 5)) * 16 + ((l_ >> 1) & 15);
                            if (F8BLK) PG8_ST8(gas_at<u32x4>(x8, (unsigned)(u.pm * 8 + u.pn * 2 + (wc >> 1)) * 32768u + a8_block_off(2 * (wc & 1) + bj, R, l_ & 1)), w16);
                            else *gas_at<u32x4>(x8, (unsigned)(u.pm * BM + R) * 1024u + (unsigned)(u.pn * BM + wc * 64 + bj * 32 + (l_ & 1) * 16)) = w16; } }
                }
                if (OUT_BF) { emit(ai * 4 + m);
                    sq += __shfl_xor(sq, 16); sq += __shfl_xor(sq, 32); sqv[m] = sq;
                    if (m == 3) { const float v = fq == 0 ? sqv[0] : (fq == 1 ? sqv[1] : (fq == 2 ? sqv[2] : sqv[3]));
                        *gas_at<float>(ss, ((unsigned)(u.pn * 4 + wc) * (unsigned)SS_M + (unsigned)(u.pm * BM + ai * HALF + wr * 64 + l_)) * 4u) = v; } }
            }
#undef PG8_TBROW
    }
};
template <int ALPHA_MODE> struct EpiOutF32 {
    static constexpr bool PERM = false, AFTER_DRAIN = false, BADJ = false; static constexpr int NSTORE = 32;
    const bf16_t* baseb; float* outf;
    __device__ __forceinline__ void operator()(const f32x4 (&acc)[2][2][4][2], const Unit& u, int wr, int wc, int fr, int fq) const {
        const int row0 = u.pm * BM + wr * 64 + fr; const int col0 = u.pn * BM + wc * 32 + 4 * fq; const float alpha = ALPHA_MODE == 1 ? 0.5f : 0.5f / (W8_SCALE * H8_SCALE);
        u32x2 bb[2][4][2][2];
#pragma unroll
        for (int ai = 0; ai < 2; ++ai)
#pragma unroll
            for (int m = 0; m < 4; ++m)
#pragma unroll
                for (int bj = 0; bj < 2; ++bj)
#pragma unroll
                    for (int n = 0; n < 2; ++n) bb[ai][m][bj][n] = *gas_at<const u32x2>(baseb, ((unsigned)(row0 + ai * HALF + m * 16) * 1024u + (unsigned)(col0 + bj * HALF + 16 * n)) * 2u);
        asm volatile("" ::: "memory");
#pragma unroll
        for (int ai = 0; ai < 2; ++ai)
#pragma unroll
            for (int m = 0; m < 4; ++m) {
                const unsigned off = (unsigned)(row0 + ai * HALF + m * 16) * 1024u + (unsigned)col0;
#pragma unroll
                for (int bj = 0; bj < 2; ++bj)
#pragma unroll
                    for (int n = 0; n < 2; ++n) { const u32x2 r = bb[ai][m][bj][n];
                        const f32x4 b = {__uint_as_float(r.x << 16), __uint_as_float(r.x & 0xffff0000u), __uint_as_float(r.y << 16), __uint_as_float(r.y & 0xffff0000u)};
                        *gas_at<f32x4>(outf, (off + bj * HALF + 16 * n) * 4u) = b + acc[ai][bj][m][n] * alpha; }
            }
    }
};
__host__ __device__ __forceinline__ int att_dim(int bj, int fq, int n, int i) { return bj == 0 ? (fq < 2 ? (n == 0 ? 4 * fq + i : 8 + 4 * fq + i) : 8 * fq + 4 * n + i) : 32 + 8 * fq + 4 * n + i; }
__host__ __device__ __forceinline__ int win_orig_col(int c) {
    const int pn = c >> 8, w = c & 255, wc = w >> 6, bj = (w >> 5) & 1, fq = (w >> 3) & 3, n = (w >> 2) & 1, i = w & 3;
    if (pn < 4) { const int head = 2 * (pn & 1) + bj, g = 4 * wc + fq; return (pn < 2 ? 0 : 512) + head * 128 + (n == 0 ? 4 * g + i : 64 + 4 * g + i); }
    if (pn >= 8 && pn < 12) { const int head = 4 * (pn & 1) + wc; return (pn < 10 ? 2048 : 2560) + head * 64 + att_dim(bj, fq, n, i); }
    return c;
}
template <int MODE = 0, bool F8 = false> struct EpiProjFused {
    static constexpr bool PERM = true, AFTER_DRAIN = false, BADJ = true; static constexpr int NSTORE = 16;
    bf16_t* O; int ldo; const float* ss; const f32x4* rope_r; const f32x4* rope_a; const float* qnw; const float* knw; float* kmean; PG8_LAS unsigned char* tb; RTab rt;
    __device__ __forceinline__ void operator()(const f32x4 (&acc)[2][2][4][2], const Unit& u, int wr, int wc, int fr, int fq) const {
        const int pn = MODE == 1 ? u.pn + 8 : (MODE == 2 ? (u.pn < 8 ? u.pn : u.pn + 4) : (MODE == 3 ? (u.pn < 4 ? u.pn : u.pn + 2) : (MODE == 4 ? (u.pn < 2 ? u.pn + 4 : u.pn + 10) : u.pn))); const float dsc = F8 ? 1.0f / W8_SCALE : 1.0f;
#define PG8_EMIT_ROWS() do { const int l_ = fq * 16 + fr; _Pragma("unroll") for (int k_ = 0; k_ < 2; ++k_) { const u32x4 o_ = *(const PG8_LAS u32x4*)(tb + ((l_ >> 3) + 8 * k_) * 144 + (l_ & 7) * 16); \
        PG8_ST(gas_at<u32x4>(O, ((unsigned)(u.pm * BM + ai * HALF + wr * 64 + m * 16 + (l_ >> 3) + 8 * k_) * (unsigned)ldo + (unsigned)(pn * BM + wc * 64)) * 2u + (unsigned)(l_ & 7) * 16u), o_); } } while (0)
#define PG8_EPI_LANE() asm volatile("" : "+v"(fr), "+v"(fq)); const int row0 = u.pm * BM + wr * 64 + fr; const int col0 = pn * BM + wc * 64 + 8 * fq
        if (MODE != 1 && MODE != 4 && pn < 4) {
            PG8_EPI_LANE();
            const float sc = pn >= 2 ? 0.08838834764831845f : 1.0f; const int g = 4 * wc + fq;
            f32x4 cs[2][4][2];
#pragma unroll
            for (int m = 0; m < 4; ++m)
#pragma unroll
                for (int h = 0; h < 2; ++h) cs[0][m][h] = *gas_at<const f32x4>(rope_r, ((unsigned)((row0 + m * 16) & 2047) * 64u + 4u * (unsigned)g) * 8u + 16u * h);
            float rr[8];
            if (rt.tab) rstd8_tab(rt, u, wr, fr, rr); else rstd8_ss16(ss, row0, fq, rr);
            asm volatile("" ::: "memory");
#pragma unroll
            for (int gi = 0; gi < 8; ++gi) rr[gi] *= (sc * dsc);
#pragma unroll
            for (int m = 0; m < 4; ++m)
#pragma unroll
                for (int h = 0; h < 2; ++h) cs[1][m][h] = *gas_at<const f32x4>(rope_r, ((unsigned)((row0 + HALF + m * 16) & 2047) * 64u + 4u * (unsigned)g) * 8u + 16u * h);
            asm volatile("" ::: "memory");
#pragma unroll
            for (int ai = 0; ai < 2; ++ai)
#pragma unroll
                for (int m = 0; m < 4; ++m) {
                    const int row = row0 + ai * HALF + m * 16; const float r = rr[ai * 4 + m];
                    const f32x4 c01 = cs[ai][m][0], c23 = cs[ai][m][1];
                    const f32x4 cv = {c01[0], c01[2], c23[0], c23[2]}, sv = {c01[1], c01[3], c23[1], c23[3]};
#pragma unroll
                    for (int bj = 0; bj < 2; ++bj) { const f32x4 x1 = acc[ai][bj][m][0] * r, x2 = acc[ai][bj][m][1] * r;
                        const f32x4 v0 = x1 * cv - x2 * sv, v1 = x2 * cv + x1 * sv;
                        u32x4 w; w.x = cvt_pk_bf16(v0[0], v0[1]); w.y = cvt_pk_bf16(v0[2], v0[3]); w.z = cvt_pk_bf16(v1[0], v1[1]); w.w = cvt_pk_bf16(v1[2], v1[3]);
                        *(PG8_LAS u32x4*)(tb + fr * 144 + bj * 64 + fq * 16) = w; }
                    PG8_EMIT_ROWS();
                }
        } else if (MODE != 2 && MODE != 4 && pn >= 8 && pn < 12) {
            PG8_EPI_LANE();
            const bool isk = pn >= 10; const float* gw = isk ? knw : qnw;
            const float qs = isk ? 1.0f : 0.125f * 1.4426950408889634f;
            f32x4 gg[2][2], ca[4][2];
#pragma unroll
            for (int bj = 0; bj < 2; ++bj)
#pragma unroll
                for (int n = 0; n < 2; ++n) gg[bj][n] = *gas_at<const f32x4>(gw, (unsigned)att_dim(bj, fq, n, 0) * 4u);
            const unsigned cof = 4u * (unsigned)(fq & 1) * 8u;
#pragma unroll
            for (int m = 0; m < 4; ++m)
#pragma unroll
                for (int h = 0; h < 2; ++h) ca[m][h] = *gas_at<const f32x4>(rope_a, (unsigned)((row0 + m * 16) & 2047) * 64u + cof + 16u * h);
            float rr[8];
            if (rt.tab) rstd8_tab(rt, u, wr, fr, rr); else rstd8_ss16(ss, row0, fq, rr);
            asm volatile("" ::: "memory");
#pragma unroll
            for (int gi = 0; gi < 8; ++gi) rr[gi] *= dsc;
            f32x4 ksum[2][2];
#pragma unroll
            for (int bj = 0; bj < 2; ++bj)
#pragma unroll
                for (int n = 0; n < 2; ++n) ksum[bj][n] = (f32x4){0.f, 0.f, 0.f, 0.f};
#pragma unroll
            for (int ai = 0; ai < 2; ++ai)
#pragma unroll
                for (int m = 0; m < 4; ++m) {
                    const int row = row0 + ai * HALF + m * 16; const float r = rr[ai * 4 + m];
                    const f32x4 c01 = ca[m][0], c23 = ca[m][1];
                    if (ai == 0) {
#pragma unroll
                        for (int h = 0; h < 2; ++h) ca[m][h] = *gas_at<const f32x4>(rope_a, (unsigned)((row0 + HALF + m * 16) & 2047) * 64u + cof + 16u * h);
                    }
                    float sq = 0.f;
#pragma unroll
                    for (int bj = 0; bj < 2; ++bj)
#pragma unroll
                        for (int n = 0; n < 2; ++n) { const f32x4 a = acc[ai][bj][m][n]; sq += (a[0] * a[0] + a[1] * a[1]) + (a[2] * a[2] + a[3] * a[3]); }
                    sq += __shfl_xor(sq, 16); sq += __shfl_xor(sq, 32);
                    const float s = r * __builtin_amdgcn_rsqf(sq * (r * r) * (1.0f / 64.0f) + 1e-6f);
#pragma unroll
                    for (int bj = 0; bj < 2; ++bj) {
                        f32x4 y0 = acc[ai][bj][m][0] * s * gg[bj][0], y1 = acc[ai][bj][m][1] * s * gg[bj][1];
                        if (bj == 0 && fq < 2) {
                            const f32x4 cv = {c01[0], c01[2], c23[0], c23[2]}, sv = {c01[1], c01[3], c23[1], c23[3]};
                            const f32x4 x1 = y0, x2 = y1; y0 = x1 * cv - x2 * sv; y1 = x2 * cv + x1 * sv;
                        }
                        if (isk) { ksum[bj][0] += y0; ksum[bj][1] += y1; }
                        asm volatile("" : "+v"(ksum[bj][0]), "+v"(ksum[bj][1]));
                        const f32x4 v0 = y0 * qs, v1 = y1 * qs;
                        u32x4 w; w.x = cvt_pk_bf16(v0[0], v0[1]); w.y = cvt_pk_bf16(v0[2], v0[3]); w.z = cvt_pk_bf16(v1[0], v1[1]); w.w = cvt_pk_bf16(v1[2], v1[3]);
                        *(PG8_LAS u32x4*)(tb + fr * 144 + bj * 64 + fq * 16) = w;
                        asm volatile("" ::: "memory");
                    }
                    PG8_EMIT_ROWS();
                }
            if (isk) {
                const unsigned kmo = ((unsigned)(((u.pm >> 3) * 8 + 4 * (pn & 1) + wc) * 8 + (u.pm & 7)) * 64u + 8u * (unsigned)fq) * 4u;
#pragma unroll
                for (int bj = 0; bj < 2; ++bj)
#pragma unroll
                    for (int n = 0; n < 2; ++n)
#pragma unroll
                        for (int i = 0; i < 4; ++i) { float v = ksum[bj][n][i]; v += __shfl_xor(v, 1); v += __shfl_xor(v, 2); v += __shfl_xor(v, 4); v += __shfl_xor(v, 8);
                            if (fr == 0) __hip_atomic_fetch_add(gas_at<float>(kmean, kmo + (unsigned)(32 * bj + 4 * n + i) * 4u), v * (1.0f / 256.0f), __ATOMIC_RELAXED, __HIP_MEMORY_SCOPE_AGENT); }
            }
        } else {
            PG8_EPI_LANE();
            float rr[8]; if (rt.tab) rstd8_tab(rt, u, wr, fr, rr); else rstd8_ss16(ss, row0, fq, rr);
#pragma unroll
            for (int ai = 0; ai < 2; ++ai)
#pragma unroll
                for (int m = 0; m < 4; ++m) {
                    const int row = row0 + ai * HALF + m * 16; const float r = rr[ai * 4 + m] * dsc;
#pragma unroll
                    for (int bj = 0; bj < 2; ++bj) { const f32x4 v0 = acc[ai][bj][m][0] * r, v1 = acc[ai][bj][m][1] * r;
                        u32x4 w; w.x = cvt_pk_bf16(v0[0], v0[1]); w.y = cvt_pk_bf16(v0[2], v0[3]); w.z = cvt_pk_bf16(v1[0], v1[1]); w.w = cvt_pk_bf16(v1[2], v1[3]);
                        *(PG8_LAS u32x4*)(tb + fr * 144 + bj * 64 + fq * 16) = w; }
                    PG8_EMIT_ROWS();
                }
        }
#undef PG8_EPI_LANE
#undef PG8_EMIT_ROWS
    }
};

struct EpiNone {
    static constexpr bool PERM = true, AFTER_DRAIN = false, BADJ = false; static constexpr int NSTORE = 0;
    __device__ __forceinline__ void operator()(const f32x4 (&acc)[2][2][4][2], const Unit&, int, int, int, int) const {
#pragma unroll
        for (int a = 0; a < 2; ++a)
#pragma unroll
            for (int b = 0; b < 2; ++b)
#pragma unroll
                for (int m = 0; m < 4; ++m)
#pragma unroll
                    for (int n = 0; n < 2; ++n) asm volatile("" :: "v"(acc[a][b][m][n]));
    }
};
struct Row0Order : StaticOrder { __host__ __device__ bool next(int i, Unit& u) const { const bool r = StaticOrder::next(i, u); u.pm = 0; return r; } };
struct EpiProj {
    static constexpr bool PERM = true, AFTER_DRAIN = false, BADJ = false; static constexpr int NSTORE = 16;
    bf16_t* O; int ldo; const float* ss;
    __device__ __forceinline__ void operator()(const f32x4 (&acc)[2][2][4][2], const Unit& u, int wr, int wc, int fr, int fq) const {
        const int row0 = u.pm * BM + wr * 64 + fr; const int col0 = u.pn * BM + wc * 32 + 8 * fq;
#pragma unroll
        for (int ai = 0; ai < 2; ++ai)
#pragma unroll
            for (int m = 0; m < 4; ++m) {
                const int row = row0 + ai * HALF + m * 16; const float r = rstd_ss16(ss, row);
#pragma unroll
                for (int bj = 0; bj < 2; ++bj) { const f32x4 v0 = acc[ai][bj][m][0] * r, v1 = acc[ai][bj][m][1] * r;
                    u32x4 w; w.x = cvt_pk_bf16(v0[0], v0[1]); w.y = cvt_pk_bf16(v0[2], v0[3]); w.z = cvt_pk_bf16(v1[0], v1[1]); w.w = cvt_pk_bf16(v1[2], v1[3]);
                    *(u32x4*)(O + (size_t)row * ldo + col0 + bj * HALF) = w; }
            }
    }
};

#ifndef MK_RELAX
#define MK_RELAX 0
#endif
template <class Epi, class Sched, bool ALIGN_EPI = false, bool SP2 = false, bool FP8 = false, int ALAYOUT = 0>
__device__ __forceinline__ void gemm_phase(PG8_LAS unsigned char* lds, const Gemm g, const Sched& S, const Epi& E, const int wv  ) {
    int tid_ = wv * 64 + mk_lane(); asm volatile("" : "+v"(tid_));
    const int tid = tid_, wid = __builtin_amdgcn_readfirstlane(tid >> 6), lane = tid & 63, wr = wid >> 2, wc = wid & 3, fr = lane & 15, fq = lane >> 4;
    const int K = g.K, nt = FP8 ? K / (2 * BK) : K / BK;
    unsigned voffA[2], voffB[2];
#pragma unroll
    for (int i = 0; i < 2; ++i) { int R, C; stage_rc(tid * 16 + i * 8192, R, C); const int Rb = Epi::PERM ? ((R & ~31) + perm32(R & 31)) : R;
        voffA[i] = ALAYOUT == 2 ? (unsigned)((C >> 5) * 16384 + R * 64 + ((C >> 3) & 3) * 16) : ALAYOUT == 1 ? a8_block_off(C >> 4, R, (C >> 3) & 1) : (FP8 ? (unsigned)(R * K + C * 2) : (unsigned)(R * K + C) * 2u); const int Rb2 = Epi::BADJ ? 64 * (Rb >> 5) + (Rb & 31) : Rb; voffB[i] = FP8 ? (unsigned)(Rb2 * K + C * 2) : (unsigned)(Rb2 * K + C) * 2u; }
    const size_t kstep = (size_t)(BK * 2);
    const size_t hstep = FP8 ? (size_t)HALF * K : (size_t)HALF * K * 2;
    const size_t tstep = 2 * hstep;
    const size_t hstepB = Epi::BADJ ? hstep / 4 : hstep;
    const size_t kstepA = ALAYOUT != 0 ? (size_t)32768 : kstep, hstepA = ALAYOUT == 1 ? (size_t)4096 : (ALAYOUT == 2 ? (size_t)8192 : hstep);
    const unsigned ldsw = (unsigned)wid * 1024u;
    const int aoff = lds_byte(wr * 64 + fr, fq * 8), boff = lds_byte(wc * 32 + fr, fq * 8);
    const PG8_LAS unsigned char* ldsB = lds + 4 * HTB + boff; asm volatile("" : "+v"(ldsB));
#define PG8_SA(b, h) (((b) * 2 + (h)) * HTB)
#define PG8_SB(b, h) ((4 + (b) * 2 + (h)) * HTB)
#define PG8_STAGE(bufoff, gbase, voff) do { _Pragma("unroll") for (int _i = 0; _i < 2; ++_i) { unsigned vo_ = (voff)[_i]; asm volatile("" : "+v"(vo_)); \
        __builtin_amdgcn_global_load_lds((const unsigned*)((const char*)(gbase) + vo_), (PG8_LAS unsigned*)(lds + (bufoff) + ldsw + _i * 8192), 16, 0, 0); } } while (0)
#define PG8_LDA(dst, b, h) do { _Pragma("unroll") for (int m = 0; m < 4; ++m) _Pragma("unroll") for (int k = 0; k < 2; ++k) dst[m][k] = *(const PG8_LAS bf16x8*)(lds + PG8_SA(b, h) + aoff + m * 2048 + k * 1024); } while (0)
#define PG8_LDB(dst, b, h) do { _Pragma("unroll") for (int n = 0; n < 2; ++n) _Pragma("unroll") for (int k = 0; k < 2; ++k) dst[n][k] = *(const PG8_LAS bf16x8*)(ldsB + (PG8_SB(b, h) - 4 * HTB) + n * 2048 + k * 1024); } while (0)
#define PG8_MMA(ai, bj, At, Bt) do { __builtin_amdgcn_s_setprio(1); _Pragma("unroll") for (int m = 0; m < 4; ++m) _Pragma("unroll") for (int n = 0; n < 2; ++n) { \
        if constexpr (FP8) { acc[ai][bj][m][n] = __builtin_amdgcn_mfma_scale_f32_16x16x128_f8f6f4(cat8(Bt[n][0], Bt[n][1]), cat8(At[m][0], At[m][1]), acc[ai][bj][m][n], 0, 0, 0, 0, 0, 0); } \
        else { _Pragma("unroll") for (int k = 0; k < 2; ++k) acc[ai][bj][m][n] = __builtin_amdgcn_mfma_f32_16x16x32_bf16(Bt[n][k], At[m][k], acc[ai][bj][m][n], 0, 0, 0); } } __builtin_amdgcn_s_setprio(0); } while (0)
#define PG8_WAIT_V(n) asm volatile("s_waitcnt vmcnt(" #n ")" ::: "memory")
#define PG8_WAIT_L(n) asm volatile("s_waitcnt lgkmcnt(" #n ")" ::: "memory")
#define PG8_WAIT_V8X() do { if (rx) asm volatile("s_waitcnt vmcnt(%0)" :: "n"(8 + Epi::NSTORE) : "memory"); else asm volatile("s_waitcnt vmcnt(8)" ::: "memory"); } while (0)
#define PG8_BAR __builtin_amdgcn_s_barrier()
#define PG8_SCHED __builtin_amdgcn_sched_barrier(0)
    Unit cur, nxt; int ui = 0;
    if (!S.next(0, cur)) return;
    f32x4 acc[2][2][4][2];
#pragma unroll
    for (int a = 0; a < 2; ++a)
#pragma unroll
        for (int b = 0; b < 2; ++b)
#pragma unroll
            for (int m = 0; m < 4; ++m)
#pragma unroll
                for (int n = 0; n < 2; ++n) acc[a][b][m][n] = (f32x4){0.f, 0.f, 0.f, 0.f};
    bf16x8 At[4][2], B0[2][2], B1[2][2];
    const char* cA = (const char*)g.A + (size_t)cur.pm * tstep; const char* cB = (const char*)g.Bt + (size_t)cur.pn * tstep;
    S.a_ready(cur);
    if constexpr (SP2) {
        PG8_STAGE(PG8_SB(0, 0), cB, voffB); PG8_STAGE(PG8_SB(0, 1), cB + hstepB, voffB); PG8_STAGE(PG8_SA(0, 0), cA, voffA); PG8_STAGE(PG8_SA(0, 1), cA + hstepA, voffA);
        if (wr == 1) PG8_BAR;
        PG8_WAIT_V(2); PG8_BAR;
        PG8_STAGE(PG8_SB(1, 0), cB + kstep, voffB); PG8_STAGE(PG8_SA(1, 0), cA + kstepA, voffA); PG8_STAGE(PG8_SB(1, 1), cB + hstepB + kstep, voffB);
        PG8_WAIT_V(6); PG8_BAR;
    } else {
        PG8_STAGE(PG8_SB(0, 0), cB, voffB); PG8_STAGE(PG8_SA(0, 0), cA, voffA); PG8_STAGE(PG8_SB(0, 1), cB + hstepB, voffB); PG8_STAGE(PG8_SA(0, 1), cA + hstepA, voffA);
        if (wr == 1) PG8_BAR;
        PG8_WAIT_V(4); PG8_BAR;
        PG8_STAGE(PG8_SB(1, 0), cB + kstep, voffB); PG8_STAGE(PG8_SA(1, 0), cA + kstepA, voffA); PG8_STAGE(PG8_SB(1, 1), cB + hstepB + kstep, voffB);
        PG8_WAIT_V(6); PG8_BAR;
    }
    for (;;) {
        const bool has_next = S.next(ui + 1, nxt);
        const char* nA = has_next ? (const char*)g.A + (size_t)nxt.pm * tstep : cA; const char* nB = has_next ? (const char*)g.Bt + (size_t)nxt.pn * tstep : cB;
#pragma unroll 1
        for (int t = 0; t < nt; t += 2) {
            const bool last = (t == nt - 2); const bool rx = (t == 0) && (ui > 0) && (Epi::NSTORE > 0) && MK_RELAX;
            const char* a1 = cA + (size_t)(t + 1) * kstepA;
            const char* a2 = last ? nA : cA + (size_t)(t + 2) * kstepA; const char* b2 = last ? nB : cB + (size_t)(t + 2) * kstep;
            const char* a3 = a2 + kstepA; const char* b3 = b2 + kstep;
            if (last && has_next) S.a_ready(nxt);
            if constexpr (SP2) {
            PG8_LDB(B0, 0, 0); PG8_LDB(B1, 0, 1); PG8_SCHED; PG8_LDA(At, 0, 0); PG8_STAGE(PG8_SA(1, 1), a1 + hstepA, voffA);
            PG8_WAIT_V8X(); PG8_WAIT_L(0); PG8_BAR; PG8_MMA(0, 0, At, B0); PG8_MMA(0, 1, At, B1); PG8_BAR; PG8_SCHED;
            PG8_LDA(At, 0, 1); PG8_STAGE(PG8_SB(0, 0), b2, voffB); PG8_STAGE(PG8_SB(0, 1), b2 + hstepB, voffB); PG8_STAGE(PG8_SA(0, 0), a2, voffA);
            PG8_WAIT_V8X(); PG8_WAIT_L(0); PG8_BAR; PG8_MMA(1, 0, At, B0); PG8_MMA(1, 1, At, B1); PG8_BAR; PG8_SCHED;
            PG8_LDB(B0, 1, 0); PG8_LDB(B1, 1, 1); PG8_SCHED; PG8_LDA(At, 1, 0); PG8_STAGE(PG8_SA(0, 1), a2 + hstepA, voffA);
            PG8_WAIT_V(8); PG8_WAIT_L(0); PG8_BAR; PG8_MMA(0, 0, At, B0); PG8_MMA(0, 1, At, B1); PG8_BAR; PG8_SCHED;
            PG8_LDA(At, 1, 1); PG8_STAGE(PG8_SB(1, 0), b3, voffB); PG8_STAGE(PG8_SB(1, 1), b3 + hstepB, voffB); PG8_STAGE(PG8_SA(1, 0), a3, voffA);
            PG8_WAIT_V(8); PG8_WAIT_L(0); PG8_BAR; PG8_MMA(1, 0, At, B0); PG8_MMA(1, 1, At, B1); PG8_BAR; PG8_SCHED;
            } else {
            PG8_LDB(B0, 0, 0); PG8_SCHED; PG8_LDA(At, 0, 0); PG8_STAGE(PG8_SA(1, 1), a1 + hstepA, voffA);
            PG8_WAIT_L(8); PG8_BAR; PG8_WAIT_L(0); PG8_MMA(0, 0, At, B0); PG8_BAR; PG8_SCHED;
            PG8_LDB(B1, 0, 1); PG8_STAGE(PG8_SB(0, 0), b2, voffB);
            PG8_BAR; PG8_WAIT_L(0); PG8_MMA(0, 1, At, B1); PG8_BAR;
            PG8_LDA(At, 0, 1); PG8_STAGE(PG8_SA(0, 0), a2, voffA);
            PG8_BAR; PG8_WAIT_L(0); PG8_MMA(1, 0, At, B0); PG8_BAR; PG8_SCHED;
            PG8_STAGE(PG8_SB(0, 1), b2 + hstepB, voffB);
            PG8_WAIT_V(6); PG8_BAR; PG8_MMA(1, 1, At, B1); PG8_BAR;
            PG8_LDB(B0, 1, 0); PG8_SCHED; PG8_LDA(At, 1, 0); PG8_STAGE(PG8_SA(0, 1), a2 + hstepA, voffA);
            PG8_WAIT_L(8); PG8_BAR; PG8_WAIT_L(0); PG8_MMA(0, 0, At, B0); PG8_BAR; PG8_SCHED;
            PG8_LDB(B1, 1, 1); PG8_STAGE(PG8_SB(1, 0), b3, voffB);
            PG8_BAR; PG8_WAIT_L(0); PG8_MMA(0, 1, At, B1); PG8_BAR;
            PG8_LDA(At, 1, 1); PG8_STAGE(PG8_SA(1, 0), a3, voffA);
            PG8_BAR; PG8_WAIT_L(0); PG8_MMA(1, 0, At, B0); PG8_BAR; PG8_SCHED;
            PG8_STAGE(PG8_SB(1, 1), b3 + hstepB, voffB);
            PG8_WAIT_V(6); PG8_BAR; PG8_MMA(1, 1, At, B1); PG8_BAR;
            }
        }
        if constexpr (ALIGN_EPI) { if (wr == 0) PG8_BAR; }
        if constexpr (!Epi::AFTER_DRAIN) { const int le_ = mk_lane(); E(acc, cur, wr, wc, le_ & 15, le_ >> 4); S.done(cur); }
        if (!has_next) break;
#pragma unroll
        for (int a = 0; a < 2; ++a)
#pragma unroll
            for (int b = 0; b < 2; ++b)
#pragma unroll
                for (int m = 0; m < 4; ++m)
#pragma unroll
                    for (int n = 0; n < 2; ++n) acc[a][b][m][n] = (f32x4){0.f, 0.f, 0.f, 0.f};
        cur = nxt; cA = nA; cB = nB; ++ui;
        if constexpr (ALIGN_EPI) { if (wr == 1) PG8_BAR; }
    }
    PG8_WAIT_V(0);
    if constexpr (!ALIGN_EPI) { if (wr == 0) PG8_BAR; }
    PG8_BAR;
    if constexpr (Epi::AFTER_DRAIN) { E.fused(acc, cur, wr, wc, fr, fq, lds, wid, lane); S.done(cur); }
#undef PG8_SA
#undef PG8_SB
#undef PG8_STAGE
#undef PG8_LDA
#undef PG8_LDB
#undef PG8_MMA
#undef PG8_WAIT_V
#undef PG8_WAIT_V8X
#undef PG8_WAIT_L
#undef PG8_BAR
#undef PG8_SCHED
}
}
#include <hip/hip_bf16.h>
#ifndef ATTN_OUT_FP8
#define ATTN_OUT_FP8 MK_FP8_WOUT
#endif
#include <cmath>
namespace attn_body {
using bf16=__hip_bfloat16;
using bf16x8=__attribute__((ext_vector_type(8)))short;
using s16x4=__attribute__((ext_vector_type(4)))short;
using f32x16=__attribute__((ext_vector_type(16)))float;
using u32x4=__attribute__((ext_vector_type(4)))unsigned;
constexpr int BATCH=32,NHEAD=8,SEQ=2048,D=64,DM=3584,OP=1024;
constexpr int NW=8,QBLK=32,QB=QBLK*NW,KVBLK=64,NQB=SEQ/QB;
constexpr int ATTN_PITCH=DM, ATTN_UNIT_ROWS=QB;
__device__ __forceinline__ int crow(int r,int hi){return (r&3)+8*(r>>2)+4*hi;}
#define SBAR() __builtin_amdgcn_sched_barrier(0)
__device__ __forceinline__ void cmask(f32x16&p0,f32x16&p1,int jb,int qrel,int hi){
  const float NEG=-INFINITY; int kb=64*jb+4*hi;
  #pragma unroll
  for(int r=0;r<16;++r){int kv=kb+(r&3)+8*(r>>2); if(kv>qrel)p0[r]=NEG; if(kv+32>qrel)p1[r]=NEG;}
}

constexpr int NSLOT=3, SLOTB=8192;
constexpr int LDS_K=0, LDS_V=NSLOT*SLOTB, LDS_WS=2*NSLOT*SLOTB, LDS_OST=LDS_WS+NW*64*4, LDS_BYTES=LDS_OST+NW*4096;
constexpr float C2=0.125f*1.4426950408889634f;
__device__ __forceinline__ void glds16(const void*gsrc,unsigned lds_dst){unsigned keep;
  asm volatile("s_mov_b32 %0, m0\n\ts_mov_b32 m0, %2\n\ts_nop 0\n\tglobal_load_lds_dwordx4 %1, off\n\ts_mov_b32 m0, %0":"=&s"(keep):"v"(gsrc),"s"(lds_dst):"memory");}
__device__ __forceinline__ float max3f(float a,float b,float c){float r;asm("v_max3_f32 %0, %1, %2, %3":"=v"(r):"v"(a),"v"(b),"v"(c));return r;}
__device__ __forceinline__ float max2f(float a,float b){float r;asm("v_max_f32_e32 %0, %1, %2":"=v"(r):"v"(a),"v"(b));return r;}
__device__ __forceinline__ float fadd_s(float a,float b){float r;asm("v_add_f32_e32 %0, %1, %2":"=v"(r):"v"(a),"v"(b));return r;}
__device__ __forceinline__ float fsub_s(float a,float b){float r;asm("v_sub_f32_e32 %0, %1, %2":"=v"(r):"v"(a),"v"(b));return r;}
typedef float f32x2_t __attribute__((ext_vector_type(2))); typedef __bf16 bf16x2_t __attribute__((ext_vector_type(2)));
__device__ __forceinline__ unsigned cvtpk_s(float lo,float hi){f32x2_t v={lo,hi};bf16x2_t b=__builtin_convertvector(v,bf16x2_t);return __builtin_bit_cast(unsigned,b);}
#define WAIT_BAR(N) asm volatile("s_waitcnt vmcnt(" #N ") lgkmcnt(0)\n\ts_barrier":::"memory")

__device__ __forceinline__ void qkt(f32x16&p0,f32x16&p1,const char*Kslot,const bf16x8*qr,const f32x16&negm,int r32,int hi){
  const char*kb=Kslot+hi*1024+r32*16;
  #pragma unroll
  for(int d0=0;d0<4;++d0){
    const bf16x8 b0=*reinterpret_cast<const bf16x8*>(kb+d0*2048);
    const bf16x8 b1=*reinterpret_cast<const bf16x8*>(kb+d0*2048+512);
    if(d0==0){p0=__builtin_amdgcn_mfma_f32_32x32x16_bf16(b0,qr[0],negm,0,0,0);p1=__builtin_amdgcn_mfma_f32_32x32x16_bf16(b1,qr[0],negm,0,0,0);}
    else{p0=__builtin_amdgcn_mfma_f32_32x32x16_bf16(b0,qr[d0],p0,0,0,0);p1=__builtin_amdgcn_mfma_f32_32x32x16_bf16(b1,qr[d0],p1,0,0,0);}}
}
typedef __attribute__((address_space(3))) const char* lds_cptr;
typedef short v4i16_t __attribute__((ext_vector_type(4)));
__device__ __forceinline__ void kload8(bf16x8*kf,lds_cptr kp){
  kf[0]=*(const __attribute__((address_space(3))) bf16x8*)(kp);      kf[1]=*(const __attribute__((address_space(3))) bf16x8*)(kp+512);
  kf[2]=*(const __attribute__((address_space(3))) bf16x8*)(kp+2048); kf[3]=*(const __attribute__((address_space(3))) bf16x8*)(kp+2560);
  kf[4]=*(const __attribute__((address_space(3))) bf16x8*)(kp+4096); kf[5]=*(const __attribute__((address_space(3))) bf16x8*)(kp+4608);
  kf[6]=*(const __attribute__((address_space(3))) bf16x8*)(kp+6144); kf[7]=*(const __attribute__((address_space(3))) bf16x8*)(kp+6656);
}
__device__ __forceinline__ void kload2(bf16x8*kf,lds_cptr kp,int j){ kf[2*j]=*(const __attribute__((address_space(3))) bf16x8*)(kp+j*2048); kf[2*j+1]=*(const __attribute__((address_space(3))) bf16x8*)(kp+j*2048+512); }
__device__ __forceinline__ s16x4 vtr(lds_cptr p){ return __builtin_bit_cast(s16x4,__builtin_amdgcn_ds_read_tr16_b64_v4i16((__attribute__((address_space(3))) v4i16_t*)p)); }
__device__ __forceinline__ float rowmax(const f32x16&p0,const f32x16&p1){
  float a=max3f(p0[0],p0[1],p1[0]),b=max3f(p0[2],p0[3],p1[1]);a=max3f(a,p1[2],p1[3]);
  #pragma unroll
  for(int r=4;r<16;r+=4){a=max3f(a,p0[r],p0[r+1]);b=max3f(b,p0[r+2],p0[r+3]);a=max3f(a,p1[r],p1[r+1]);b=max3f(b,p1[r+2],p1[r+3]);}
  const float m=max2f(a,b);
  auto rr=__builtin_amdgcn_permlane32_swap(__float_as_uint(m),__float_as_uint(m),false,false);
  return max2f(__uint_as_float(rr[0]),__uint_as_float(rr[1]));
}
__device__ __forceinline__ void pv(f32x16*o,int vb,bf16x8 pa0,bf16x8 pa1,bf16x8 pa2,bf16x8 pa3){
  #pragma unroll
  for(int d0=0;d0<2;++d0){s16x4 lo[4],hi[4];
    #pragma unroll
    for(int ks=0;ks<4;++ks){
      asm volatile("ds_read_b64_tr_b16 %0,%1 offset:%c2":"=&v"(lo[ks]):"v"(vb),"i"(d0*4096+ks*1024):"memory");
      asm volatile("ds_read_b64_tr_b16 %0,%1 offset:%c2":"=&v"(hi[ks]):"v"(vb),"i"(d0*4096+ks*1024+512):"memory");}
    asm volatile("s_waitcnt lgkmcnt(0)":::"memory");SBAR();
    #define PK(k) (bf16x8){lo[k][0],lo[k][1],lo[k][2],lo[k][3],hi[k][0],hi[k][1],hi[k][2],hi[k][3]}
    o[d0]=__builtin_amdgcn_mfma_f32_32x32x16_bf16(pa0,PK(0),o[d0],0,0,0);
    o[d0]=__builtin_amdgcn_mfma_f32_32x32x16_bf16(pa1,PK(1),o[d0],0,0,0);
    o[d0]=__builtin_amdgcn_mfma_f32_32x32x16_bf16(pa2,PK(2),o[d0],0,0,0);
    o[d0]=__builtin_amdgcn_mfma_f32_32x32x16_bf16(pa3,PK(3),o[d0],0,0,0);
    #undef PK
  }
}

#ifndef ATTN_STORE16
#define ATTN_STORE16(p,v) (*(__attribute__((address_space(1))) u32x4*)(p)=(v))
#endif
template<int THRL> __device__ __forceinline__ void attn_unit(int b,int h,int qb,const bf16*Q,const bf16*K,const bf16*V,bf16*O,const float*kmean,const float*beta,char*shm,const int wv){
  int tid_o=wv*64+mk_lane(); asm volatile("":"+v"(tid_o));
  const int tid=tid_o,lane=tid&63,r32=lane&31,hi=lane>>5; const int wid=__builtin_amdgcn_readfirstlane(tid>>6);
  const long rowbase=(long)b*SEQ; const int q0=qb*QB;
  const int hoff=(h>>2)*256+(h&3)*64;
  const bf16*Qw=Q+(rowbase+q0+wid*QBLK)*DM+hoff;
  const bf16*Kh=K+rowbase*DM+hoff,*Vh=V+rowbase*DM+h*D;
  const unsigned lds0=(unsigned)(uintptr_t)shm;
  float*wsf=(float*)(shm+LDS_WS)+wid*64;
  const bf16*ksrc=Kh+(long)lane*DM+wid*8;
  const bf16*vsrc=Vh+(long)(16*(wid&3)+(lane>>2))*DM+(wid>>2)*32+(lane&3)*8;
  const unsigned kdst=lds0+LDS_K+wid*1024, vdst=lds0+LDS_V+wid*1024;
  #define DMA_K(t,slot) glds16(ksrc+(long)(t)*KVBLK*DM,(unsigned)__builtin_amdgcn_readfirstlane(kdst+(slot)))
  #define DMA_V(t,slot) glds16(vsrc+(long)(t)*KVBLK*DM,(unsigned)__builtin_amdgcn_readfirstlane(vdst+(slot)))
  const int vb0=(int)(lds0+LDS_V)+((lane>>4)&1)*32+(lane&3)*8+(4*hi+((lane&15)>>2))*64;
  const char*Kbase=shm+LDS_K; bf16x8 kf[8];
  const lds_cptr shm3=(lds_cptr)shm; const lds_cptr kp0=shm3+LDS_K+hi*1024+r32*16; const lds_cptr vp0=shm3+LDS_V+((lane>>4)&1)*32+(lane&3)*8+(4*hi+((lane&15)>>2))*64;
  const int NT=(q0+QB)/KVBLK;
  DMA_K(0,0);DMA_V(0,0);DMA_K(1,SLOTB);
  bf16x8 qr[4];
  #pragma unroll
  for(int d0=0;d0<4;++d0)qr[d0]=*reinterpret_cast<const bf16x8*>(&Qw[(long)r32*DM+d0*16+hi*8]);
  unsigned selbits=(2u<<qb)-1u;
  if(qb>3){
    float g[7];
    #pragma unroll
    for(int n=0;n<7;++n){ g[n]=-INFINITY;
      if(n<qb){ const float*km=kmean+((long)(b*NHEAD+h)*8+n)*64+hi*8; float a=0.f;
        #pragma unroll
        for(int d0=0;d0<4;++d0){ const float4 k0=*reinterpret_cast<const float4*>(km+d0*16),k1=*reinterpret_cast<const float4*>(km+d0*16+4); const bf16x8 qq=qr[d0];
          a+=__uint_as_float((unsigned)(unsigned short)qq[0]<<16)*k0.x+__uint_as_float((unsigned)(unsigned short)qq[1]<<16)*k0.y+__uint_as_float((unsigned)(unsigned short)qq[2]<<16)*k0.z+__uint_as_float((unsigned)(unsigned short)qq[3]<<16)*k0.w
            +__uint_as_float((unsigned)(unsigned short)qq[4]<<16)*k1.x+__uint_as_float((unsigned)(unsigned short)qq[5]<<16)*k1.y+__uint_as_float((unsigned)(unsigned short)qq[6]<<16)*k1.z+__uint_as_float((unsigned)(unsigned short)qq[7]<<16)*k1.w; }
        a+=__shfl_xor(a,32); g[n]=a; } }
    selbits=1u<<qb;
    #pragma unroll
    for(int n=0;n<7;++n){ int rank=0;
      #pragma unroll
      for(int m2=0;m2<7;++m2) if(m2!=n) rank+=((g[m2]>g[n])||(g[m2]==g[n]&&m2<n))?1:0;
      if(n<qb&&rank<3) selbits|=1u<<n; }
  }
  #define MWORD(t) ((unsigned)(((int)(selbits<<(31-((t)>>2))))>>31))
  float mhat=0.f,l_reg=0.f;f32x16 o[2];f32x16 negm; { float zf; asm volatile("v_mov_b32 %0, 0":"=v"(zf));
    _Pragma("unroll") for(int r=0;r<16;++r){o[0][r]=zf;o[1][r]=zf;negm[r]=zf;} } asm volatile("":"+v"(negm));
  const int qrel=wid*QBLK+r32;
  #define CMASK(P0,P1,t) do{int jb_=(t)-(NT-4); if(jb_>=0)cmask(P0,P1,jb_,qrel,hi);}while(0)
  bool resc=false;
  #define START(P0,P1) do{ const float rm=(selbits&1u)?rowmax(P0,P1):0.f; resc=false; \
    { const float dl=rm; mhat=fadd_s(mhat,dl); \
      _Pragma("unroll") for(int r=0;r<16;++r){P0[r]=fsub_s(P0[r],dl);P1[r]=fsub_s(P1[r],dl);} \
      _Pragma("unroll") for(int r=0;r<16;++r)negm[r]=-mhat; asm volatile("":"+v"(negm)); } \
    _Pragma("unroll") for(int r=0;r<16;++r)P0[r]=__builtin_amdgcn_exp2f(P0[r]); }while(0)
  #define RESC() do{ if(resc){ asm volatile("s_waitcnt lgkmcnt(0)":::"memory"); \
      _Pragma("unroll") for(int d_=0;d_<2;++d_) _Pragma("unroll") for(int r=0;r<16;++r)o[d_][r]*=wsf[crow(r,hi)]; } }while(0)
  f32x16 pA0,pA1,pB0,pB1;
  int sl_prev=0,sl_cur=0,sl_next=SLOTB;
  #define ROT() do{sl_prev=sl_cur;sl_cur=sl_next;sl_next=(sl_next==(NSLOT-1)*SLOTB)?0:sl_next+SLOTB;}while(0)
  DMA_K(2,2*SLOTB);
  WAIT_BAR(3);
  qkt(pA0,pA1,Kbase,qr,negm,r32,hi);asm volatile("s_nop 15\n\ts_nop 7":"+v"(pA0),"+v"(pA1));CMASK(pA0,pA1,0);
  START(pA0,pA1);
  _Pragma("unroll") for(int r=0;r<16;++r)pA1[r]=__builtin_amdgcn_exp2f(pA1[r]);
  WAIT_BAR(0);
  DMA_K(3,0);DMA_V(1,SLOTB);
  ROT();
  kload8(kf,kp0+sl_cur);
  WAIT_BAR(2);
  s16x4 vlo[8],vhi[8]; u32x4 pw0,pw1,pw2,pw3;
  #define PKW(P,B) (cvtpk_s(P[B],P[B+1])&mwp_)
  #define PAF(k) __builtin_bit_cast(bf16x8,pw##k)
  #define VFR(i) (bf16x8){vlo[i][0],vlo[i][1],vlo[i][2],vlo[i][3],vhi[i][0],vhi[i][1],vhi[i][2],vhi[i][3]}
  #define PIN(x) asm volatile("":"+v"(x))
  #define MX3(a,b,c) __builtin_fmaxf(__builtin_fmaxf((a),(b)),(c))
  #define GAPA(MF,A0,A1,A2,A3,W0,W1,PW) do{ MF; sacc+=A0; sacc+=A1; sacc+=A2; sacc+=A3; PIN(sacc); W0; W1; PIN(PW); SBAR(); }while(0)
  #define EX(v) __builtin_amdgcn_exp2f(v)
  #define GAPB(MF,X,B) do{ MF; X[B]=EX(X[B]); X[B+1]=EX(X[B+1]); X[B+2]=EX(X[B+2]); X[B+3]=EX(X[B+3]); PIN(X); SBAR(); }while(0)
  #define VRD(i) do{ vlo[i]=vtr(vp_+(((i)>>2)*4096+((i)&3)*1024)); vhi[i]=vtr(vp_+(((i)>>2)*4096+((i)&3)*1024+512)); }while(0)
  #define KRD(G,j) do{ if(G){ kload2(kf,kp0+sl_next,j); SBAR(); } }while(0)
  #define STEP(C0,C1,P0,P1,t,GK,GV,GL) do{ SBAR(); \
    const unsigned mwp_=MWORD((t)-1), mwc_=MWORD(t); \
    const lds_cptr vp_=vp0+sl_prev; \
    VRD(0); SBAR(); float sacc=(P0[0]+P0[1]); \
    GAPA(C0=__builtin_amdgcn_mfma_f32_32x32x16_bf16(kf[0],qr[0],negm,0,0,0), P0[2],P0[3],P0[4],P0[5],     pw0[0]=PKW(P0,0), pw0[1]=PKW(P0,2), pw0); \
    VRD(4); SBAR(); GAPA(C1=__builtin_amdgcn_mfma_f32_32x32x16_bf16(kf[1],qr[0],negm,0,0,0), P0[6],P0[7],P0[8],P0[9],     pw0[2]=PKW(P0,4), pw0[3]=PKW(P0,6), pw0); \
    VRD(1); SBAR(); GAPA(C0=__builtin_amdgcn_mfma_f32_32x32x16_bf16(kf[2],qr[1],C0,0,0,0),   P0[10],P0[11],P0[12],P0[13], pw1[0]=PKW(P0,8), pw1[1]=PKW(P0,10), pw1); \
    VRD(5); SBAR(); GAPA(C1=__builtin_amdgcn_mfma_f32_32x32x16_bf16(kf[3],qr[1],C1,0,0,0),   P0[14],P0[15],P1[0],P1[1],   pw1[2]=PKW(P0,12),pw1[3]=PKW(P0,14), pw1); \
    VRD(2); SBAR(); GAPA(C0=__builtin_amdgcn_mfma_f32_32x32x16_bf16(kf[4],qr[2],C0,0,0,0),   P1[2],P1[3],P1[4],P1[5],     pw2[0]=PKW(P1,0), pw2[1]=PKW(P1,2), pw2); \
    VRD(6); SBAR(); GAPA(C1=__builtin_amdgcn_mfma_f32_32x32x16_bf16(kf[5],qr[2],C1,0,0,0),   P1[6],P1[7],P1[8],P1[9],     pw2[2]=PKW(P1,4), pw2[3]=PKW(P1,6), pw2); \
    VRD(3); SBAR(); GAPA(C0=__builtin_amdgcn_mfma_f32_32x32x16_bf16(kf[6],qr[3],C0,0,0,0),   P1[10],P1[11],P1[12],P1[13], pw3[0]=PKW(P1,8), pw3[1]=PKW(P1,10), pw3); \
    VRD(7); SBAR(); GAPA(C1=__builtin_amdgcn_mfma_f32_32x32x16_bf16(kf[7],qr[3],C1,0,0,0),   P1[14],P1[15],0.f,0.f,       pw3[2]=PKW(P1,12),pw3[3]=PKW(P1,14), pw3); \
    l_reg+=(mwp_?sacc:0.f); \
    if(GK){DMA_K((t)+3,sl_cur);} if(GV){DMA_V((t)+1,sl_next);} \
    CMASK(C0,C1,t); \
    { float a=MX3(C0[0],C0[1],C1[0]),b=MX3(C0[2],C0[3],C1[1]); a=MX3(a,C1[2],C1[3]); \
      _Pragma("unroll") for(int r=4;r<16;r+=4){a=MX3(a,C0[r],C0[r+1]);b=MX3(b,C0[r+2],C0[r+3]);a=MX3(a,C1[r],C1[r+1]);b=MX3(b,C1[r+2],C1[r+3]);} \
      float rm=__builtin_fmaxf(a,b); { auto rr=__builtin_amdgcn_permlane32_swap(__float_as_uint(rm),__float_as_uint(rm),false,false); rm=__builtin_fmaxf(__uint_as_float(rr[0]),__uint_as_float(rr[1])); } \
      rm=mwc_?rm:-INFINITY; resc=false; \
      if(__builtin_expect(__any(rm>(float)THRL),0)){ const float dl=__builtin_fmaxf(rm,0.f); mhat+=dl; \
        _Pragma("unroll") for(int r=0;r<16;++r){C0[r]-=dl;C1[r]-=dl;} \
        _Pragma("unroll") for(int r=0;r<16;++r)negm[r]=-mhat; asm volatile("":"+v"(negm)); \
        const float f=__builtin_amdgcn_exp2f(-dl); l_reg*=f; if(hi==0)wsf[r32]=f; resc=true; } } \
    SBAR(); \
    GAPB(o[0]=__builtin_amdgcn_mfma_f32_32x32x16_bf16(PAF(0),VFR(0),o[0],0,0,0), C0,0); \
    GAPB(o[1]=__builtin_amdgcn_mfma_f32_32x32x16_bf16(PAF(0),VFR(4),o[1],0,0,0), C0,4); \
    KRD(GL,0); GAPB(o[0]=__builtin_amdgcn_mfma_f32_32x32x16_bf16(PAF(1),VFR(1),o[0],0,0,0), C0,8); \
    KRD(GL,1); GAPB(o[1]=__builtin_amdgcn_mfma_f32_32x32x16_bf16(PAF(1),VFR(5),o[1],0,0,0), C0,12); \
    KRD(GL,2); GAPB(o[0]=__builtin_amdgcn_mfma_f32_32x32x16_bf16(PAF(2),VFR(2),o[0],0,0,0), C1,0); \
    KRD(GL,3); GAPB(o[1]=__builtin_amdgcn_mfma_f32_32x32x16_bf16(PAF(2),VFR(6),o[1],0,0,0), C1,4); \
    GAPB(o[0]=__builtin_amdgcn_mfma_f32_32x32x16_bf16(PAF(3),VFR(3),o[0],0,0,0), C1,8); \
    GAPB(o[1]=__builtin_amdgcn_mfma_f32_32x32x16_bf16(PAF(3),VFR(7),o[1],0,0,0), C1,12); \
    }while(0)
  int t=1;
  #undef CMASK
  #define CMASK(P0,P1,t) do{}while(0)
  for(;t+5<NT;t+=2){
    STEP(pB0,pB1,pA0,pA1,t,true,true,true);     WAIT_BAR(2); RESC(); ROT();
    STEP(pA0,pA1,pB0,pB1,t+1,true,true,true);   WAIT_BAR(2); RESC(); ROT();
  }
  #undef CMASK
  #define CMASK(P0,P1,t) do{int jb_=(t)-(NT-4); if(jb_>=0)cmask(P0,P1,jb_,qrel,hi);}while(0)
  #define ENDW(tt) do{ if((tt)+3<NT){WAIT_BAR(2);} else if((tt)+2<NT){WAIT_BAR(1);} else {WAIT_BAR(0);} }while(0)
  for(;t+1<NT;t+=2){
    STEP(pB0,pB1,pA0,pA1,t,(t+3<NT),(t+1<NT),(t+1<NT));       ENDW(t);   RESC(); ROT();
    STEP(pA0,pA1,pB0,pB1,t+1,(t+4<NT),(t+2<NT),(t+2<NT));     ENDW(t+1); RESC(); ROT();
  }
  STEP(pB0,pB1,pA0,pA1,NT-1,false,false,false); RESC();
  { const unsigned mwp_=0xffffffffu; float sacc=pB0[0]+pB0[1]; _Pragma("unroll") for(int r=2;r<16;++r)sacc+=pB0[r]; _Pragma("unroll") for(int r=0;r<16;++r)sacc+=pB1[r]; l_reg+=sacc;
    pw0=(u32x4){PKW(pB0,0),PKW(pB0,2),PKW(pB0,4),PKW(pB0,6)};pw1=(u32x4){PKW(pB0,8),PKW(pB0,10),PKW(pB0,12),PKW(pB0,14)};pw2=(u32x4){PKW(pB1,0),PKW(pB1,2),PKW(pB1,4),PKW(pB1,6)};pw3=(u32x4){PKW(pB1,8),PKW(pB1,10),PKW(pB1,12),PKW(pB1,14)};
    SBAR(); pv(o,vb0+sl_cur,PAF(0),PAF(1),PAF(2),PAF(3)); }
  #undef PKW
  #undef PAF
  #undef VFR
  #undef PIN
  #undef MX3
  #undef GAPA
  #undef GAPB
  #undef EX
  #undef VRD
  #undef KRD
  #undef STEP
  #undef ENDW
  {auto rr=__builtin_amdgcn_permlane32_swap(__float_as_uint(l_reg),__float_as_uint(l_reg),false,false);l_reg=__uint_as_float(rr[0])+__uint_as_float(rr[1]);}
  if(hi==0)wsf[32+r32]=l_reg;asm volatile("s_waitcnt lgkmcnt(0)":::"memory");
  float rli[16];
  #pragma unroll
  for(int r=0;r<16;++r)rli[r]=__builtin_amdgcn_rcpf(wsf[32+crow(r,hi)]);
  bf16*Ow=O+(rowbase+q0+wid*QBLK)*OP+h*D;
  typedef float f4g_ __attribute__((ext_vector_type(4)));
  const f4g_ bg0=*(const __attribute__((address_space(1))) f4g_*)(beta+h*D+(lane&7)*8), bg1=*(const __attribute__((address_space(1))) f4g_*)(beta+h*D+(lane&7)*8+4);
  { bf16*stg=(bf16*)(shm+LDS_OST)+wid*2048;
    #pragma unroll
    for(int r=0;r<16;++r){const int orow=crow(r,hi);
      #pragma unroll
      for(int d0=0;d0<2;++d0)stg[orow*64+d0*32+r32]=__float2bfloat16(o[d0][r]*rli[r]);}
    asm volatile("s_waitcnt lgkmcnt(0)":::"memory");
    int lane_e=lane; asm volatile("":"+v"(lane_e));
    #pragma unroll
    for(int i=0;i<4;++i){const int row=i*8+(lane_e>>3),ch=lane_e&7; const u32x4 v=*(const u32x4*)(stg+row*64+ch*8);
      float f[8]; f[0]=__uint_as_float(v.x<<16);f[1]=__uint_as_float(v.x&0xffff0000u);f[2]=__uint_as_float(v.y<<16);f[3]=__uint_as_float(v.y&0xffff0000u);f[4]=__uint_as_float(v.z<<16);f[5]=__uint_as_float(v.z&0xffff0000u);f[6]=__uint_as_float(v.w<<16);f[7]=__uint_as_float(v.w&0xffff0000u);
      float sq=((f[0]*f[0]+f[1]*f[1])+(f[2]*f[2]+f[3]*f[3]))+((f[4]*f[4]+f[5]*f[5])+(f[6]*f[6]+f[7]*f[7]));
      sq+=__shfl_xor(sq,1);sq+=__shfl_xor(sq,2);sq+=__shfl_xor(sq,4);
      const float rn=1.0f/sqrtf(sq*(1.0f/64.0f)+1e-6f);
      const float4 b0=make_float4(bg0[0],bg0[1],bg0[2],bg0[3]),b1=make_float4(bg1[0],bg1[1],bg1[2],bg1[3]);
#if ATTN_OUT_FP8
      { typedef unsigned u32x2_t __attribute__((ext_vector_type(2))); u32x2_t w8; w8.x=pg8::pk4_fp8(f[0]*rn*b0.x,f[1]*rn*b0.y,f[2]*rn*b0.z,f[3]*rn*b0.w); w8.y=pg8::pk4_fp8(f[4]*rn*b1.x,f[5]*rn*b1.y,f[6]*rn*b1.z,f[7]*rn*b1.w);
        MIX_STNT(w8,(__attribute__((address_space(1))) u32x2_t*)((unsigned char*)O+((rowbase+q0+wid*QBLK+row)*OP+h*D+ch*8))); }
#else
      u32x4 w; w.x=cvtpk_s(f[0]*rn*b0.x,f[1]*rn*b0.y);w.y=cvtpk_s(f[2]*rn*b0.z,f[3]*rn*b0.w);w.z=cvtpk_s(f[4]*rn*b1.x,f[5]*rn*b1.y);w.w=cvtpk_s(f[6]*rn*b1.z,f[7]*rn*b1.w);
      ATTN_STORE16(Ow+(long)row*OP+ch*8,w);
#endif
      } }
  asm volatile("s_waitcnt lgkmcnt(0)\n\ts_barrier":::"memory");
  #undef MWORD
  #undef DMA_K
  #undef DMA_V
  #undef CMASK
  #undef START
  #undef RESC
  #undef ROT
}
constexpr int ATTN_LDS_BYTES=LDS_BYTES;
struct AttnTensors { const bf16* Q; const bf16* K; const bf16* V; bf16* O; const float* kmean; const float* beta; };
struct AttnUnit { int bh; int qb; };
struct StaticOrder {
  int vcu,G;
  __device__ __forceinline__ explicit StaticOrder(int grid,int vcu_):vcu(vcu_),G(grid){}
  __device__ __forceinline__ bool next(int i,AttnUnit&u)const{
    if(G==256){ const int p=vcu>>1;
#ifndef MK_DEAL
#define MK_DEAL 22
#endif
#if MK_DEAL == 23
      if(vcu&1){ if(i>=12)return false; if(i<8){u.bh=2*p;u.qb=7-i;} else {u.bh=2*p+1; const int k=i-8; u.qb=(k==0)?5:(k==1)?3:(k==2)?1:0;} }
      else { if(i>=4)return false; u.bh=2*p+1; u.qb=(i==0)?7:(i==1)?6:(i==2)?4:2; }
#elif MK_DEAL == 24
      if(vcu&1){ if(i>=12)return false; if(i<8){u.bh=2*p;u.qb=7-i;} else {u.bh=2*p+1; const int k=i-8; u.qb=(k==0)?4:(k==1)?3:(k==2)?1:0;} }
      else { if(i>=4)return false; u.bh=2*p+1; u.qb=(i==0)?7:(i==1)?6:(i==2)?5:2; }
#elif MK_DEAL == 21
      if(vcu&1){ if(i>=12)return false; if(i<8){u.bh=2*p;u.qb=7-i;} else {u.bh=2*p+1; const int k=i-8; u.qb=(k==0)?5:(k==1)?3:(k==2)?2:1;} }
      else { if(i>=4)return false; u.bh=2*p+1; u.qb=(i==0)?7:(i==1)?6:(i==2)?4:0; }
#else
      if(vcu&1){ if(i>=12)return false; if(i<8){u.bh=2*p;u.qb=7-i;} else {u.bh=2*p+1; const int k=i-8; u.qb=(k==0)?5:(k==1)?3:(k==2)?2:0;} }
      else { if(i>=4)return false; u.bh=2*p+1; u.qb=(i==0)?7:(i==1)?6:(i==2)?4:1; }
#endif
      return true; }
    const int bh=vcu+(i>>3)*G; if(bh>=BATCH*NHEAD)return false; u.bh=bh; u.qb=7-(i&7); return true; }
  __device__ __forceinline__ void a_ready(const AttnUnit&)const{}
  __device__ __forceinline__ void done(const AttnUnit&)const{}
};
template<class Sched,int THRL=8> __device__ __forceinline__ void attn_phase(char*lds,const AttnTensors&T,const Sched&S,const int wv){
  AttnUnit u;
  for(int i=0;S.next(i,u);++i){ S.a_ready(u); attn_unit<THRL>(u.bh/NHEAD,u.bh%NHEAD,u.qb,T.Q,T.K,T.V,T.O,T.kmean,T.beta,lds,wv); S.done(u); }
}
#undef SBAR
#undef WAIT_BAR
}
#ifndef RET_OUT_FP8
#define RET_OUT_FP8 MK_FP8_WOUT
#define RGAS __attribute__((address_space(1)))
#ifndef MK_NT_RET
#define MK_NT_RET 0
#endif
#if MK_NT_RET
#define RET_LDNT(p) __builtin_nontemporal_load(p)
#else
#define RET_LDNT(p) (*(p))
#endif
#endif
namespace ret_body {
typedef short bf16x8 __attribute__((ext_vector_type(8)));
typedef short s16x4 __attribute__((ext_vector_type(4)));
typedef float f32x16 __attribute__((ext_vector_type(16)));
typedef unsigned u32x4 __attribute__((ext_vector_type(4)));
typedef unsigned u32x2 __attribute__((ext_vector_type(2)));
typedef float f32x4r __attribute__((ext_vector_type(4)));
#define RLAS __attribute__((address_space(3)))
constexpr int SEQ = 2048, INW = 3584, OP = 1024, PC_RQ = 0, PC_RK = 512, PC_RV = 1024, PC_RG = 1536;
constexpr int R0 = 0, R1 = 32768, R2 = 65536, R3 = 98304, RBETA = 131072 + 1024, RDEC = RBETA + 512, RET_LDS_END = RDEC + 512;
__device__ __forceinline__ int sw_off(int row, int ch) { return 256 * row + 16 * (ch ^ (((row & 3) << 2) | ((row >> 2) & 3))); }
__device__ __forceinline__ bf16x8 ld_row(const RLAS unsigned char* base, int row, int ch) { return *(const RLAS bf16x8*)(base + sw_off(row, ch)); }
__device__ __forceinline__ s16x4 tr4(const RLAS unsigned char* p) { typedef short v4i16_t __attribute__((ext_vector_type(4))); return __builtin_bit_cast(s16x4, __builtin_amdgcn_ds_read_tr16_b64_v4i16((RLAS v4i16_t*)p)); }
__device__ __forceinline__ bf16x8 ld_tr(const RLAS unsigned char* base, int k0, int c0ch, int lane) {
    const int g = lane >> 4, i = lane & 15, q = i >> 2, p = i & 3;
    const int row = k0 + 8 * (g >> 1) + q, ch = c0ch + 2 * (g & 1) + (p >> 1);
    const s16x4 lo = tr4(base + sw_off(row, ch) + 8 * (p & 1)), hi = tr4(base + sw_off(row + 4, ch) + 8 * (p & 1));
    return (bf16x8){lo[0], lo[1], lo[2], lo[3], hi[0], hi[1], hi[2], hi[3]};
}
__device__ __forceinline__ unsigned cvtpk(float lo, float hi) { typedef float f32x2_t __attribute__((ext_vector_type(2))); typedef __bf16 bf16x2_t __attribute__((ext_vector_type(2)));
    f32x2_t v = {lo, hi}; bf16x2_t b = __builtin_convertvector(v, bf16x2_t); return __builtin_bit_cast(unsigned, b); }
__device__ __forceinline__ float bflo(unsigned u) { return __uint_as_float(u << 16); }
__device__ __forceinline__ float bfhi(unsigned u) { return __uint_as_float(u & 0xffff0000u); }
#define RMFMA(a, b, c) __builtin_amdgcn_mfma_f32_32x32x16_bf16(a, b, c, 0, 0, 0)
#define OPQ1(a) asm volatile("" : "+v"(a))
#define OPQ2(a, b) asm volatile("" : "+v"(a), "+v"(b))

__device__ __forceinline__ void ret_unit(const unsigned short* PROJ, unsigned short* MIX, const float* beta_g, int b, int h, RLAS unsigned char* lds, const int w  ) {
#define LANE_IDX() const int lane = mk_lane(), tid = w * 64 + lane, l31 = lane & 31, hi = lane >> 5; (void)tid; (void)l31; (void)hi
    const int qi = w & 3, pb = w >> 2;
    const float gamma = 1.0f - exp2f(-5.0f - (float)h), lg = log2f(gamma);
    RLAS unsigned char* r0 = lds + R0; RLAS unsigned char* r1 = lds + R1; RLAS unsigned char* r2 = lds + R2; RLAS unsigned char* r3 = lds + R3;
    RLAS float* betas = (RLAS float*)(lds + RBETA); RLAS float* dtab = (RLAS float*)(lds + RDEC);
    { LANE_IDX(); for (int i = tid; i < 32768 / 16; i += 512) ((RLAS u32x4*)r3)[i] = (u32x4){0u, 0u, 0u, 0u};
      if (tid < 128) { betas[tid] = beta_g[h * 128 + tid]; dtab[tid] = __builtin_amdgcn_exp2f((float)tid * lg); } }
    f32x16 st[2];
#pragma unroll
    for (int j = 0; j < 2; ++j)
#pragma unroll
        for (int r = 0; r < 16; ++r) st[j][r] = 0.f;
    const float cd = exp2f(128.0f * lg);
    u32x4 gq[4], gk[4], gv[4];
#define RET_LOAD(cc) do { LANE_IDX(); const int lrow = tid >> 2, lcb = (tid & 3) * 4; const unsigned short* p = PROJ + ((size_t)b * SEQ + (cc) * 128 + lrow) * INW + h * 128 + lcb * 8; \
        const unsigned short* pqk = PROJ + ((size_t)b * SEQ + (cc) * 128 + lrow) * INW + (h >> 1) * 256 + (tid & 3) * 64 + (h & 1) * 32;     \
        _Pragma("unroll") for (int i = 0; i < 4; ++i) { gq[i] = RET_LDNT((const RGAS u32x4*)(pqk + PC_RQ + i * 8)); gk[i] = RET_LDNT((const RGAS u32x4*)(pqk + PC_RK + i * 8)); gv[i] = RET_LDNT((const RGAS u32x4*)(p + PC_RV + i * 8)); } } while (0)
    RET_LOAD(0);
#pragma unroll 1
    for (int c = 0; c < 16; ++c) {
        const size_t grow = (size_t)b * SEQ + c * 128;
        float lgc = lg; asm volatile("" : "+v"(lgc));
        {
            LANE_IDX(); const int lrow = tid >> 2, lcb = (tid & 3) * 4;
#pragma unroll
            for (int i = 0; i < 4; ++i) { *(RLAS u32x4*)(r0 + sw_off(lrow, lcb + i)) = gq[i]; *(RLAS u32x4*)(r1 + sw_off(lrow, lcb + i)) = gk[i]; *(RLAS u32x4*)(r2 + sw_off(lrow, lcb + i)) = gv[i]; }
        }
        __syncthreads();
        f32x16 ao[2], as[2];
        { LANE_IDX();
        float zf; asm volatile("v_mov_b32 %0, 0" : "=v"(zf));
#pragma unroll
        for (int j = 0; j < 2; ++j)
#pragma unroll
            for (int r = 0; r < 16; ++r) { ao[j][r] = zf; as[j][r] = zf; }
#pragma unroll 2
        for (int ks = 0; ks < 8; ++ks) {
            const bf16x8 bq = ld_row(r0, 32 * qi + l31, 2 * ks + hi);
#pragma unroll
            for (int j = 0; j < 2; ++j) { const bf16x8 a = ld_row(r3, 32 * (2 * pb + j) + l31, 2 * ks + hi); ao[j] = RMFMA(a, bq, ao[j]); }
#pragma unroll
            for (int j = 0; j < 2; ++j) if (2 * pb + j <= qi) { const bf16x8 a = ld_row(r1, 32 * (2 * pb + j) + l31, 2 * ks + hi); as[j] = RMFMA(a, bq, as[j]); }
        }
        const float qdec = __builtin_amdgcn_exp2f((float)(32 * qi + l31 + 1) * lgc);
#pragma unroll
        for (int j = 0; j < 2; ++j)
#pragma unroll
            for (int r = 0; r < 16; ++r) ao[j][r] *= qdec;
        }
        __syncthreads();
        { LANE_IDX();
#pragma unroll
        for (int j = 0; j < 2; ++j) if (2 * pb + j <= qi) {
            const int kb = 2 * pb + j, q = 32 * qi + l31;
#pragma unroll
            for (int g4 = 0; g4 < 4; ++g4) { float pv[4];
#pragma unroll
                for (int i = 0; i < 4; ++i) { const int key = 32 * kb + 8 * g4 + 4 * hi + i, diff = q - key; pv[i] = diff >= 0 ? as[j][4 * g4 + i] * dtab[diff >= 0 ? diff : 0] : 0.f; }
                u32x2 wv; wv.x = cvtpk(pv[0], pv[1]); wv.y = cvtpk(pv[2], pv[3]);
                *(RLAS u32x2*)(r0 + sw_off(q, 4 * kb + g4) + 8 * hi) = wv; }
        }
        }
        __syncthreads();
        if (c + 1 < 16) RET_LOAD(c + 1);
        u32x4 grg[4];
        { LANE_IDX(); const int lrow = tid >> 2, seg = tid & 3; const unsigned short* gp = PROJ + (grow + lrow) * INW + PC_RG + h * 128 + 32 * seg;
#pragma unroll
          for (int i = 0; i < 4; ++i) grg[i] = RET_LDNT((const RGAS u32x4*)(gp + 8 * i)); }
        { LANE_IDX();
#pragma unroll 2
        for (int ks = 0; ks < 8; ++ks) if (ks < 2 * qi + 2) {
            const bf16x8 bp = ld_row(r0, 32 * qi + l31, 2 * ks + hi);
#pragma unroll
            for (int j = 0; j < 2; ++j) { const bf16x8 a = ld_tr(r2, 16 * ks, 4 * (2 * pb + j), lane); ao[j] = RMFMA(a, bp, ao[j]); }
        }
#pragma unroll
        for (int j = 0; j < 2; ++j)
#pragma unroll
            for (int r = 0; r < 16; ++r) st[j][r] *= cd;
#pragma unroll 2
        for (int ks = 0; ks < 8; ++ks) {
            const bf16x8 ak = ld_tr(r1, 16 * ks, 4 * qi, lane);
            float kf[8];
            const f32x4r d0 = *(const RLAS f32x4r*)(dtab + 120 - 16 * ks - 8 * hi), d1 = *(const RLAS f32x4r*)(dtab + 124 - 16 * ks - 8 * hi);
            const float dk[8] = {d1[3], d1[2], d1[1], d1[0], d0[3], d0[2], d0[1], d0[0]};
#pragma unroll
            for (int i = 0; i < 8; ++i) kf[i] = __uint_as_float((unsigned)(unsigned short)ak[i] << 16) * dk[i];
            u32x4 aw; aw.x = cvtpk(kf[0], kf[1]); aw.y = cvtpk(kf[2], kf[3]); aw.z = cvtpk(kf[4], kf[5]); aw.w = cvtpk(kf[6], kf[7]);
            const bf16x8 a = __builtin_bit_cast(bf16x8, aw);
#pragma unroll
            for (int j = 0; j < 2; ++j) { const bf16x8 bv = ld_tr(r2, 16 * ks, 4 * (2 * pb + j), lane); st[j] = RMFMA(a, bv, st[j]); }
        }
        }
        __syncthreads();
        { LANE_IDX();
#pragma unroll
        for (int j = 0; j < 2; ++j) { const int eb = 2 * pb + j;
#pragma unroll
            for (int g4 = 0; g4 < 4; ++g4) {
                u32x2 wo; wo.x = cvtpk(ao[j][4 * g4 + 0], ao[j][4 * g4 + 1]); wo.y = cvtpk(ao[j][4 * g4 + 2], ao[j][4 * g4 + 3]);
                *(RLAS u32x2*)(r1 + sw_off(32 * qi + l31, 4 * eb + g4) + 8 * hi) = wo;
                u32x2 ws; ws.x = cvtpk(st[j][4 * g4 + 0], st[j][4 * g4 + 1]); ws.y = cvtpk(st[j][4 * g4 + 2], st[j][4 * g4 + 3]);
                *(RLAS u32x2*)(r3 + sw_off(32 * eb + l31, 4 * qi + g4) + 8 * hi) = ws; }
        }
        }
        __syncthreads();
        {
            LANE_IDX(); const int lrow = tid >> 2, seg = tid & 3; float o[32]; float sq = 0.f;
#pragma unroll
            for (int i = 0; i < 4; ++i) { const u32x4 v = *(const RLAS u32x4*)(r1 + sw_off(lrow, 4 * seg + i));
                o[8 * i + 0] = bflo(v.x); o[8 * i + 1] = bfhi(v.x); o[8 * i + 2] = bflo(v.y); o[8 * i + 3] = bfhi(v.y); o[8 * i + 4] = bflo(v.z); o[8 * i + 5] = bfhi(v.z); o[8 * i + 6] = bflo(v.w); o[8 * i + 7] = bfhi(v.w); }
#pragma unroll
            for (int i = 0; i < 32; ++i) sq += o[i] * o[i];
            sq += __shfl_xor(sq, 1); sq += __shfl_xor(sq, 2);
            const float rn = 1.0f / sqrtf(sq * (1.0f / 128.0f) + 1e-6f);
            unsigned short* op = MIX + (grow + lrow) * OP + h * 128 + 32 * seg;
#pragma unroll
            for (int i = 0; i < 4; ++i) { const u32x4 gr = grg[i];
                const float gg[8] = {bflo(gr.x), bfhi(gr.x), bflo(gr.y), bfhi(gr.y), bflo(gr.z), bfhi(gr.z), bflo(gr.w), bfhi(gr.w)};
                float y[8];
#pragma unroll
                for (int k = 0; k < 8; ++k) { const float g1 = gg[k]; const float sg = g1 * __builtin_amdgcn_rcpf(1.0f + __builtin_amdgcn_exp2f(-1.4426950408889634f * g1)); y[k] = o[8 * i + k] * rn * sg * betas[32 * seg + 8 * i + k]; }
#if RET_OUT_FP8
                { u32x2 w8; w8.x = pg8::pk4_fp8(y[0], y[1], y[2], y[3]); w8.y = pg8::pk4_fp8(y[4], y[5], y[6], y[7]);
                  MIX_STNT(w8, (__attribute__((address_space(1))) u32x2*)((unsigned char*)MIX + (grow + lrow) * OP + h * 128 + 32 * seg + 8 * i)); }
                if (i == 1) __builtin_amdgcn_sched_barrier(0); }
#else
                u32x4 wv; wv.x = cvtpk(y[0], y[1]); wv.y = cvtpk(y[2], y[3]); wv.z = cvtpk(y[4], y[5]); wv.w = cvtpk(y[6], y[7]);
                *(u32x4*)(op + 8 * i) = wv;
                if (i == 1) __builtin_amdgcn_sched_barrier(0); }
#endif
        }
        __syncthreads();
    }
}
#undef RET_LOAD
#undef LANE_IDX
#undef RMFMA
#undef OPQ1
#undef OPQ2
#undef RLAS
}
#define GAS __attribute__((address_space(1)))
#define LAS __attribute__((address_space(3)))
typedef unsigned short bf16;
typedef unsigned v4u __attribute__((ext_vector_type(4)));
typedef float f32x4 __attribute__((ext_vector_type(4)));
typedef short bf16x8 __attribute__((ext_vector_type(8)));
typedef GAS unsigned gu32;
typedef GAS unsigned long long gu64;
#define RLX_AGENT __ATOMIC_RELAXED, __HIP_MEMORY_SCOPE_AGENT
#define LDS_WAIT() asm volatile("s_waitcnt lgkmcnt(0)" ::: "memory")
#define VM_WAIT() asm volatile("s_waitcnt vmcnt(0)" ::: "memory")
__device__ __forceinline__ unsigned long long rt() { return __builtin_amdgcn_s_memrealtime(); }
__device__ __forceinline__ unsigned f2bf(float f) { unsigned u = __builtin_bit_cast(unsigned, f); return (u + 0x7fffu + ((u >> 16) & 1u)) >> 16; }
__device__ __forceinline__ unsigned pk2(float lo, float hi) { return f2bf(lo) | (f2bf(hi) << 16); }

#define XB_TMO      128
#define XB_XCNT(j)  (256  + 64 * (j))
#define XB_XSUB(j)  (1280 + 64 * (j))
#define XB_XGEN(j)  (2304 + 64 * (j))
#define XB_TOP      3328
#define XB_TOPGEN   3392
#define XCD_BAR_WORDS 3456
#define XB_SPIN_CAP (1u << 18)

__device__ __forceinline__ unsigned xb_ld(unsigned* p)              { return __hip_atomic_load(p, __ATOMIC_RELAXED, __HIP_MEMORY_SCOPE_AGENT); }
__device__ __forceinline__ unsigned xb_add(unsigned* p, unsigned v) { return __hip_atomic_fetch_add(p, v, __ATOMIC_RELAXED, __HIP_MEMORY_SCOPE_AGENT); }
__device__ __forceinline__ unsigned xb_xcc_id() { return (unsigned)__builtin_amdgcn_s_getreg((3 << 11) | 20) & 0xFu; }
#define XB_SPIN(cond, bar) do { unsigned _sp = 0; while (cond) { __builtin_amdgcn_s_sleep(1); \
    if ((++_sp & 255u) == 0u) { if (xb_ld(&(bar)[XB_TMO])) break; if (_sp > XB_SPIN_CAP) { atomicAdd(&(bar)[XB_TMO], 1u); break; } } } } while (0)

struct XcdBarrier {
    unsigned* bar; unsigned x;
    bool t0;
    volatile LAS unsigned* st;
};

__device__ __forceinline__ XcdBarrier xcd_barrier_post(unsigned* bar, volatile LAS unsigned* st) {
    XcdBarrier b; b.bar = bar; b.x = xb_xcc_id(); b.st = st; b.t0 = (threadIdx.x == 0);
    if (b.t0) (void)xb_add(&bar[XB_XCNT(b.x)], 1u);
    return b;
}
__device__ __forceinline__ void xcd_barrier_complete(unsigned* bar, unsigned x, unsigned& nloc, unsigned& nx) {
    const unsigned G = gridDim.x * gridDim.y * gridDim.z;
    unsigned sum, cnt, mine, sp = 0u;
    for (;;) {
        sum = 0u; cnt = 0u; mine = 0u;
#pragma unroll
        for (unsigned j = 0; j < 16; ++j) { const unsigned c = xb_ld(&bar[XB_XCNT(j)]); sum += c; cnt += (c > 0u) ? 1u : 0u; mine = (j == x) ? c : mine; }
        if (sum == G) break;
        __builtin_amdgcn_s_sleep(1);
        if ((++sp & 255u) == 0u) { if (xb_ld(&bar[XB_TMO])) break; if (sp > XB_SPIN_CAP) { atomicAdd(&bar[XB_TMO], 1u); break; } }
    }
    nloc = mine > 0u ? mine : 1u; nx = cnt > 0u ? cnt : 1u;
}

__device__ __forceinline__ void xcd_barrier(const XcdBarrier& b) {
    asm volatile("s_waitcnt vmcnt(0)" ::: "memory");
    __syncthreads();
    if (b.t0) {
        unsigned* bar = b.bar;
        __builtin_amdgcn_s_waitcnt(0);
        unsigned nloc = b.st[0], nx = b.st[1];
        if (nloc == 0u) { xcd_barrier_complete(bar, b.x, nloc, nx); b.st[0] = nloc; b.st[1] = nx; }
        const unsigned old = xb_add(&bar[XB_XSUB(b.x)], 1u);
        const unsigned gen = old / nloc;
        if (old + 1u == (gen + 1u) * nloc) {
            __builtin_amdgcn_fence(__ATOMIC_RELEASE, "agent");
            asm volatile("s_waitcnt vmcnt(0)" ::: "memory");
            const unsigned og = xb_add(&bar[XB_TOP], 1u);
            const unsigned tg = og / nx;
            if (og + 1u == (tg + 1u) * nx) xb_add(&bar[XB_TOPGEN], 1u);
            else XB_SPIN(xb_ld(&bar[XB_TOPGEN]) == tg, bar);
            __builtin_amdgcn_fence(__ATOMIC_ACQUIRE, "agent");
            xb_add(&bar[XB_XGEN(b.x)], 1u);
            asm volatile("s_waitcnt vmcnt(0)" ::: "memory");
        } else {
            XB_SPIN(xb_ld(&bar[XB_XGEN(b.x)]) == gen, bar);
            __builtin_amdgcn_fence(__ATOMIC_ACQUIRE, "agent");
            asm volatile("s_waitcnt vmcnt(0)" ::: "memory");
        }
    }
    __syncthreads();
}

#define LB_SUB(j) (64 * (j))
#define LB_GEN(j) (1024 + 64 * (j))
#define LB_WORDS 2048
__device__ __forceinline__ void xcc_local_barrier(const XcdBarrier& b, unsigned* lbar) {
    asm volatile("s_waitcnt vmcnt(0)" ::: "memory");
    __syncthreads();
    if (b.t0) {
        __builtin_amdgcn_s_waitcnt(0);
        unsigned nloc = b.st[0]; if (nloc == 0u) nloc = 1u;
        const unsigned old = xb_add(&lbar[LB_SUB(b.x)], 1u);
        const unsigned gen = old / nloc;
        if (old + 1u == (gen + 1u) * nloc) xb_add(&lbar[LB_GEN(b.x)], 1u);
        else XB_SPIN(xb_ld(&lbar[LB_GEN(b.x)]) == gen, b.bar);
        __builtin_amdgcn_fence(__ATOMIC_ACQUIRE, "agent");
        asm volatile("s_waitcnt vmcnt(0)" ::: "memory");
    }
    __syncthreads();
}

#ifndef PG8_SP2
#define PG8_SP2 true
#endif
#ifndef PG8_ALIGN
#define PG8_ALIGN true
#endif
#ifndef MK_DUP
#define MK_DUP (-1)
#endif
#ifndef MK_FP8
#define MK_FP8 1
#endif
#ifndef MK_FP8_P1
#define MK_FP8_P1 1
#endif
#ifndef MK_FP8_P2
#define MK_FP8_P2 1
#endif
#ifndef MK_STAGGER
#define MK_STAGGER 0
#endif
#ifndef MK_FP8_WIN
#define MK_FP8_WIN 0
#endif
#ifndef MK_LOCAL_BAR
#define MK_LOCAL_BAR 0
#endif
#ifndef MK_XSTAG_TICKS
#define MK_XSTAG_TICKS 0
#endif
#ifndef MK_PER_PHASE
#define MK_PER_PHASE 0
#endif

constexpr int NWAVES = 8;
constexpr int BATCH = 32, SEQ = 2048, D = 1024, M = BATCH * SEQ;
static_assert(pg8::SS_M == M, "row-statistics pitch");
constexpr int FF = 2816, INW = 3584;
constexpr int RH = 4, RD = 128, AH = 8, AD = 64, NBLK = 8, BLK = 256;
constexpr int PC_RQ = 0, PC_RK = 512, PC_RV = 1024, PC_RG = 1536, PC_AQ = 2048, PC_AK = 2560, PC_AV = 3072;
constexpr float EPS = 1e-6f;
constexpr float C2 = 0.125f * 1.4426950408889634f;
constexpr int N_PHASES = 10;

constexpr size_t MiB = 1u << 20;
constexpr size_t WS_CTL = 0, CTL_ZERO_BYTES = 1 * MiB;
constexpr size_t WS_W1A = 2 * MiB, WS_WD1 = 14 * MiB, WS_WIN = 20 * MiB, WS_WOUT = 27 * MiB, WS_W2A = 29 * MiB, WS_WD2 = 40 * MiB;
constexpr size_t WS_ROPE_R = 46 * MiB, WS_ROPE_A = 47 * MiB, WS_KMEAN = 47 * MiB + 512 * 1024, WS_RS0 = 48 * MiB, WS_SS1 = 49 * MiB, WS_SS2 = 53 * MiB;
constexpr size_t WS_XB = 64 * MiB, WS_MIX = 192 * MiB, WS_BIG = 320 * MiB, WS_XB8 = 768 * MiB, WS_END = 832 * MiB;
static_assert(WS_W1A + (size_t)2 * FF * D * 2 <= WS_WD1 && WS_WD1 + (size_t)D * FF * 2 <= WS_WIN && WS_WIN + (size_t)INW * D * 2 <= WS_WOUT && WS_WOUT + (size_t)D * D * 2 <= WS_W2A &&
              WS_W2A + (size_t)2 * FF * D * 2 <= WS_WD2 && WS_WD2 + (size_t)D * FF * 2 <= WS_ROPE_R && WS_ROPE_R + (size_t)SEQ * 64 * 8 <= WS_ROPE_A && WS_ROPE_A + (size_t)SEQ * 8 * 8 <= WS_KMEAN &&
              WS_KMEAN + (size_t)BATCH * AH * NBLK * AD * 4 <= WS_RS0 && WS_RS0 + (size_t)M * 4 <= WS_SS1 && WS_SS1 + (size_t)M * 64 <= WS_SS2 && WS_SS2 + (size_t)M * 64 <= WS_XB &&
              WS_XB + (size_t)M * D * 2 <= WS_MIX && WS_MIX + (size_t)M * D * 2 <= WS_BIG && WS_BIG + (size_t)M * INW * 2 <= WS_XB8 && WS_XB8 + (size_t)M * D <= WS_END, "d_ws map");
constexpr int CW_TMO = 0, CW_CODE = 1;
constexpr int CW_BAR = 4096, CW_LBAR = 8192, CW_XTAB = 12288;

constexpr int RING_OFF = 0, RING_BYTES = 131072;
constexpr int LDSCTL_OFF = RING_BYTES, MISC_OFF = LDSCTL_OFF + 320;
constexpr int LDS_BYTES = 155648;
constexpr int TB_OFF = 136192;
constexpr int RTAB_OFF = 132096;
static_assert(MISC_OFF + 128 <= RTAB_OFF && RTAB_OFF + 4 * 256 * 4 <= TB_OFF && TB_OFF + 8 * 2304 <= LDS_BYTES, "LDS map");


typedef float f32x2 __attribute__((ext_vector_type(2)));
struct Frame {
    LAS unsigned char* lds;
    volatile LAS unsigned* MISC;
    gu32* ctl;
    int tid, lane, wave;
    int vcu, G;
    const float* x; float* out;
    bf16 *W1A, *WD1, *WIN, *WOUT, *W2A, *WD2;
    bf16 *XB, *MIXB, *HB, *PROJ;
    unsigned char *XB8, *H8, *W2A8, *WD28, *WIN8;
    f32x2 *ROPE_R, *ROPE_A;
    float *KMEAN, *RS0, *SS1, *SS2;
};
__device__ __forceinline__ float bf_lo(unsigned u) { return __uint_as_float(u << 16); }
__device__ __forceinline__ float bf_hi(unsigned u) { return __uint_as_float(u & 0xffff0000u); }
__device__ __forceinline__ void unpack8(const v4u r, float (&x)[8]) { x[0] = bf_lo(r.x); x[1] = bf_hi(r.x); x[2] = bf_lo(r.y); x[3] = bf_hi(r.y); x[4] = bf_lo(r.z); x[5] = bf_hi(r.z); x[6] = bf_lo(r.w); x[7] = bf_hi(r.w); }
__device__ __forceinline__ v4u pack8(const float (&y)[8]) { v4u o; o.x = pk2(y[0], y[1]); o.y = pk2(y[2], y[3]); o.z = pk2(y[4], y[5]); o.w = pk2(y[6], y[7]); return o; }
__device__ __forceinline__ float wave_sum(float v) {
#pragma unroll
    for (int o = 1; o < 64; o <<= 1) v += __shfl_xor(v, o);
    return v;
}
__device__ __forceinline__ float silu_f(float g) { return g * __builtin_amdgcn_rcpf(1.0f + __builtin_amdgcn_exp2f(-1.4426950408889634f * g)); }

template <bool WINMAP = false> __device__ __forceinline__ void p0_transpose_item(const float* W, int K, int N, bf16* WT, int k0, int n0, int dst_row0, const float* kscale, LAS float* scr, int lane) {
    const int scol = WINMAP ? pg8::win_orig_col(n0 + (lane & 31)) : n0 + (lane & 31);
    float wv[32];
#pragma unroll
    for (int i = 0; i < 32; ++i) wv[i] = P0_LDNT((const GAS float*)W + (size_t)(k0 + 2 * i + (lane >> 5)) * N + scol);
#pragma unroll
    for (int i = 0; i < 32; ++i) { const int kk = 2 * i + (lane >> 5); const float sc = kscale ? kscale[k0 + kk] : 1.0f; scr[kk * 33 + (lane & 31)] = wv[i] * sc; }
    LDS_WAIT(); asm volatile("" ::: "memory");
    const int c = lane & 7;
#pragma unroll
    for (int j = 0; j < 4; ++j) { const int n = (lane >> 3) + 8 * j; const LAS float* s = scr + (8 * c) * 33 + n;
        v4u o; o.x = pk2(s[0 * 33], s[1 * 33]); o.y = pk2(s[2 * 33], s[3 * 33]); o.z = pk2(s[4 * 33], s[5 * 33]); o.w = pk2(s[6 * 33], s[7 * 33]);
        P0_STNT(o, (GAS v4u*)(WT + (size_t)(dst_row0 + n) * K + k0 + 8 * c)); }
    LDS_WAIT(); asm volatile("" ::: "memory");
}
template <bool WINMAP = false> __device__ __forceinline__ void p0_transpose_item_f8(const float* W, int K, int N, unsigned char* WT, int k0, int n0, int dst_row0, const float* kscale, float mul, LAS float* scr, int lane) {
    const int scol = WINMAP ? pg8::win_orig_col(n0 + (lane & 31)) : n0 + (lane & 31);
    float wv[32];
#pragma unroll
    for (int i = 0; i < 32; ++i) wv[i] = P0_LDNT((const GAS float*)W + (size_t)(k0 + 2 * i + (lane >> 5)) * N + scol);
#pragma unroll
    for (int i = 0; i < 32; ++i) { const int kk = 2 * i + (lane >> 5); const float sc = (kscale ? kscale[k0 + kk] : 1.0f) * mul; scr[kk * 33 + (lane & 31)] = wv[i] * sc; }
    LDS_WAIT(); asm volatile("" ::: "memory");
    const int c = lane & 7;
#pragma unroll
    for (int j = 0; j < 4; ++j) { const int n = (lane >> 3) + 8 * j; const LAS float* s = scr + (8 * c) * 33 + n;
        pg8::u32x2 o; o.x = pg8::pk4_fp8(s[0 * 33], s[1 * 33], s[2 * 33], s[3 * 33]); o.y = pg8::pk4_fp8(s[4 * 33], s[5 * 33], s[6 * 33], s[7 * 33]);
        P0_STNT(o, (GAS pg8::u32x2*)(WT + (size_t)(dst_row0 + n) * K + k0 + 8 * c)); }
    LDS_WAIT(); asm volatile("" ::: "memory");
}
__device__ __forceinline__ void x_row_to_bf16(Frame& F, const float* xrow, bf16* orow, float* rs) {
    const GAS f32x4* xr = (const GAS f32x4*)xrow + F.lane;
    f32x4 v[4]; float s = 0.f;
#pragma unroll
    for (int j = 0; j < 4; ++j) { v[j] = xr[64 * j]; s += (v[j].x * v[j].x + v[j].y * v[j].y) + (v[j].z * v[j].z + v[j].w * v[j].w); }
    const float tot = wave_sum(s);
    if (F.lane == 0) *rs = 1.0f / sqrtf(tot * (1.f / D) + EPS);
    GAS unsigned long long* o8 = (GAS unsigned long long*)orow + F.lane;
#pragma unroll
    for (int j = 0; j < 4; ++j) o8[64 * j] = (unsigned long long)pk2(v[j].x, v[j].y) | ((unsigned long long)pk2(v[j].z, v[j].w) << 32);
}
__device__ __forceinline__ void x_rows2_to_bf16(Frame& F, const float* xrow, bf16* orow, float* rs, size_t estride, int rstride, unsigned char* o8row = nullptr) {
    const GAS f32x4* xr = (const GAS f32x4*)xrow + F.lane; const GAS f32x4* xr2 = (const GAS f32x4*)(xrow + estride) + F.lane;
    f32x4 v[4], v2[4]; float s = 0.f, s2 = 0.f;
#pragma unroll
    for (int j = 0; j < 4; ++j) { v[j] = P0_LDNT(xr + 64 * j); v2[j] = P0_LDNT(xr2 + 64 * j); }
#pragma unroll
    for (int j = 0; j < 4; ++j) { s += (v[j].x * v[j].x + v[j].y * v[j].y) + (v[j].z * v[j].z + v[j].w * v[j].w); s2 += (v2[j].x * v2[j].x + v2[j].y * v2[j].y) + (v2[j].z * v2[j].z + v2[j].w * v2[j].w); }
    const float tot = wave_sum(s), tot2 = wave_sum(s2);
    if (F.lane == 0) { rs[0] = 1.0f / sqrtf(tot * (1.f / D) + EPS); rs[rstride] = 1.0f / sqrtf(tot2 * (1.f / D) + EPS); }
    GAS unsigned long long* o8 = (GAS unsigned long long*)orow + F.lane; GAS unsigned long long* o82 = (GAS unsigned long long*)(orow + estride) + F.lane;
    if (MK_FP8_P1) {
        GAS unsigned* q8 = (GAS unsigned*)o8row + F.lane; GAS unsigned* q82 = (GAS unsigned*)(o8row + estride) + F.lane;
#pragma unroll
        for (int j = 0; j < 4; ++j) { q8[64 * j] = pg8::pk4_fp8(v[j].x, v[j].y, v[j].z, v[j].w); q82[64 * j] = pg8::pk4_fp8(v2[j].x, v2[j].y, v2[j].z, v2[j].w); }
    }
#pragma unroll
    for (int j = 0; j < 4; ++j) { P0_STNT((unsigned long long)pk2(v[j].x, v[j].y) | ((unsigned long long)pk2(v[j].z, v[j].w) << 32), o8 + 64 * j); P0_STNT((unsigned long long)pk2(v2[j].x, v2[j].y) | ((unsigned long long)pk2(v2[j].z, v2[j].w) << 32), o82 + 64 * j); }
}
struct Args { const float* in[16]; float* out; unsigned char* ws; float invf_r[64]; float invf_a[8]; int ph_lo, ph_hi, li, pad; };
__device__ __forceinline__ void p0_prologue(Frame& F, const Args& args) {
    LAS float* scr = (LAS float*)(F.lds + RING_OFF + F.wave * 16384);
    const int gw = F.vcu * NWAVES + F.wave, NGW = F.G * NWAVES;
    constexpr int I_GU = (D / 64) * (FF / 32), I_DN = (FF / 64) * (D / 32), I_IN = (D / 64) * (INW / 32), I_OUT = (D / 64) * (D / 32);
    constexpr int NITEMS = 2 * (2 * I_GU + I_DN) + I_IN + I_OUT;
    for (int it = gw; it < NITEMS; it += NGW) {
        int r = it;
#pragma unroll
        for (int f = 0; f < 2; ++f) {
            const float* nw = args.in[f == 0 ? 1 : 12]; const float* wg = args.in[f == 0 ? 2 : 13]; const float* wu = args.in[f == 0 ? 3 : 14]; const float* wd = args.in[f == 0 ? 4 : 15];
            bf16* WA = f == 0 ? F.W1A : F.W2A; bf16* WD = f == 0 ? F.WD1 : F.WD2;
            if (r >= 0 && r < I_GU) { const int nblk = FF / 32, kb = r / nblk, nb = r % nblk, n0 = 32 * nb; const int dr = 256 * (n0 / 128) + (n0 % 128);
                if (f == 1 && MK_FP8) p0_transpose_item_f8(wg, D, FF, F.W2A8, 64 * kb, n0, dr, nw, pg8::W8_SCALE, scr, F.lane); else if (f == 0 && MK_FP8_P1) p0_transpose_item_f8(wg, D, FF, (unsigned char*)F.W1A, 64 * kb, n0, dr, nw, pg8::W8_SCALE, scr, F.lane); else p0_transpose_item(wg, D, FF, WA, 64 * kb, n0, dr, nw, scr, F.lane); r = -1; } else if (r >= 0) r -= I_GU;
            if (r >= 0 && r < I_GU) { const int nblk = FF / 32, kb = r / nblk, nb = r % nblk, n0 = 32 * nb; const int dr = 256 * (n0 / 128) + 128 + (n0 % 128);
                if (f == 1 && MK_FP8) p0_transpose_item_f8(wu, D, FF, F.W2A8, 64 * kb, n0, dr, nw, pg8::W8_SCALE, scr, F.lane); else if (f == 0 && MK_FP8_P1) p0_transpose_item_f8(wu, D, FF, (unsigned char*)F.W1A, 64 * kb, n0, dr, nw, pg8::W8_SCALE, scr, F.lane); else p0_transpose_item(wu, D, FF, WA, 64 * kb, n0, dr, nw, scr, F.lane); r = -1; } else if (r >= 0) r -= I_GU;
            if (r >= 0 && r < I_DN) { const int nblk = D / 32, kb = r / nblk, nb = r % nblk, n0 = 32 * nb;
                if (f == 1 && MK_FP8) p0_transpose_item_f8(wd, FF, D, F.WD28, 64 * kb, n0, n0, nullptr, pg8::W8_SCALE, scr, F.lane); else if (f == 0 && MK_FP8_P2) p0_transpose_item_f8(wd, FF, D, (unsigned char*)F.WD1, 64 * kb, n0, n0, nullptr, pg8::W8_SCALE, scr, F.lane); else p0_transpose_item(wd, FF, D, WD, 64 * kb, n0, n0, nullptr, scr, F.lane); r = -1; } else if (r >= 0) r -= I_DN;
        }
        if (r >= 0 && r < I_IN) { const int nblk = INW / 32, kb = r / nblk, nb = r % nblk, n0 = 32 * nb, tile = n0 >> 8;
            if (MK_FP8_WIN == 2) {
                if (tile == 4 || tile == 5 || tile == 12 || tile == 13) p0_transpose_item_f8<true>(args.in[6], D, INW, F.WIN8, 64 * kb, n0, (tile < 8 ? tile - 4 : tile - 10) * 256 + (n0 & 255), args.in[5], pg8::W8_SCALE, scr, F.lane);
                else p0_transpose_item<true>(args.in[6], D, INW, F.WIN + 524288, 64 * kb, n0, (tile < 4 ? tile : tile - 2) * 256 + (n0 & 255), args.in[5], scr, F.lane);
            } else
            if (MK_FP8_WIN && (tile < 8 || tile >= 12)) p0_transpose_item_f8<true>(args.in[6], D, INW, F.WIN8, 64 * kb, n0, tile < 8 ? n0 : n0 - 1024, args.in[5], pg8::W8_SCALE, scr, F.lane);
            else p0_transpose_item<true>(args.in[6], D, INW, F.WIN, 64 * kb, n0, n0, args.in[5], scr, F.lane);
            r = -1; } else if (r >= 0) r -= I_IN;
        if (r >= 0 && r < I_OUT) { const int nblk = D / 32, kb = r / nblk, nb = r % nblk, n0 = 32 * nb;
            if (MK_FP8_WOUT) p0_transpose_item_f8(args.in[11], D, D, (unsigned char*)F.WOUT, 64 * kb, n0, n0, nullptr, pg8::W8_SCALE, scr, F.lane); else p0_transpose_item(args.in[11], D, D, F.WOUT, 64 * kb, n0, n0, nullptr, scr, F.lane); r = -1; }
    }
    if (M % (2 * NGW) == 0) { for (int m = gw; m < M; m += 2 * NGW) x_rows2_to_bf16(F, F.x + (size_t)m * D, F.XB + (size_t)m * D, F.RS0 + m, (size_t)NGW * D, NGW, F.XB8 + (size_t)m * D); }
    else { for (int m = gw; m < M; m += NGW) x_row_to_bf16(F, F.x + (size_t)m * D, F.XB + (size_t)m * D, F.RS0 + m); }
    const int gt = F.vcu * (NWAVES * 64) + F.tid, NGT = F.G * NWAVES * 64;
    for (int idx = gt; idx < BATCH * AH * NBLK * AD; idx += NGT) F.KMEAN[idx] = 0.f;
    for (int idx = gt; idx < SEQ * 72; idx += NGT) {
        const int pos = idx / 72, i = idx % 72;
        float invf = 0.f;
#pragma unroll
        for (int k = 0; k < 64; ++k) invf = (i == k) ? args.invf_r[k] : invf;
#pragma unroll
        for (int k = 0; k < 8; ++k) invf = (i == 64 + k) ? args.invf_a[k] : invf;
        const float ang = (float)pos * invf;
        double rv = (double)ang * 0.15915494309189535; rv -= floor(rv);
        const float a = (float)(rv * 6.283185307179586);
        f32x2 cs; cs.x = cosf(a); cs.y = sinf(a);
        if (i < 64) F.ROPE_R[pos * 64 + i] = cs; else F.ROPE_A[pos * 8 + (i - 64)] = cs;
    }
}

__global__ void __launch_bounds__(NWAVES * 64, 2) mk_fwd(Args args) {
    __shared__ __attribute__((aligned(16))) unsigned char lds[LDS_BYTES];
    Frame F;
    F.lds = (LAS unsigned char*)lds;
    F.MISC = (volatile LAS unsigned*)(F.lds + MISC_OFF);
    F.wave = __builtin_amdgcn_readfirstlane((int)threadIdx.x >> 6); F.lane = mk_lane(); F.tid = F.wave * 64 + F.lane;
    F.G = gridDim.x; { const int bx = blockIdx.x; F.vcu = (F.G % 8 == 0) ? (bx % 8) * (F.G / 8) + bx / 8 : bx; }
    unsigned char* ws = args.ws;
    F.ctl = (gu32*)(ws + WS_CTL);
    F.x = args.in[0]; F.out = args.out;
#define FRAME_PTRS() do { unsigned char* ws = args.ws; asm volatile("" : "+s"(ws)); F.lane = mk_lane(); F.tid = F.wave * 64 + F.lane; \
    F.W1A = (bf16*)(ws + WS_W1A); F.WD1 = (bf16*)(ws + WS_WD1); F.WIN = (bf16*)(ws + WS_WIN); F.WOUT = (bf16*)(ws + WS_WOUT); F.W2A = (bf16*)(ws + WS_W2A); F.WD2 = (bf16*)(ws + WS_WD2); \
    F.XB8 = ws + WS_XB8; F.H8 = ws + WS_BIG; F.W2A8 = ws + WS_W2A; F.WD28 = ws + WS_WD2; F.WIN8 = ws + WS_WIN; \
    F.XB = (bf16*)(ws + WS_XB); F.MIXB = (bf16*)(ws + WS_MIX); F.HB = (bf16*)(ws + WS_BIG); F.PROJ = (bf16*)(ws + WS_BIG); \
    F.ROPE_R = (f32x2*)(ws + WS_ROPE_R); F.ROPE_A = (f32x2*)(ws + WS_ROPE_A); \
    F.KMEAN = (float*)(ws + WS_KMEAN); F.RS0 = (float*)(ws + WS_RS0); F.SS1 = (float*)(ws + WS_SS1); F.SS2 = (float*)(ws + WS_SS2); } while (0)
    FRAME_PTRS();
    for (int u = F.tid; u < (LDS_BYTES - LDSCTL_OFF) / 4; u += NWAVES * 64) ((LAS unsigned*)(F.lds + LDSCTL_OFF))[u] = 0u;
    __syncthreads();
    XcdBarrier bar; bar.bar = (unsigned*)(F.ctl + CW_BAR); bar.x = 0; bar.st = nullptr; bar.t0 = false;
    if (!MK_PER_PHASE) bar = xcd_barrier_post((unsigned*)(F.ctl + CW_BAR), F.MISC + 8);
    if (!MK_PER_PHASE && MK_LOCAL_BAR && F.tid == 0) __hip_atomic_store(F.ctl + CW_XTAB + blockIdx.x, bar.x + 1u, RLX_AGENT);
#define GRID_BAR() do { if (!MK_PER_PHASE) { unsigned char* w_ = args.ws; asm volatile("" : "+s"(w_)); XcdBarrier b_; b_.bar = (unsigned*)w_ + CW_BAR; b_.x = xb_xcc_id(); b_.st = F.MISC + 8; b_.t0 = (F.wave == 0) && (mk_lane() == 0); \
        if (MK_LOCAL_BAR && F.MISC[12] != 0u) xcc_local_barrier(b_, (unsigned*)w_ + CW_LBAR); else xcd_barrier(b_); } } while (0)
#ifndef MK_STAG4
#define MK_STAG4 0
#endif
#ifndef MK_STAG7
#define MK_STAG7 750
#endif
#ifndef MK_STAG9
#define MK_STAG9 1400
#endif
#define STAGGER4(ticks) do { const unsigned long long w_ = (unsigned long long)(ticks) * (MK_STAG4 == 1 ? (blockIdx.x & 3) : (MK_STAG4 == 2 ? ((blockIdx.x >> 3) & 1) : 0)); if (w_) { const unsigned long long t0_ = rt(); while (rt() - t0_ < w_) __builtin_amdgcn_s_sleep(8); } } while (0)
#define STAGGER(ticks) do { if (MK_STAGGER && (F.vcu & 1)) { const unsigned long long t0_ = rt(); while (rt() - t0_ < (unsigned long long)(ticks)) __builtin_amdgcn_s_sleep(8); } } while (0)
    const int lo = args.ph_lo, hi = args.ph_hi;
#define IN(k) (lo <= (k) && (k) < hi)
#define BOTH(k) (IN(k) && IN((k) + 1))

#if MK_DUP == 0
    if (IN(0)) { FRAME_PTRS(); p0_prologue(F, args); GRID_BAR(); }
#endif
    if (IN(0)) { FRAME_PTRS(); p0_prologue(F, args); if (BOTH(0)) GRID_BAR(); }
    if (!MK_PER_PHASE && MK_LOCAL_BAR && IN(0) && BOTH(0)) {
        bool ok = true;
        if (F.tid < F.G) { const unsigned v = __hip_atomic_load(F.ctl + CW_XTAB + F.tid, RLX_AGENT), r0 = __hip_atomic_load(F.ctl + CW_XTAB + (F.tid & 7), RLX_AGENT); ok = (v != 0u) && (v == r0); }
        const bool local_ok = (__syncthreads_and(ok ? 1 : 0) != 0) && F.G == 256;
        if (F.tid == 0) F.MISC[12] = local_ok ? 1u : 0u;
        __syncthreads();
        if (local_ok && MK_XSTAG_TICKS > 0) { const unsigned long long t0_ = rt(), w_ = (unsigned long long)MK_XSTAG_TICKS * (blockIdx.x & 7); while (rt() - t0_ < w_) __builtin_amdgcn_s_sleep(8); }
    }

#if MK_DUP == 1
    if (IN(1)) { FRAME_PTRS();
#if MK_FP8_P1
        pg8::Gemm g{(const pg8::bf16_t*)F.XB8, (const pg8::bf16_t*)F.W1A, M, 2 * FF, D}; pg8::StaticOrder S; S.init(M, 2 * FF, F.G, (int)blockIdx.x);
#else
        pg8::Gemm g{F.XB, F.W1A, M, 2 * FF, D}; pg8::StaticOrder S; S.init(M, 2 * FF, F.G, (int)blockIdx.x);
#endif
        const pg8::RTab rt_ = pg8::fill_rstd_table<false>((LAS float*)(F.lds + RTAB_OFF), S, F.RS0, F.tid);
        pg8::EpiSwiGLU<false, MK_FP8_P1 != 0, true, MK_FP8_P2 != 0> E{F.HB, FF, F.RS0, rt_};
        pg8::gemm_phase<pg8::EpiSwiGLU<false, MK_FP8_P1 != 0, true, MK_FP8_P2 != 0>, pg8::StaticOrder, PG8_ALIGN, PG8_SP2, MK_FP8_P1 != 0>(F.lds + RING_OFF, g, S, E, F.wave);
        GRID_BAR();
    }
#endif
    if (IN(1)) { FRAME_PTRS(); STAGGER(1300);
#if MK_FP8_P1
        pg8::Gemm g{(const pg8::bf16_t*)F.XB8, (const pg8::bf16_t*)F.W1A, M, 2 * FF, D}; pg8::StaticOrder S; S.init(M, 2 * FF, F.G, (int)blockIdx.x);
#else
        pg8::Gemm g{F.XB, F.W1A, M, 2 * FF, D}; pg8::StaticOrder S; S.init(M, 2 * FF, F.G, (int)blockIdx.x);
#endif
        const pg8::RTab rt_ = pg8::fill_rstd_table<false>((LAS float*)(F.lds + RTAB_OFF), S, F.RS0, F.tid);
        pg8::EpiSwiGLU<false, MK_FP8_P1 != 0, true, MK_FP8_P2 != 0> E{F.HB, FF, F.RS0, rt_};
        pg8::gemm_phase<pg8::EpiSwiGLU<false, MK_FP8_P1 != 0, true, MK_FP8_P2 != 0>, pg8::StaticOrder, PG8_ALIGN, PG8_SP2, MK_FP8_P1 != 0>(F.lds + RING_OFF, g, S, E, F.wave);
        if (BOTH(1)) GRID_BAR();
    }
#if MK_DUP == 2 || MK_DUP == 22
    if (IN(2)) { FRAME_PTRS();
        pg8::Gemm g{F.HB, F.WD1, M, D, FF}; pg8::StaticOrder S; S.init(M, D, F.G, (int)blockIdx.x);
#if MK_DUP == 22
        pg8::EpiNone E{};
        pg8::gemm_phase<pg8::EpiNone, pg8::StaticOrder, PG8_ALIGN, PG8_SP2, false, 2>(F.lds + RING_OFF, g, S, E, F.wave);
#else
#ifndef MK_EDBG
#define MK_EDBG 0
#endif
        pg8::EpiResid<true, false, true, 1, MK_FP8_WIN != 0> E{nullptr, F.XB, nullptr, (bf16*)(args.ws + WS_MIX), (float*)(args.ws + ((size_t)736 << 20)), args.ws + ((size_t)672 << 20), F.lds + TB_OFF + F.wave * 2304};
#if MK_FP8_P2
        pg8::gemm_phase<pg8::EpiResid<true, false, true, 2, MK_FP8_WIN != 0>, pg8::StaticOrder, PG8_ALIGN, PG8_SP2, true, 1>(F.lds + RING_OFF, g, S, E, F.wave);
#else
        pg8::gemm_phase<pg8::EpiResid<true, false, true, 1, MK_FP8_WIN != 0>, pg8::StaticOrder, PG8_ALIGN, PG8_SP2, false, 2>(F.lds + RING_OFF, g, S, E, F.wave);
#endif
#endif
        GRID_BAR();
    }
#endif
    if (IN(2)) { FRAME_PTRS();
        pg8::Gemm g{F.HB, F.WD1, M, D, FF}; pg8::StaticOrder S; S.init(M, D, F.G, (int)blockIdx.x);
#if MK_FP8_P2
        pg8::EpiResid<true, false, true, 2, MK_FP8_WIN != 0> E{nullptr, F.XB, nullptr, F.XB, F.SS1, F.XB8, F.lds + TB_OFF + F.wave * 2304};
#else
        pg8::EpiResid<true, false, true, 1, MK_FP8_WIN != 0> E{nullptr, F.XB, nullptr, F.XB, F.SS1, F.XB8, F.lds + TB_OFF + F.wave * 2304};
#endif
#if MK_FP8_P2
        pg8::gemm_phase<pg8::EpiResid<true, false, true, 2, MK_FP8_WIN != 0>, pg8::StaticOrder, PG8_ALIGN, PG8_SP2, true, 1>(F.lds + RING_OFF, g, S, E, F.wave);
#else
        pg8::gemm_phase<pg8::EpiResid<true, false, true, 1, MK_FP8_WIN != 0>, pg8::StaticOrder, PG8_ALIGN, PG8_SP2, false, 2>(F.lds + RING_OFF, g, S, E, F.wave);
#endif
        if (BOTH(2)) GRID_BAR();
    }
#if MK_DUP == 33
    if (IN(3)) { FRAME_PTRS();
        pg8::Gemm g{F.XB, F.WIN, M, INW, D}; pg8::StaticOrder S; S.init(M, INW, F.G, (int)blockIdx.x); pg8::EpiNone E{};
        pg8::gemm_phase<pg8::EpiNone, pg8::StaticOrder, PG8_ALIGN, PG8_SP2>(F.lds + RING_OFF, g, S, E, F.wave);
        GRID_BAR();
    }
#endif
#if MK_DUP == 3
    if (IN(3)) { FRAME_PTRS();
#if MK_FP8_WIN
        {   pg8::Gemm g{F.XB, F.WIN + (size_t)2048 * D, M, 1024, D}; pg8::StaticOrder S; S.init(M, 1024, F.G, (int)blockIdx.x);
            pg8::EpiProjFused<1, false> E{F.PROJ, INW, F.SS1, (const pg8::f32x4*)F.ROPE_R, (const pg8::f32x4*)F.ROPE_A, args.in[8], args.in[9], F.KMEAN, F.lds + TB_OFF + F.wave * 2304, pg8::RTab{nullptr, 0}};
            pg8::gemm_phase<pg8::EpiProjFused<1, false>, pg8::StaticOrder, PG8_ALIGN, PG8_SP2>(F.lds + RING_OFF, g, S, E, F.wave); }
        {   pg8::Gemm g{(const pg8::bf16_t*)F.XB8, (const pg8::bf16_t*)F.WIN8, M, 2560, D}; pg8::StaticOrder S; S.init(M, 2560, F.G, (int)blockIdx.x);
            const pg8::RTab rt_ = pg8::fill_rstd_table<true>((LAS float*)(F.lds + RTAB_OFF), S, F.SS1, F.tid);
            pg8::EpiProjFused<2, true> E{F.PROJ, INW, F.SS1, (const pg8::f32x4*)F.ROPE_R, (const pg8::f32x4*)F.ROPE_A, args.in[8], args.in[9], F.KMEAN, F.lds + TB_OFF + F.wave * 2304, rt_};
            pg8::gemm_phase<pg8::EpiProjFused<2, true>, pg8::StaticOrder, PG8_ALIGN, PG8_SP2, true, 1>(F.lds + RING_OFF, g, S, E, F.wave); }
#else
        pg8::Gemm g{F.XB, F.WIN, M, INW, D}; pg8::StaticOrder S; S.init(M, INW, F.G, (int)blockIdx.x);
        const pg8::RTab rt_ = pg8::fill_rstd_table<true>((LAS float*)(F.lds + RTAB_OFF), S, F.SS1, F.tid);
        pg8::EpiProjFused<0, false> E{F.PROJ, INW, F.SS1, (const pg8::f32x4*)F.ROPE_R, (const pg8::f32x4*)F.ROPE_A, args.in[8], args.in[9], F.KMEAN, F.lds + TB_OFF + F.wave * 2304, rt_};
        pg8::gemm_phase<pg8::EpiProjFused<0, false>, pg8::StaticOrder, PG8_ALIGN, PG8_SP2>(F.lds + RING_OFF, g, S, E, F.wave);
#endif
        GRID_BAR();
    }
#endif
    if (IN(3)) { FRAME_PTRS(); STAGGER(1500);
#if MK_FP8_WIN == 2
        {   pg8::Gemm g{F.XB, F.WIN + 524288, M, 2560, D}; pg8::StaticOrder S; S.init(M, 2560, F.G, (int)blockIdx.x);
            const pg8::RTab rt_ = pg8::fill_rstd_table<true>((LAS float*)(F.lds + RTAB_OFF), S, F.SS1, F.tid);
            pg8::EpiProjFused<3, false> E{F.PROJ, INW, F.SS1, (const pg8::f32x4*)F.ROPE_R, (const pg8::f32x4*)F.ROPE_A, args.in[8], args.in[9], F.KMEAN, F.lds + TB_OFF + F.wave * 2304, rt_};
            pg8::gemm_phase<pg8::EpiProjFused<3, false>, pg8::StaticOrder, PG8_ALIGN, PG8_SP2>(F.lds + RING_OFF, g, S, E, F.wave); }
        {   pg8::Gemm g{(const pg8::bf16_t*)F.XB8, (const pg8::bf16_t*)F.WIN8, M, 1024, D}; pg8::StaticOrder S; S.init(M, 1024, F.G, (int)blockIdx.x);
            const pg8::RTab rt_ = pg8::fill_rstd_table<true>((LAS float*)(F.lds + RTAB_OFF), S, F.SS1, F.tid);
            pg8::EpiProjFused<4, true> E{F.PROJ, INW, F.SS1, (const pg8::f32x4*)F.ROPE_R, (const pg8::f32x4*)F.ROPE_A, args.in[8], args.in[9], F.KMEAN, F.lds + TB_OFF + F.wave * 2304, rt_};
            pg8::gemm_phase<pg8::EpiProjFused<4, true>, pg8::StaticOrder, PG8_ALIGN, PG8_SP2, true, 1>(F.lds + RING_OFF, g, S, E, F.wave); }
#elif MK_FP8_WIN
        {   pg8::Gemm g{F.XB, F.WIN + (size_t)2048 * D, M, 1024, D}; pg8::StaticOrder S; S.init(M, 1024, F.G, (int)blockIdx.x);
            pg8::EpiProjFused<1, false> E{F.PROJ, INW, F.SS1, (const pg8::f32x4*)F.ROPE_R, (const pg8::f32x4*)F.ROPE_A, args.in[8], args.in[9], F.KMEAN, F.lds + TB_OFF + F.wave * 2304, pg8::RTab{nullptr, 0}};
            pg8::gemm_phase<pg8::EpiProjFused<1, false>, pg8::StaticOrder, PG8_ALIGN, PG8_SP2>(F.lds + RING_OFF, g, S, E, F.wave); }
        {   pg8::Gemm g{(const pg8::bf16_t*)F.XB8, (const pg8::bf16_t*)F.WIN8, M, 2560, D}; pg8::StaticOrder S; S.init(M, 2560, F.G, (int)blockIdx.x);
            const pg8::RTab rt_ = pg8::fill_rstd_table<true>((LAS float*)(F.lds + RTAB_OFF), S, F.SS1, F.tid);
            pg8::EpiProjFused<2, true> E{F.PROJ, INW, F.SS1, (const pg8::f32x4*)F.ROPE_R, (const pg8::f32x4*)F.ROPE_A, args.in[8], args.in[9], F.KMEAN, F.lds + TB_OFF + F.wave * 2304, rt_};
            pg8::gemm_phase<pg8::EpiProjFused<2, true>, pg8::StaticOrder, PG8_ALIGN, PG8_SP2, true, 1>(F.lds + RING_OFF, g, S, E, F.wave); }
#else
        pg8::Gemm g{F.XB, F.WIN, M, INW, D}; pg8::StaticOrder S; S.init(M, INW, F.G, (int)blockIdx.x);
        const pg8::RTab rt_ = pg8::fill_rstd_table<true>((LAS float*)(F.lds + RTAB_OFF), S, F.SS1, F.tid);
        pg8::EpiProjFused<0, false> E{F.PROJ, INW, F.SS1, (const pg8::f32x4*)F.ROPE_R, (const pg8::f32x4*)F.ROPE_A, args.in[8], args.in[9], F.KMEAN, F.lds + TB_OFF + F.wave * 2304, rt_};
        pg8::gemm_phase<pg8::EpiProjFused<0, false>, pg8::StaticOrder, PG8_ALIGN, PG8_SP2>(F.lds + RING_OFF, g, S, E, F.wave);
#endif
        if (BOTH(3)) GRID_BAR();
    }
    if (IN(4)) { FRAME_PTRS();
    }
#if MK_DUP == 5
    if (IN(5)) { FRAME_PTRS();
        static_assert(ret_body::RET_LDS_END <= LDS_BYTES && ret_body::RBETA >= MISC_OFF + 128, "retention body LDS vs frame");
        if (F.G == 256) { if (!(F.vcu & 1)) { const int u = F.vcu >> 1; ret_body::ret_unit(F.PROJ, F.MIXB, args.in[7], u / RH, u % RH, F.lds, F.wave); } }
        else for (int u = F.vcu; u < BATCH * RH; u += F.G) ret_body::ret_unit(F.PROJ, F.MIXB, args.in[7], u / RH, u % RH, F.lds, F.wave);
        GRID_BAR();
    }
#endif
    if (IN(5)) { FRAME_PTRS();
        static_assert(ret_body::RET_LDS_END <= LDS_BYTES && ret_body::RBETA >= MISC_OFF + 128, "retention body LDS vs frame");
        if (F.G == 256) { if (!(F.vcu & 1)) { const int u = F.vcu >> 1; ret_body::ret_unit(F.PROJ, F.MIXB, args.in[7], u / RH, u % RH, F.lds, F.wave); } }
        else for (int u = F.vcu; u < BATCH * RH; u += F.G) ret_body::ret_unit(F.PROJ, F.MIXB, args.in[7], u / RH, u % RH, F.lds, F.wave);
    }
#if MK_DUP == 6
    if (IN(6)) { FRAME_PTRS();
        static_assert(attn_body::ATTN_LDS_BYTES <= RING_BYTES, "attention body LDS vs frame");
        const attn_body::AttnTensors AT{(const attn_body::bf16*)(F.PROJ + PC_AQ), (const attn_body::bf16*)(F.PROJ + PC_AK), (const attn_body::bf16*)(F.PROJ + PC_AV), (attn_body::bf16*)(MK_FP8_WOUT ? (bf16*)((unsigned char*)F.MIXB + 512) : F.MIXB + 512), F.KMEAN, args.in[10]};
        const attn_body::StaticOrder SA((int)F.G, F.vcu);
        attn_body::attn_phase<attn_body::StaticOrder>((char*)lds + RING_OFF, AT, SA, F.wave);
        GRID_BAR();
    }
#endif
    if (IN(6)) { FRAME_PTRS();
        static_assert(attn_body::ATTN_LDS_BYTES <= RING_BYTES, "attention body LDS vs frame");
        const attn_body::AttnTensors AT{(const attn_body::bf16*)(F.PROJ + PC_AQ), (const attn_body::bf16*)(F.PROJ + PC_AK), (const attn_body::bf16*)(F.PROJ + PC_AV), (attn_body::bf16*)(MK_FP8_WOUT ? (bf16*)((unsigned char*)F.MIXB + 512) : F.MIXB + 512), F.KMEAN, args.in[10]};
        const attn_body::StaticOrder SA((int)F.G, F.vcu);
        attn_body::attn_phase<attn_body::StaticOrder>((char*)lds + RING_OFF, AT, SA, F.wave);
        if (BOTH(6)) GRID_BAR();
    }
    if (IN(7)) { FRAME_PTRS(); STAGGER4(MK_STAG7);
#if MK_FP8_WOUT
        pg8::Gemm g{F.MIXB, F.WOUT, M, D, D}; pg8::StaticOrder S; S.init(M, D, F.G, (int)blockIdx.x);
        pg8::EpiResid<true, false, true, 3, MK_FP8 != 0> E{nullptr, F.XB, nullptr, F.XB, F.SS2, F.XB8, F.lds + TB_OFF + F.wave * 2304};
        pg8::gemm_phase<pg8::EpiResid<true, false, true, 3, MK_FP8 != 0>, pg8::StaticOrder, PG8_ALIGN, PG8_SP2, true>(F.lds + RING_OFF, g, S, E, F.wave);
#else
        pg8::Gemm g{F.MIXB, F.WOUT, M, D, D}; pg8::StaticOrder S; S.init(M, D, F.G, (int)blockIdx.x);
        pg8::EpiResid<true, false, true, 0, MK_FP8 != 0> E{nullptr, F.XB, nullptr, F.XB, F.SS2, F.XB8, F.lds + TB_OFF + F.wave * 2304};
        pg8::gemm_phase<pg8::EpiResid<true, false, true, 0, MK_FP8 != 0>, pg8::StaticOrder, PG8_ALIGN, PG8_SP2>(F.lds + RING_OFF, g, S, E, F.wave);
#endif
        if (BOTH(7)) GRID_BAR();
    }
#if MK_DUP == 8
    if (IN(8)) { FRAME_PTRS();
#if MK_FP8
        pg8::Gemm g{(const pg8::bf16_t*)F.XB8, (const pg8::bf16_t*)F.W2A8, M, 2 * FF, D}; pg8::StaticOrder S; S.init(M, 2 * FF, F.G, (int)blockIdx.x);
        const pg8::RTab rt_ = pg8::fill_rstd_table<true>((LAS float*)(F.lds + RTAB_OFF), S, F.SS2, F.tid);
        pg8::EpiSwiGLU<true, true, true> E{(pg8::bf16_t*)F.H8, FF, F.SS2, rt_};
        pg8::gemm_phase<pg8::EpiSwiGLU<true, true, true>, pg8::StaticOrder, PG8_ALIGN, PG8_SP2, true, 1>(F.lds + RING_OFF, g, S, E, F.wave);
#else
        pg8::Gemm g{F.XB, F.W2A, M, 2 * FF, D}; pg8::StaticOrder S; S.init(M, 2 * FF, F.G, (int)blockIdx.x);
        pg8::EpiSwiGLU<true> E{F.HB, FF, F.SS2, pg8::RTab{nullptr, 0}};
        pg8::gemm_phase<pg8::EpiSwiGLU<true>, pg8::StaticOrder, PG8_ALIGN, PG8_SP2>(F.lds + RING_OFF, g, S, E, F.wave);
#endif
        GRID_BAR();
    }
#endif
    if (IN(8)) { FRAME_PTRS(); STAGGER(750);
#if MK_FP8
        pg8::Gemm g{(const pg8::bf16_t*)F.XB8, (const pg8::bf16_t*)F.W2A8, M, 2 * FF, D}; pg8::StaticOrder S; S.init(M, 2 * FF, F.G, (int)blockIdx.x);
        const pg8::RTab rt_ = pg8::fill_rstd_table<true>((LAS float*)(F.lds + RTAB_OFF), S, F.SS2, F.tid);
        pg8::EpiSwiGLU<true, true, true> E{(pg8::bf16_t*)F.H8, FF, F.SS2, rt_};
        pg8::gemm_phase<pg8::EpiSwiGLU<true, true, true>, pg8::StaticOrder, PG8_ALIGN, PG8_SP2, true, 1>(F.lds + RING_OFF, g, S, E, F.wave);
#else
        pg8::Gemm g{F.XB, F.W2A, M, 2 * FF, D}; pg8::StaticOrder S; S.init(M, 2 * FF, F.G, (int)blockIdx.x);
        pg8::EpiSwiGLU<true> E{F.HB, FF, F.SS2, pg8::RTab{nullptr, 0}};
        pg8::gemm_phase<pg8::EpiSwiGLU<true>, pg8::StaticOrder, PG8_ALIGN, PG8_SP2>(F.lds + RING_OFF, g, S, E, F.wave);
#endif
        if (BOTH(8)) GRID_BAR();
    }
#if defined(MK_PROBE) && (MK_PROBE == 90 || MK_PROBE == 91)
    if (IN(8)) { FRAME_PTRS();
        const unsigned long long t0 = __builtin_amdgcn_s_memtime(), r0 = __builtin_amdgcn_s_memrealtime();
#if MK_PROBE == 90
        { pg8::Gemm g{(const pg8::bf16_t*)F.XB8, (const pg8::bf16_t*)F.W2A8, M, 2 * FF, D}; pg8::StaticOrder S; S.init(M, 2 * FF, F.G, (int)blockIdx.x); pg8::EpiNone E{};
        pg8::gemm_phase<pg8::EpiNone, pg8::StaticOrder, PG8_ALIGN, PG8_SP2, true, 1>(F.lds + RING_OFF, g, S, E, F.wave); }
#else
        { pg8::Gemm g{F.XB, F.W1A, M, 2 * FF, D}; pg8::StaticOrder S; S.init(M, 2 * FF, F.G, (int)blockIdx.x); pg8::EpiNone E{};
        pg8::gemm_phase<pg8::EpiNone, pg8::StaticOrder, PG8_ALIGN, PG8_SP2>(F.lds + RING_OFF, g, S, E, F.wave); }
#endif
        const unsigned long long t1 = __builtin_amdgcn_s_memtime(), r1 = __builtin_amdgcn_s_memrealtime();
        if (blockIdx.x == 0) { const unsigned long long ticks = 5000ull * (t1 - t0) / (r1 - r0);
            while (__builtin_amdgcn_s_memrealtime() - r1 < ticks) __builtin_amdgcn_s_sleep(32); }
        GRID_BAR();
    }
#elif defined(MK_PROBE)
    if (IN(8)) { FRAME_PTRS();
#if MK_PROBE == 81
        pg8::Gemm g{(const pg8::bf16_t*)F.XB8, (const pg8::bf16_t*)F.W2A8, M, 2 * FF, D}; pg8::StaticOrder S; S.init(M, 2 * FF, F.G, (int)blockIdx.x); pg8::EpiNone E{};
        pg8::gemm_phase<pg8::EpiNone, pg8::StaticOrder, PG8_ALIGN, PG8_SP2, true, 1>(F.lds + RING_OFF, g, S, E, F.wave);
#elif MK_PROBE == 82
        pg8::Gemm g{(const pg8::bf16_t*)(args.ws + (512u << 10)), (const pg8::bf16_t*)F.W2A8, M, 2 * FF, D}; pg8::Row0Order S; S.init(M, 2 * FF, F.G, (int)blockIdx.x); pg8::EpiNone E{};
        pg8::gemm_phase<pg8::EpiNone, pg8::Row0Order, PG8_ALIGN, PG8_SP2, true>(F.lds + RING_OFF, g, S, E, F.wave);
#elif MK_PROBE == 83
        pg8::Gemm g{(const pg8::bf16_t*)F.XB8, (const pg8::bf16_t*)F.W2A8, M, 2 * FF, D}; pg8::Row0Order S; S.init(M, 2 * FF, F.G, (int)blockIdx.x); pg8::EpiNone E{};
        pg8::gemm_phase<pg8::EpiNone, pg8::Row0Order, PG8_ALIGN, PG8_SP2, true, 1>(F.lds + RING_OFF, g, S, E, F.wave);
#elif MK_PROBE == 11
        pg8::Gemm g{F.XB, F.W1A, M, 2 * FF, D}; pg8::StaticOrder S; S.init(M, 2 * FF, F.G, (int)blockIdx.x); pg8::EpiNone E{};
        pg8::gemm_phase<pg8::EpiNone, pg8::StaticOrder, PG8_ALIGN, PG8_SP2>(F.lds + RING_OFF, g, S, E, F.wave);
#endif
        GRID_BAR();
    }
#endif
    if (IN(9)) { FRAME_PTRS(); STAGGER4(MK_STAG9);
#if MK_FP8
        pg8::Gemm g{(const pg8::bf16_t*)F.H8, (const pg8::bf16_t*)F.WD28, M, D, FF}; pg8::StaticOrder S; S.init(M, D, F.G, (int)blockIdx.x);
        pg8::EpiResid<true, true, false, 2> E{nullptr, F.XB, F.out, nullptr, nullptr, nullptr, F.lds + TB_OFF + F.wave * 2304};
        pg8::gemm_phase<pg8::EpiResid<true, true, false, 2>, pg8::StaticOrder, PG8_ALIGN, PG8_SP2, true, 1>(F.lds + RING_OFF, g, S, E, F.wave);
#else
        pg8::Gemm g{F.HB, F.WD2, M, D, FF}; pg8::StaticOrder S; S.init(M, D, F.G, (int)blockIdx.x);
        pg8::EpiResid<true, true, false, 1> E{nullptr, F.XB, F.out, nullptr, nullptr, nullptr, F.lds + TB_OFF + F.wave * 2304};
        pg8::gemm_phase<pg8::EpiResid<true, true, false, 1>, pg8::StaticOrder, PG8_ALIGN, PG8_SP2>(F.lds + RING_OFF, g, S, E, F.wave);
#endif
    }
#undef IN
#undef BOTH
#undef GRID_BAR
}

extern "C" void kernel_launch(void* const* d_in, const int* in_sizes, int n_in, void* d_out, int out_size, void* d_ws, size_t ws_size, hipStream_t stream) {
    static int grid = 0;
    if (grid == 0) {
        if (n_in != 16 || in_sizes[0] != M * D || out_size != M * D || ws_size < WS_END) { fprintf(stderr, "kernel_launch: unexpected shapes (n_in %d, in0 %d, out %d, ws %zu); nothing launched\n", n_in, n_in > 0 ? in_sizes[0] : -1, out_size, ws_size); grid = -1; return; }
        int dev = 0, cus = 0, per_cu = 0;
        if (hipGetDevice(&dev) != hipSuccess || hipDeviceGetAttribute(&cus, hipDeviceAttributeMultiprocessorCount, dev) != hipSuccess) { fprintf(stderr, "kernel_launch: device query failed\n"); grid = -1; return; }
        if (hipOccupancyMaxActiveBlocksPerMultiprocessor(&per_cu, (const void*)mk_fwd, NWAVES * 64, 0) != hipSuccess || per_cu < 1)
            fprintf(stderr, "kernel_launch: note: occupancy query reports %d workgroups per CU\n", per_cu);
        (void)hipGetLastError();
        grid = cus;
    }
    if (grid < 0) return;
    if (hipMemsetAsync((char*)d_ws + WS_CTL, 0, CTL_ZERO_BYTES, stream) != hipSuccess) { fprintf(stderr, "kernel_launch: memset failed\n"); return; }
    Args a{};
    for (int i = 0; i < 16; ++i) a.in[i] = (const float*)d_in[i];
    a.out = (float*)d_out; a.ws = (unsigned char*)d_ws;
    for (int i = 0; i < 64; ++i) a.invf_r[i] = (float)std::pow(10000.0, -(double)i * 2.0 / 128.0);
    for (int i = 0; i < 8; ++i) a.invf_a[i] = (float)std::pow(500000.0, -(double)i * 2.0 / 16.0);
#if MK_PER_PHASE
    for (int p = 0; p < N_PHASES; ++p) { a.ph_lo = p; a.ph_hi = p + 1; a.li = p; hipLaunchKernelGGL(mk_fwd, dim3(grid), dim3(NWAVES * 64), 0, stream, a); }
#else
    a.ph_lo = 0; a.ph_hi = N_PHASES; a.li = 0;
    hipLaunchKernelGGL(mk_fwd, dim3(grid), dim3(NWAVES * 64), 0, stream, a);
#endif
    const hipError_t le = hipPeekAtLastError();
    if (le != hipSuccess) fprintf(stderr, "kernel_launch: launch failed: %s\n", hipGetErrorName(le));
}
```

```cpp
#include <hip/hip_runtime.h>
#include <cstdio>
#include <cstdint>
#include <cmath>
#ifndef MK_NT_P0
#define MK_NT_P0 0
#endif
#ifndef MK_NT_MIX
#define MK_NT_MIX 0
#endif
#if MK_NT_P0
#define P0_LDNT(p) __builtin_nontemporal_load(p)
#define P0_STNT(v, p) __builtin_nontemporal_store((v), (p))
#else
#define P0_LDNT(p) (*(p))
#define P0_STNT(v, p) (*(p) = (v))
#endif
#if MK_NT_MIX
#define MIX_STNT(v, p) __builtin_nontemporal_store((v), (p))
#else
#define MIX_STNT(v, p) (*(p) = (v))
#endif
__device__ __forceinline__ int mk_lane() { int l; asm volatile("v_mbcnt_lo_u32_b32 %0, -1, 0\n\tv_mbcnt_hi_u32_b32 %0, -1, %0" : "=v"(l)); return l; }
#ifndef MK_FP8_WOUT
#define MK_FP8_WOUT 0
#endif
#define MK_FP8_WOUT 1
namespace pg8 {
#define PG8_LAS __attribute__((address_space(3)))
typedef unsigned short bf16_t;
typedef short bf16x8 __attribute__((ext_vector_type(8)));
typedef float f32x4 __attribute__((ext_vector_type(4)));
typedef unsigned u32x4 __attribute__((ext_vector_type(4)));
constexpr int BM = 256, BK = 64, HALF = 128, HTB = HALF * BK * 2  , STAGE_BYTES = 8 * HTB, NXCD = 8, WGM = 8;

__host__ __device__ __forceinline__ int lds_byte(int r, int c) { const int st = (r >> 4) * 2 + (c >> 5), rr = r & 15, cc = c & 31, ob = rr * 64 + cc * 2; return st * 1024 + (ob ^ (((ob >> 9) & 1) << 5)); }
__host__ __device__ __forceinline__ void stage_rc(int b, int& R, int& C) { const int st = b / 1024, sb = b % 1024, swz = sb ^ (((sb >> 9) & 1) << 5); R = (st >> 1) * 16 + swz / 64; C = (st & 1) * 32 + (swz % 64) / 2; }
__host__ __device__ __forceinline__ unsigned a8_block_off(int wc, int R, int pz) { return (unsigned)(wc * 8192 + R * 32 + pz * 16); }
__host__ __device__ __forceinline__ int perm32(int rho) { const int n = rho >> 4, i = rho & 15; return 8 * (i >> 2) + 4 * n + (i & 3); }

struct Unit { int pm, pn; };
struct Gemm { const bf16_t* A; const bf16_t* Bt; int M, N, K; };

struct StaticOrder {
    int nM, nN, nwg, G, c;
    __host__ __device__ void init(int M, int N, int G_, int c_) { nM = M / BM; nN = N / BM; nwg = nM * nN; G = G_; c = c_; }
    __host__ __device__ bool next(int i, Unit& u) const {
        const long L = (long)i * G + c; if (L >= nwg) return false;
        int wgid = (int)L; { const int q = nwg / NXCD, r = nwg % NXCD, xcd = wgid % NXCD, off = wgid / NXCD; wgid = (xcd < r ? xcd * (q + 1) : r * (q + 1) + (xcd - r) * q) + off; }
        const int nig = WGM * nN, gid = wgid / nig, fm = gid * WGM, gsz = (nM - fm) < WGM ? (nM - fm) : WGM;
        u.pm = fm + ((wgid % nig) % gsz); u.pn = (wgid % nig) / gsz; return true;
    }
    __device__ __forceinline__ void a_ready(const Unit&) const {}
    __device__ __forceinline__ void done(const Unit&) const {}
};

__device__ __forceinline__ unsigned cvt_pk_bf16(float lo, float hi) { unsigned r; asm volatile("v_cvt_pk_bf16_f32 %0, %1, %2" : "=v"(r) : "v"(lo), "v"(hi)); return r; }
typedef int i32x8 __attribute__((ext_vector_type(8)));
typedef unsigned u32x2 __attribute__((ext_vector_type(2)));
__device__ __forceinline__ i32x8 cat8(const bf16x8 a, const bf16x8 b) { typedef int i32x4_ __attribute__((ext_vector_type(4))); const i32x4_ x = __builtin_bit_cast(i32x4_, a), y = __builtin_bit_cast(i32x4_, b); return (i32x8){x[0], x[1], x[2], x[3], y[0], y[1], y[2], y[3]}; }
#ifndef MK_F8SAT
#define MK_F8SAT 1
#endif
__device__ __forceinline__ unsigned pk4_fp8(float a, float b, float c, float d) {
#if !MK_F8SAT
    a = __builtin_amdgcn_fmed3f(a, -448.f, 448.f); b = __builtin_amdgcn_fmed3f(b, -448.f, 448.f); c = __builtin_amdgcn_fmed3f(c, -448.f, 448.f); d = __builtin_amdgcn_fmed3f(d, -448.f, 448.f);
#endif
    int w = 0; w = __builtin_amdgcn_cvt_pk_fp8_f32(a, b, w, false); w = __builtin_amdgcn_cvt_pk_fp8_f32(c, d, w, true); return (unsigned)w; }
constexpr float W8_SCALE = 64.0f, H8_SCALE = 8.0f;
constexpr int SS_M = 65536;
__device__ __forceinline__ float rstd_ss16(const float* ss, int row) {
    float s = 0.f;
#pragma unroll
    for (int k = 0; k < 16; ++k) s += ss[(size_t)k * SS_M + row];
    return __builtin_amdgcn_rsqf(s * (1.0f / 1024.0f) + 1e-6f);
}
#define PG8_GAS __attribute__((address_space(1)))
#ifndef MK_NT
#define MK_NT 1
#endif
#ifndef MK_NT_BASE
#define MK_NT_BASE 0
#endif
#if MK_NT_BASE
#define PG8_LDNT_BASE(p) __builtin_nontemporal_load(p)
#else
#define PG8_LDNT_BASE(p) (*(p))
#endif
#ifndef MK_NT_X8
#define MK_NT_X8 1
#endif
#if MK_NT && MK_NT_X8
#define PG8_ST8(p, v) __builtin_nontemporal_store((v), (p))
#else
#define PG8_ST8(p, v) (*(p) = (v))
#endif
#if MK_NT
#define PG8_ST(p, v) __builtin_nontemporal_store((v), (p))
#else
#define PG8_ST(p, v) (*(p) = (v))
#endif
template <typename T> __device__ __forceinline__ PG8_GAS T* gas_ul(const void* base, unsigned uni_off, unsigned lane_off) { return (PG8_GAS T*)(((PG8_GAS char*)base + uni_off) + lane_off); }
template <typename T> __device__ __forceinline__ PG8_GAS T* gas_at(const void* base, unsigned byte_off) { return (PG8_GAS T*)((PG8_GAS char*)base + byte_off); }
__device__ __forceinline__ void rstd8_ss16(const float* ss, int row0, int fq, float (&rr)[8]) {
    float q[8][4];
#pragma unroll
    for (int g = 0; g < 8; ++g)
#pragma unroll
        for (int j = 0; j < 4; ++j) q[g][j] = *gas_at<const float>(ss, ((unsigned)(4 * fq + j) * (unsigned)SS_M + (unsigned)(row0 + (g >> 2) * HALF + (g & 3) * 16)) * 4u);
    asm volatile("" ::: "memory");
#pragma unroll
    for (int g = 0; g < 8; ++g) { float s = (q[g][0] + q[g][1]) + (q[g][2] + q[g][3]); s += __shfl_xor(s, 16); s += __shfl_xor(s, 32); rr[g] = __builtin_amdgcn_rsqf(s * (1.0f / 1024.0f) + 1e-6f); }
}
constexpr int RTAB_SLOTS = 4;
struct RTab { const PG8_LAS float* tab; int pm0; };
template <bool SS16, int KIND = 0, class Sched> __device__ __forceinline__ RTab fill_rstd_table(PG8_LAS float* tab, const Sched& S, const float* src  , int tid, float c1 = 1.0f, float c2 = 1.0f) {
    Unit u; if (!S.next(0, u)) return RTab{nullptr, 0};
    const int pm0 = u.pm; int pml = pm0;
    for (int i = 1; S.next(i, u); ++i) pml = u.pm;
    const int ns = ((pml - pm0) >> 3) + 1;
    if (ns > RTAB_SLOTS || ((pml - pm0) & 7)) return RTab{nullptr, 0};
    const int r = tid >> 1, h = tid & 1;
    if (SS16) {
        float q[RTAB_SLOTS][8];
#pragma unroll
        for (int k = 0; k < RTAB_SLOTS; ++k) { const int pm = k < ns ? pm0 + 8 * k : pm0;
#pragma unroll
            for (int j = 0; j < 8; ++j) q[k][j] = *gas_at<const float>(src, ((unsigned)(h * 8 + j) * (unsigned)SS_M + (unsigned)(pm * BM + r)) * 4u); }
#pragma unroll
        for (int k = 0; k < RTAB_SLOTS; ++k) { float s = ((q[k][0] + q[k][1]) + (q[k][2] + q[k][3])) + ((q[k][4] + q[k][5]) + (q[k][6] + q[k][7])); s += __shfl_xor(s, 1);
            const float rs_ = __builtin_amdgcn_rsqf(s * (1.0f / 1024.0f) + 1e-6f);
            if (h == 0) { if (KIND == 1) { const float r1 = rs_ * c1; tab[2 * (k * BM + r)] = -1.4426950408889634f * r1; tab[2 * (k * BM + r) + 1] = __builtin_amdgcn_rcpf(r1 * r1 * c2); } else tab[k * BM + r] = rs_; } }
    } else {
#pragma unroll
        for (int k = 0; k < RTAB_SLOTS / 2; ++k) { const int kk = 2 * k + h; const int pm = kk < ns ? pm0 + 8 * kk : pm0; const float rs_ = *gas_at<const float>(src, (unsigned)(pm * BM + r) * 4u);
            if (KIND == 1) { const float r1 = rs_ * c1; tab[2 * (kk * BM + r)] = -1.4426950408889634f * r1; tab[2 * (kk * BM + r) + 1] = __builtin_amdgcn_rcpf(r1 * r1 * c2); } else tab[kk * BM + r] = rs_; }
    }
    __syncthreads();
    return RTab{tab, pm0};
}
__device__ __forceinline__ void rstd8_tab(const RTab& t, const Unit& u, int wr, int fr, float (&rr)[8]) {
    const PG8_LAS float* p = t.tab + ((u.pm - t.pm0) >> 3) * BM + wr * 64 + fr;
#pragma unroll
    for (int g = 0; g < 8; ++g) rr[g] = p[(g >> 2) * HALF + (g & 3) * 16];
}
__device__ __forceinline__ void rstd8_tab2(const RTab& t, const Unit& u, int wr, int fr, float (&tt)[8], float (&ii)[8]) {
    typedef float f32x2_ __attribute__((ext_vector_type(2)));
    const PG8_LAS f32x2_* p = (const PG8_LAS f32x2_*)t.tab + ((u.pm - t.pm0) >> 3) * BM + wr * 64 + fr;
#pragma unroll
    for (int g = 0; g < 8; ++g) { const f32x2_ v = p[(g >> 2) * HALF + (g & 3) * 16]; tt[g] = v[0]; ii[g] = v[1]; }
}
__device__ __forceinline__ u32x4 pair_rows_f8(const u32x2 a, const u32x2 b, const int lane) {
    const int i0 = (((lane & 1) * 32 + ((lane >> 1) & 15)) * 4), i1 = i0 + 64; const bool hi = lane >= 32;
    const int ax0 = __builtin_amdgcn_ds_bpermute(i0, (int)a.x), ay0 = __builtin_amdgcn_ds_bpermute(i0, (int)a.y), ax1 = __builtin_amdgcn_ds_bpermute(i1, (int)a.x), ay1 = __builtin_amdgcn_ds_bpermute(i1, (int)a.y);
    const int bx0 = __builtin_amdgcn_ds_bpermute(i0, (int)b.x), by0 = __builtin_amdgcn_ds_bpermute(i0, (int)b.y), bx1 = __builtin_amdgcn_ds_bpermute(i1, (int)b.x), by1 = __builtin_amdgcn_ds_bpermute(i1, (int)b.y);
    u32x4 r; r.x = (unsigned)(hi ? bx0 : ax0); r.y = (unsigned)(hi ? by0 : ay0); r.z = (unsigned)(hi ? bx1 : ax1); r.w = (unsigned)(hi ? by1 : ay1); return r;
}
__device__ __forceinline__ u32x4 rows_linear_b16(const u32x4 w, const int lane) {
    const int src = ((lane & 3) * 16 + (lane >> 2)) * 4; u32x4 r;
    r.x = (unsigned)__builtin_amdgcn_ds_bpermute(src, (int)w.x); r.y = (unsigned)__builtin_amdgcn_ds_bpermute(src, (int)w.y); r.z = (unsigned)__builtin_amdgcn_ds_bpermute(src, (int)w.z); r.w = (unsigned)__builtin_amdgcn_ds_bpermute(src, (int)w.w); return r;
}
template <bool SS16, bool F8 = false, bool BLK = false, bool OUT8 = F8> struct EpiSwiGLU {
    static constexpr bool PERM = true, AFTER_DRAIN = false, BADJ = false; static constexpr int NSTORE = OUT8 ? 4 : 8;
    bf16_t* H; int ldh; const float* rs; RTab rt; PG8_LAS unsigned char* tb8 = nullptr;
    __device__ __forceinline__ void operator()(const f32x4 (&acc)[2][2][4][2], const Unit& u, int wr, int wc, int fr, int fq) const {
        const int row0 = u.pm * BM + wr * 64 + fr; const int col0 = u.pn * HALF + wc * 32 + 8 * fq;
        float tt[8], ii[8];
        if (rt.tab) rstd8_tab2(rt, u, wr, fr, tt, ii);
        else { float rr[8];
            if (SS16) rstd8_ss16(rs, row0, fq, rr);
            else {
#pragma unroll
                for (int g = 0; g < 8; ++g) rr[g] = *gas_at<const float>(rs, (unsigned)(row0 + (g >> 2) * HALF + (g & 3) * 16) * 4u);
                asm volatile("" ::: "memory"); }
#pragma unroll
            for (int g = 0; g < 8; ++g) { const float r = rr[g] * (F8 ? 1.0f / W8_SCALE : 1.0f); tt[g] = -1.4426950408889634f * r; ii[g] = __builtin_amdgcn_rcpf(r * r * (OUT8 ? H8_SCALE : 1.0f)); } }
        u32x2 w8e = {0u, 0u};
#pragma unroll
        for (int ai = 0; ai < 2; ++ai)
#pragma unroll
            for (int m = 0; m < 4; ++m) {
                const int row = row0 + ai * HALF + m * 16;
                const float t = tt[ai * 4 + m], ir2 = ii[ai * 4 + m];
                f32x4 hq[2];
#pragma unroll
                for (int n = 0; n < 2; ++n) { const f32x4 gv = acc[ai][0][m][n], uv = acc[ai][1][m][n];
                    f32x4 e = gv * t; e[0] = __builtin_amdgcn_exp2f(e[0]); e[1] = __builtin_amdgcn_exp2f(e[1]); e[2] = __builtin_amdgcn_exp2f(e[2]); e[3] = __builtin_amdgcn_exp2f(e[3]);
                    f32x4 d = e * ir2 + ir2; d[0] = __builtin_amdgcn_rcpf(d[0]); d[1] = __builtin_amdgcn_rcpf(d[1]); d[2] = __builtin_amdgcn_rcpf(d[2]); d[3] = __builtin_amdgcn_rcpf(d[3]);
                    hq[n] = (gv * uv) * d; }
                if (OUT8) { u32x2 w8; w8.x = pk4_fp8(hq[0][0], hq[0][1], hq[0][2], hq[0][3]); w8.y = pk4_fp8(hq[1][0], hq[1][1], hq[1][2], hq[1][3]);
                    const int l_ = fq * 16 + fr;
                    if (tb8) *(PG8_LAS u32x2*)(tb8 + ((m & 1) * 16 + fr) * 32 + fq * 8) = w8;
                    if ((m & 1) == 0) w8e = w8;
                    else { const u32x4 w16 = tb8 ? *(const PG8_LAS u32x4*)(tb8 + (l_ >> 1) * 32 + (l_ & 1) * 16) : pair_rows_f8(w8e, w8, l_);
                        const int R = ai * HALF + wr * 64 + (m - 1 + (l_ >> 5)) * 16 + ((l_ >> 1) & 15);
                        if (BLK) PG8_ST(gas_ul<u32x4>(H, (unsigned)(u.pm * (ldh >> 7) + u.pn) * 32768u + a8_block_off(wc, ai * HALF + wr * 64 + (m - 1) * 16, 0), a8_block_off(0, (l_ >> 5) * 16 + ((l_ >> 1) & 15), l_ & 1)), w16);
                        else *gas_at<u32x4>(H, (unsigned)(u.pm * BM + R) * (unsigned)ldh + (unsigned)(u.pn * HALF + wc * 32 + (l_ & 1) * 16)) = w16; } }
                else {
                u32x4 w; w.x = cvt_pk_bf16(hq[0][0], hq[0][1]); w.y = cvt_pk_bf16(hq[0][2], hq[0][3]); w.z = cvt_pk_bf16(hq[1][0], hq[1][1]); w.w = cvt_pk_bf16(hq[1][2], hq[1][3]);
                if (BLK) { const int l_ = fq * 16 + fr; const u32x4 wl = rows_linear_b16(w, l_);
                    PG8_ST(gas_at<u32x4>(H, (unsigned)(u.pm * (ldh >> 7) + u.pn) * 65536u + (unsigned)(wc * 16384 + (ai * HALF + wr * 64 + m * 16 + (l_ >> 2)) * 64 + (l_ & 3) * 16)), wl); }
                else *gas_at<u32x4>(H, ((unsigned)row * (unsigned)ldh + (unsigned)col0) * 2u) = w; }
            }
    }
};
template <bool BASE_BF, bool OUT_F32, bool OUT_BF, int ALPHA_MODE, bool OUT_F8 = false, bool F8BLK = true> struct EpiResid {
    static constexpr bool PERM = true, AFTER_DRAIN = false, BADJ = true; static constexpr int NSTORE = (OUT_F32 ? 32 : 0) + (OUT_BF ? 18 : 0) + (OUT_F8 ? 8 : 0);
    const float* basef; const bf16_t* baseb; float* outf; bf16_t* xb; float* ss; unsigned char* x8; PG8_LAS unsigned char* tb;
    __device__ __forceinline__ void operator()(const f32x4 (&acc)[2][2][4][2], const Unit& u, int wr, int wc, int fr, int fq) const {
        const int row0 = u.pm * BM + wr * 64 + fr; const int col0 = u.pn * BM + wc * 64 + 8 * fq; const float alpha = ALPHA_MODE == 0 ? 1.0f : (ALPHA_MODE == 1 ? 0.5f : (ALPHA_MODE == 2 ? 0.5f / (W8_SCALE * H8_SCALE) : 1.0f / W8_SCALE));
        const int l_ = fq * 16 + fr;
        u32x4 bb[2][4][2];
        if (BASE_BF) {
#pragma unroll
            for (int ai = 0; ai < 2; ++ai)
#pragma unroll
                for (int m = 0; m < 4; ++m)
#pragma unroll
                    for (int bj = 0; bj < 2; ++bj) bb[ai][m][bj] = PG8_LDNT_BASE(gas_ul<const u32x4>(baseb, ((unsigned)(u.pm * BM + wr * 64 + ai * HALF + m * 16) * 1024u + (unsigned)(u.pn * BM + wc * 64 + bj * 32)) * 2u, (unsigned)(fr * 1024 + 8 * fq) * 2u));
            asm volatile("" ::: "memory");
        }
#define PG8_TBROW(b, r) (tb + (r) * 144)
        auto emit = [&](const int ps) {
#pragma unroll
            for (int k = 0; k < 2; ++k) { const int r = (l_ >> 3) + 8 * k; const u32x4 o = *(const PG8_LAS u32x4*)(PG8_TBROW(ps, r) + (l_ & 7) * 16);
                if (OUT_F32) { const int pai = ps >> 3, pmm = (ps >> 1) & 3, pbj = ps & 1;
                    PG8_ST(gas_ul<u32x4>(outf, ((unsigned)(u.pm * BM + pai * HALF + wr * 64 + pmm * 16 + 8 * k) * 1024u + (unsigned)(u.pn * BM + wc * 64 + pbj * 32)) * 4u, (unsigned)(l_ >> 3) * 4096u + (unsigned)(l_ & 7) * 16u), o); }
                else { const int pai = ps >> 2, pmm = ps & 3;
                    PG8_ST(gas_ul<u32x4>(xb, ((unsigned)(u.pm * BM + pai * HALF + wr * 64 + pmm * 16 + 8 * k) * 1024u + (unsigned)(u.pn * BM + wc * 64)) * 2u, (unsigned)(l_ >> 3) * 2048u + (unsigned)(l_ & 7) * 16u), o); } }
        };
        u32x2 w8e[2] = {{0u, 0u}, {0u, 0u}}; float sqv[4] = {0.f, 0.f, 0.f, 0.f};
#pragma unroll
        for (int ai = 0; ai < 2; ++ai)
#pragma unroll
            for (int m = 0; m < 4; ++m) {
                const int row = row0 + ai * HALF + m * 16; const unsigned off = (unsigned)row * 1024u + (unsigned)col0; float sq = 0.f; f32x4 sq4 = {0.f, 0.f, 0.f, 0.f};
#pragma unroll
                for (int bj = 0; bj < 2; ++bj) {
                    f32x4 b0, b1;
                    if (BASE_BF) { const u32x4 r = bb[ai][m][bj];
                        b0 = (f32x4){__uint_as_float(r.x << 16), __uint_as_float(r.x & 0xffff0000u), __uint_as_float(r.y << 16), __uint_as_float(r.y & 0xffff0000u)};
                        b1 = (f32x4){__uint_as_float(r.z << 16), __uint_as_float(r.z & 0xffff0000u), __uint_as_float(r.w << 16), __uint_as_float(r.w & 0xffff0000u)}; }
                    else { b0 = *(const f32x4*)(basef + off + bj * 32); b1 = *(const f32x4*)(basef + off + bj * 32 + 4); }
                    const f32x4 v0 = b0 + acc[ai][bj][m][0] * alpha, v1 = b1 + acc[ai][bj][m][1] * alpha;
                    if (OUT_F32) {
                        const int st = ai * 8 + m * 2 + bj; PG8_LAS unsigned char* p = PG8_TBROW(st, fr) + fq * 32;
                        *(PG8_LAS f32x4*)p = v0; *(PG8_LAS f32x4*)(p + 16) = v1;
                        emit(st);
                    }
                    if (OUT_BF) {
                        u32x4 w; w.x = cvt_pk_bf16(v0[0], v0[1]); w.y = cvt_pk_bf16(v0[2], v0[3]); w.z = cvt_pk_bf16(v1[0], v1[1]); w.w = cvt_pk_bf16(v1[2], v1[3]);
                        *(PG8_LAS u32x4*)(PG8_TBROW(ai * 4 + m, fr) + bj * 64 + fq * 16) = w;
                        sq4 = sq4 + v0 * v0; sq4 = sq4 + v1 * v1;
                    }
                    if (OUT_F8) { u32x2 w8; w8.x = pk4_fp8(v0[0], v0[1], v0[2], v0[3]); w8.y = pk4_fp8(v1[0], v1[1], v1[2], v1[3]);
                        if ((m & 1) == 0) w8e[bj] = w8;
                        else { const u32x4 w16 = pair_rows_f8(w8e[bj], w8, l_);
                            const int R = ai * HALF + wr * 64 + (m - 1 + (l_ >> 5)) * 16 + ((l_ >> 1) & 15);
                            if (F8BLK) PG8_ST8(gas_ul<u32x4>(x8, (unsigned)(u.pm * 8 + u.pn * 2 + (wc >> 1)) * 32768u + a8_block_off(2 * (wc & 1) + bj, ai * HALF + wr * 64 + (m - 1) * 16, 0), a8_block_off(0, (l_ >> 5) * 16 + ((l_ >> 1) & 15), l_ & 1)), w16);
                            else *gas_at<u32x4>(x8, (unsigned)(u.pm * BM + R) * 1024u + (unsigned)(u.pn * BM + wc * 64 + bj * 32 + (l_ & 1) * 16)) = w16; } }
                }
                if (OUT_BF) { emit(ai * 4 + m);
                    sq = (sq4[0] + sq4[1]) + (sq4[2] + sq4[3]);
                    sq += __shfl_xor(sq, 16); sq += __shfl_xor(sq, 32); sqv[m] = sq;
                    if (m == 3) { const float v = fq == 0 ? sqv[0] : (fq == 1 ? sqv[1] : (fq == 2 ? sqv[2] : sqv[3]));
                        *gas_ul<float>(ss, ((unsigned)(u.pn * 4 + wc) * (unsigned)SS_M + (unsigned)(u.pm * BM + ai * HALF + wr * 64)) * 4u, (unsigned)l_ * 4u) = v; } }
            }
#undef PG8_TBROW
    }
};
template <int ALPHA_MODE> struct EpiOutF32 {
    static constexpr bool PERM = false, AFTER_DRAIN = false, BADJ = false; static constexpr int NSTORE = 32;
    const bf16_t* baseb; float* outf;
    __device__ __forceinline__ void operator()(const f32x4 (&acc)[2][2][4][2], const Unit& u, int wr, int wc, int fr, int fq) const {
        const int row0 = u.pm * BM + wr * 64 + fr; const int col0 = u.pn * BM + wc * 32 + 4 * fq; const float alpha = ALPHA_MODE == 1 ? 0.5f : 0.5f / (W8_SCALE * H8_SCALE);
        u32x2 bb[2][4][2][2];
#pragma unroll
        for (int ai = 0; ai < 2; ++ai)
#pragma unroll
            for (int m = 0; m < 4; ++m)
#pragma unroll
                for (int bj = 0; bj < 2; ++bj)
#pragma unroll
                    for (int n = 0; n < 2; ++n) bb[ai][m][bj][n] = *gas_at<const u32x2>(baseb, ((unsigned)(row0 + ai * HALF + m * 16) * 1024u + (unsigned)(col0 + bj * HALF + 16 * n)) * 2u);
        asm volatile("" ::: "memory");
#pragma unroll
        for (int ai = 0; ai < 2; ++ai)
#pragma unroll
            for (int m = 0; m < 4; ++m) {
                const unsigned off = (unsigned)(row0 + ai * HALF + m * 16) * 1024u + (unsigned)col0;
#pragma unroll
                for (int bj = 0; bj < 2; ++bj)
#pragma unroll
                    for (int n = 0; n < 2; ++n) { const u32x2 r = bb[ai][m][bj][n];
                        const f32x4 b = {__uint_as_float(r.x << 16), __uint_as_float(r.x & 0xffff0000u), __uint_as_float(r.y << 16), __uint_as_float(r.y & 0xffff0000u)};
                        *gas_at<f32x4>(outf, (off + bj * HALF + 16 * n) * 4u) = b + acc[ai][bj][m][n] * alpha; }
            }
    }
};
__host__ __device__ __forceinline__ int att_dim(int bj, int fq, int n, int i) { return bj == 0 ? (fq < 2 ? (n == 0 ? 4 * fq + i : 8 + 4 * fq + i) : 8 * fq + 4 * n + i) : 32 + 8 * fq + 4 * n + i; }
__host__ __device__ __forceinline__ int win_orig_col(int c) {
    const int pn = c >> 8, w = c & 255, wc = w >> 6, bj = (w >> 5) & 1, fq = (w >> 3) & 3, n = (w >> 2) & 1, i = w & 3;
    if (pn < 4) { const int head = 2 * (pn & 1) + bj, g = 4 * wc + fq; return (pn < 2 ? 0 : 512) + head * 128 + (n == 0 ? 4 * g + i : 64 + 4 * g + i); }
    if (pn >= 8 && pn < 12) { const int head = 4 * (pn & 1) + wc; return (pn < 10 ? 2048 : 2560) + head * 64 + att_dim(bj, fq, n, i); }
    return c;
}
template <int MODE = 0, bool F8 = false> struct EpiProjFused {
    static constexpr bool PERM = true, AFTER_DRAIN = false, BADJ = true; static constexpr int NSTORE = 16;
    bf16_t* O; int ldo; const float* ss; const f32x4* rope_r; const f32x4* rope_a; const float* qnw; const float* knw; float* kmean; PG8_LAS unsigned char* tb; RTab rt;
    __device__ __forceinline__ void operator()(const f32x4 (&acc)[2][2][4][2], const Unit& u, int wr, int wc, int fr, int fq) const {
        const int pn = MODE == 1 ? u.pn + 8 : (MODE == 2 ? (u.pn < 8 ? u.pn : u.pn + 4) : (MODE == 3 ? (u.pn < 4 ? u.pn : u.pn + 2) : (MODE == 4 ? (u.pn < 2 ? u.pn + 4 : u.pn + 10) : u.pn))); const float dsc = F8 ? 1.0f / W8_SCALE : 1.0f;
#define PG8_EMIT_ROWS() do { const int l_ = fq * 16 + fr; _Pragma("unroll") for (int k_ = 0; k_ < 2; ++k_) { const u32x4 o_ = *(const PG8_LAS u32x4*)(tb + ((l_ >> 3) + 8 * k_) * 144 + (l_ & 7) * 16); \
        PG8_ST(gas_ul<u32x4>(O, ((unsigned)(u.pm * BM + ai * HALF + wr * 64 + m * 16 + 8 * k_) * (unsigned)ldo + (unsigned)(pn * BM + wc * 64)) * 2u, (unsigned)(l_ >> 3) * (unsigned)ldo * 2u + (unsigned)(l_ & 7) * 16u), o_); } } while (0)
#define PG8_EPI_LANE() asm volatile("" : "+v"(fr), "+v"(fq)); const int row0 = u.pm * BM + wr * 64 + fr; const int col0 = pn * BM + wc * 64 + 8 * fq
        if (MODE != 1 && MODE != 4 && pn < 4) {
            PG8_EPI_LANE();
            const float sc = pn >= 2 ? 0.08838834764831845f : 1.0f; const int g = 4 * wc + fq;
            f32x4 cs[2][4][2];
#pragma unroll
            for (int m = 0; m < 4; ++m)
#pragma unroll
                for (int h = 0; h < 2; ++h) cs[0][m][h] = *gas_at<const f32x4>(rope_r, ((unsigned)((row0 + m * 16) & 2047) * 64u + 4u * (unsigned)g) * 8u + 16u * h);
            float rr[8];
            if (rt.tab) rstd8_tab(rt, u, wr, fr, rr); else rstd8_ss16(ss, row0, fq, rr);
            asm volatile("" ::: "memory");
#pragma unroll
            for (int gi = 0; gi < 8; ++gi) rr[gi] *= (sc * dsc);
#pragma unroll
            for (int m = 0; m < 4; ++m)
#pragma unroll
                for (int h = 0; h < 2; ++h) cs[1][m][h] = *gas_at<const f32x4>(rope_r, ((unsigned)((row0 + HALF + m * 16) & 2047) * 64u + 4u * (unsigned)g) * 8u + 16u * h);
            asm volatile("" ::: "memory");
#pragma unroll
            for (int ai = 0; ai < 2; ++ai)
#pragma unroll
                for (int m = 0; m < 4; ++m) {
                    const int row = row0 + ai * HALF + m * 16; const float r = rr[ai * 4 + m];
                    const f32x4 c01 = cs[ai][m][0], c23 = cs[ai][m][1];
                    const f32x4 cv = {c01[0], c01[2], c23[0], c23[2]}, sv = {c01[1], c01[3], c23[1], c23[3]};
#pragma unroll
                    for (int bj = 0; bj < 2; ++bj) { const f32x4 x1 = acc[ai][bj][m][0] * r, x2 = acc[ai][bj][m][1] * r;
                        const f32x4 v0 = x1 * cv - x2 * sv, v1 = x2 * cv + x1 * sv;
                        u32x4 w; w.x = cvt_pk_bf16(v0[0], v0[1]); w.y = cvt_pk_bf16(v0[2], v0[3]); w.z = cvt_pk_bf16(v1[0], v1[1]); w.w = cvt_pk_bf16(v1[2], v1[3]);
                        *(PG8_LAS u32x4*)(tb + fr * 144 + bj * 64 + fq * 16) = w; }
                    PG8_EMIT_ROWS();
                }
        } else if (MODE != 2 && MODE != 4 && pn >= 8 && pn < 12) {
            PG8_EPI_LANE();
            const bool isk = pn >= 10; const float* gw = isk ? knw : qnw;
            const float qs = isk ? 1.0f : 0.125f * 1.4426950408889634f;
            f32x4 gg[2][2], ca[4][2];
#pragma unroll
            for (int bj = 0; bj < 2; ++bj)
#pragma unroll
                for (int n = 0; n < 2; ++n) gg[bj][n] = *gas_at<const f32x4>(gw, (unsigned)att_dim(bj, fq, n, 0) * 4u);
            const unsigned cof = 4u * (unsigned)(fq & 1) * 8u;
#pragma unroll
            for (int m = 0; m < 4; ++m)
#pragma unroll
                for (int h = 0; h < 2; ++h) ca[m][h] = *gas_at<const f32x4>(rope_a, (unsigned)((row0 + m * 16) & 2047) * 64u + cof + 16u * h);
            float rr[8];
            if (rt.tab) rstd8_tab(rt, u, wr, fr, rr); else rstd8_ss16(ss, row0, fq, rr);
            asm volatile("" ::: "memory");
#pragma unroll
            for (int gi = 0; gi < 8; ++gi) rr[gi] *= dsc;
            f32x4 ksum[2][2];
#pragma unroll
            for (int bj = 0; bj < 2; ++bj)
#pragma unroll
                for (int n = 0; n < 2; ++n) ksum[bj][n] = (f32x4){0.f, 0.f, 0.f, 0.f};
#pragma unroll
            for (int ai = 0; ai < 2; ++ai)
#pragma unroll
                for (int m = 0; m < 4; ++m) {
                    const int row = row0 + ai * HALF + m * 16; const float r = rr[ai * 4 + m];
                    const f32x4 c01 = ca[m][0], c23 = ca[m][1];
                    if (ai == 0) {
#pragma unroll
                        for (int h = 0; h < 2; ++h) ca[m][h] = *gas_at<const f32x4>(rope_a, (unsigned)((row0 + HALF + m * 16) & 2047) * 64u + cof + 16u * h);
                    }
                    float sq = 0.f;
#pragma unroll
                    for (int bj = 0; bj < 2; ++bj)
#pragma unroll
                        for (int n = 0; n < 2; ++n) { const f32x4 a = acc[ai][bj][m][n]; sq += (a[0] * a[0] + a[1] * a[1]) + (a[2] * a[2] + a[3] * a[3]); }
                    sq += __shfl_xor(sq, 16); sq += __shfl_xor(sq, 32);
                    const float s = r * __builtin_amdgcn_rsqf(sq * (r * r) * (1.0f / 64.0f) + 1e-6f);
#pragma unroll
                    for (int bj = 0; bj < 2; ++bj) {
                        f32x4 y0 = acc[ai][bj][m][0] * s * gg[bj][0], y1 = acc[ai][bj][m][1] * s * gg[bj][1];
                        if (bj == 0 && fq < 2) {
                            const f32x4 cv = {c01[0], c01[2], c23[0], c23[2]}, sv = {c01[1], c01[3], c23[1], c23[3]};
                            const f32x4 x1 = y0, x2 = y1; y0 = x1 * cv - x2 * sv; y1 = x2 * cv + x1 * sv;
                        }
                        if (isk) { ksum[bj][0] += y0; ksum[bj][1] += y1; }
                        asm volatile("" : "+v"(ksum[bj][0]), "+v"(ksum[bj][1]));
                        const f32x4 v0 = y0 * qs, v1 = y1 * qs;
                        u32x4 w; w.x = cvt_pk_bf16(v0[0], v0[1]); w.y = cvt_pk_bf16(v0[2], v0[3]); w.z = cvt_pk_bf16(v1[0], v1[1]); w.w = cvt_pk_bf16(v1[2], v1[3]);
                        *(PG8_LAS u32x4*)(tb + fr * 144 + bj * 64 + fq * 16) = w;
                        asm volatile("" ::: "memory");
                    }
                    PG8_EMIT_ROWS();
                }
            if (isk) {
                const unsigned kmo = ((unsigned)(((u.pm >> 3) * 8 + 4 * (pn & 1) + wc) * 8 + (u.pm & 7)) * 64u + 8u * (unsigned)fq) * 4u;
#pragma unroll
                for (int bj = 0; bj < 2; ++bj)
#pragma unroll
                    for (int n = 0; n < 2; ++n)
#pragma unroll
                        for (int i = 0; i < 4; ++i) { float v = ksum[bj][n][i]; v += __shfl_xor(v, 1); v += __shfl_xor(v, 2); v += __shfl_xor(v, 4); v += __shfl_xor(v, 8);
                            if (fr == 0) __hip_atomic_fetch_add(gas_at<float>(kmean, kmo + (unsigned)(32 * bj + 4 * n + i) * 4u), v * (1.0f / 256.0f), __ATOMIC_RELAXED, __HIP_MEMORY_SCOPE_AGENT); }
            }
        } else {
            PG8_EPI_LANE();
            float rr[8]; if (rt.tab) rstd8_tab(rt, u, wr, fr, rr); else rstd8_ss16(ss, row0, fq, rr);
#pragma unroll
            for (int ai = 0; ai < 2; ++ai)
#pragma unroll
                for (int m = 0; m < 4; ++m) {
                    const int row = row0 + ai * HALF + m * 16; const float r = rr[ai * 4 + m] * dsc;
#pragma unroll
                    for (int bj = 0; bj < 2; ++bj) { const f32x4 v0 = acc[ai][bj][m][0] * r, v1 = acc[ai][bj][m][1] * r;
                        u32x4 w; w.x = cvt_pk_bf16(v0[0], v0[1]); w.y = cvt_pk_bf16(v0[2], v0[3]); w.z = cvt_pk_bf16(v1[0], v1[1]); w.w = cvt_pk_bf16(v1[2], v1[3]);
                        *(PG8_LAS u32x4*)(tb + fr * 144 + bj * 64 + fq * 16) = w; }
                    PG8_EMIT_ROWS();
                }
        }
#undef PG8_EPI_LANE
#undef PG8_EMIT_ROWS
    }
};

struct EpiNone {
    static constexpr bool PERM = true, AFTER_DRAIN = false, BADJ = false; static constexpr int NSTORE = 0;
    __device__ __forceinline__ void operator()(const f32x4 (&acc)[2][2][4][2], const Unit&, int, int, int, int) const {
#pragma unroll
        for (int a = 0; a < 2; ++a)
#pragma unroll
            for (int b = 0; b < 2; ++b)
#pragma unroll
                for (int m = 0; m < 4; ++m)
#pragma unroll
                    for (int n = 0; n < 2; ++n) asm volatile("" :: "v"(acc[a][b][m][n]));
    }
};
struct Row0Order : StaticOrder { __host__ __device__ bool next(int i, Unit& u) const { const bool r = StaticOrder::next(i, u); u.pm = 0; return r; } };
struct EpiProj {
    static constexpr bool PERM = true, AFTER_DRAIN = false, BADJ = false; static constexpr int NSTORE = 16;
    bf16_t* O; int ldo; const float* ss;
    __device__ __forceinline__ void operator()(const f32x4 (&acc)[2][2][4][2], const Unit& u, int wr, int wc, int fr, int fq) const {
        const int row0 = u.pm * BM + wr * 64 + fr; const int col0 = u.pn * BM + wc * 32 + 8 * fq;
#pragma unroll
        for (int ai = 0; ai < 2; ++ai)
#pragma unroll
            for (int m = 0; m < 4; ++m) {
                const int row = row0 + ai * HALF + m * 16; const float r = rstd_ss16(ss, row);
#pragma unroll
                for (int bj = 0; bj < 2; ++bj) { const f32x4 v0 = acc[ai][bj][m][0] * r, v1 = acc[ai][bj][m][1] * r;
                    u32x4 w; w.x = cvt_pk_bf16(v0[0], v0[1]); w.y = cvt_pk_bf16(v0[2], v0[3]); w.z = cvt_pk_bf16(v1[0], v1[1]); w.w = cvt_pk_bf16(v1[2], v1[3]);
                    *(u32x4*)(O + (size_t)row * ldo + col0 + bj * HALF) = w; }
            }
    }
};

#ifndef MK_RELAX
#define MK_RELAX 0
#endif
template <class Epi, class Sched, bool ALIGN_EPI = false, bool SP2 = false, bool FP8 = false, int ALAYOUT = 0>
__device__ __forceinline__ void gemm_phase(PG8_LAS unsigned char* lds, const Gemm g, const Sched& S, const Epi& E, const int wv  ) {
    int tid_ = wv * 64 + mk_lane(); asm volatile("" : "+v"(tid_));
    const int tid = tid_, wid = __builtin_amdgcn_readfirstlane(tid >> 6), lane = tid & 63, wr = wid >> 2, wc = wid & 3, fr = lane & 15, fq = lane >> 4;
    const int K = g.K, nt = FP8 ? K / (2 * BK) : K / BK;
    unsigned voffA[2], voffB[2];
#pragma unroll
    for (int i = 0; i < 2; ++i) { int R, C; stage_rc(tid * 16 + i * 8192, R, C); const int Rb = Epi::PERM ? ((R & ~31) + perm32(R & 31)) : R;
        voffA[i] = ALAYOUT == 2 ? (unsigned)((C >> 5) * 16384 + R * 64 + ((C >> 3) & 3) * 16) : ALAYOUT == 1 ? a8_block_off(C >> 4, R, (C >> 3) & 1) : (FP8 ? (unsigned)(R * K + C * 2) : (unsigned)(R * K + C) * 2u); const int Rb2 = Epi::BADJ ? 64 * (Rb >> 5) + (Rb & 31) : Rb; voffB[i] = FP8 ? (unsigned)(Rb2 * K + C * 2) : (unsigned)(Rb2 * K + C) * 2u; }
    const size_t kstep = (size_t)(BK * 2);
    const size_t hstep = FP8 ? (size_t)HALF * K : (size_t)HALF * K * 2;
    const size_t tstep = 2 * hstep;
    const size_t hstepB = Epi::BADJ ? hstep / 4 : hstep;
    const size_t kstepA = ALAYOUT != 0 ? (size_t)32768 : kstep, hstepA = ALAYOUT == 1 ? (size_t)4096 : (ALAYOUT == 2 ? (size_t)8192 : hstep);
    const unsigned ldsw = (unsigned)wid * 1024u;
    const int aoff = lds_byte(wr * 64 + fr, fq * 8), boff = lds_byte(wc * 32 + fr, fq * 8);
    const PG8_LAS unsigned char* ldsB = lds + 4 * HTB + boff; asm volatile("" : "+v"(ldsB));
#define PG8_SA(b, h) (((b) * 2 + (h)) * HTB)
#define PG8_SB(b, h) ((4 + (b) * 2 + (h)) * HTB)
#define PG8_STAGE(bufoff, gbase, voff) do { _Pragma("unroll") for (int _i = 0; _i < 2; ++_i) { unsigned vo_ = (voff)[_i]; asm volatile("" : "+v"(vo_)); \
        __builtin_amdgcn_global_load_lds((const unsigned*)((const char*)(gbase) + vo_), (PG8_LAS unsigned*)(lds + (bufoff) + ldsw + _i * 8192), 16, 0, 0); } } while (0)
#define PG8_LDA(dst, b, h) do { _Pragma("unroll") for (int m = 0; m < 4; ++m) _Pragma("unroll") for (int k = 0; k < 2; ++k) dst[m][k] = *(const PG8_LAS bf16x8*)(lds + PG8_SA(b, h) + aoff + m * 2048 + k * 1024); } while (0)
#define PG8_LDB(dst, b, h) do { _Pragma("unroll") for (int n = 0; n < 2; ++n) _Pragma("unroll") for (int k = 0; k < 2; ++k) dst[n][k] = *(const PG8_LAS bf16x8*)(ldsB + (PG8_SB(b, h) - 4 * HTB) + n * 2048 + k * 1024); } while (0)
#define PG8_MMA(ai, bj, At, Bt) do { __builtin_amdgcn_s_setprio(1); _Pragma("unroll") for (int m = 0; m < 4; ++m) _Pragma("unroll") for (int n = 0; n < 2; ++n) { \
        if constexpr (FP8) { acc[ai][bj][m][n] = __builtin_amdgcn_mfma_scale_f32_16x16x128_f8f6f4(cat8(Bt[n][0], Bt[n][1]), cat8(At[m][0], At[m][1]), acc[ai][bj][m][n], 0, 0, 0, 0, 0, 0); } \
        else { _Pragma("unroll") for (int k = 0; k < 2; ++k) acc[ai][bj][m][n] = __builtin_amdgcn_mfma_f32_16x16x32_bf16(Bt[n][k], At[m][k], acc[ai][bj][m][n], 0, 0, 0); } } __builtin_amdgcn_s_setprio(0); } while (0)
#ifndef MK_MMAZ
#define MK_MMAZ 0
#endif
#define PG8_MMAZ(ai, bj, At, Bt) do { __builtin_amdgcn_s_setprio(1); const f32x4 z4_ = {0.f, 0.f, 0.f, 0.f}; _Pragma("unroll") for (int m = 0; m < 4; ++m) _Pragma("unroll") for (int n = 0; n < 2; ++n) { \
        if constexpr (FP8) { acc[ai][bj][m][n] = __builtin_amdgcn_mfma_scale_f32_16x16x128_f8f6f4(cat8(Bt[n][0], Bt[n][1]), cat8(At[m][0], At[m][1]), z4_, 0, 0, 0, 0, 0, 0); } \
        else { acc[ai][bj][m][n] = __builtin_amdgcn_mfma_f32_16x16x32_bf16(Bt[n][0], At[m][0], z4_, 0, 0, 0); acc[ai][bj][m][n] = __builtin_amdgcn_mfma_f32_16x16x32_bf16(Bt[n][1], At[m][1], acc[ai][bj][m][n], 0, 0, 0); } } __builtin_amdgcn_s_setprio(0); } while (0)
#define PG8_WAIT_V(n) asm volatile("s_waitcnt vmcnt(" #n ")" ::: "memory")
#define PG8_WAIT_L(n) asm volatile("s_waitcnt lgkmcnt(" #n ")" ::: "memory")
#define PG8_WAIT_V8X() do { if (rx) asm volatile("s_waitcnt vmcnt(%0)" :: "n"(8 + Epi::NSTORE) : "memory"); else asm volatile("s_waitcnt vmcnt(8)" ::: "memory"); } while (0)
#define PG8_BAR __builtin_amdgcn_s_barrier()
#define PG8_SCHED __builtin_amdgcn_sched_barrier(0)
    Unit cur, nxt; int ui = 0;
    if (!S.next(0, cur)) return;
    f32x4 acc[2][2][4][2];
    if constexpr (!(SP2 && MK_MMAZ))
#pragma unroll
    for (int a = 0; a < 2; ++a)
#pragma unroll
        for (int b = 0; b < 2; ++b)
#pragma unroll
            for (int m = 0; m < 4; ++m)
#pragma unroll
                for (int n = 0; n < 2; ++n) acc[a][b][m][n] = (f32x4){0.f, 0.f, 0.f, 0.f};
    bf16x8 At[4][2], B0[2][2], B1[2][2];
    const char* cA = (const char*)g.A + (size_t)cur.pm * tstep; const char* cB = (const char*)g.Bt + (size_t)cur.pn * tstep;
    S.a_ready(cur);
    if constexpr (SP2) {
        PG8_STAGE(PG8_SB(0, 0), cB, voffB); PG8_STAGE(PG8_SB(0, 1), cB + hstepB, voffB); PG8_STAGE(PG8_SA(0, 0), cA, voffA); PG8_STAGE(PG8_SA(0, 1), cA + hstepA, voffA);
        if (wr == 1) PG8_BAR;
        PG8_WAIT_V(2); PG8_BAR;
        PG8_STAGE(PG8_SB(1, 0), cB + kstep, voffB); PG8_STAGE(PG8_SA(1, 0), cA + kstepA, voffA); PG8_STAGE(PG8_SB(1, 1), cB + hstepB + kstep, voffB);
        PG8_WAIT_V(6); PG8_BAR;
    } else {
        PG8_STAGE(PG8_SB(0, 0), cB, voffB); PG8_STAGE(PG8_SA(0, 0), cA, voffA); PG8_STAGE(PG8_SB(0, 1), cB + hstepB, voffB); PG8_STAGE(PG8_SA(0, 1), cA + hstepA, voffA);
        if (wr == 1) PG8_BAR;
        PG8_WAIT_V(4); PG8_BAR;
        PG8_STAGE(PG8_SB(1, 0), cB + kstep, voffB); PG8_STAGE(PG8_SA(1, 0), cA + kstepA, voffA); PG8_STAGE(PG8_SB(1, 1), cB + hstepB + kstep, voffB);
        PG8_WAIT_V(6); PG8_BAR;
    }
    for (;;) {
        const bool has_next = S.next(ui + 1, nxt);
        const char* nA = has_next ? (const char*)g.A + (size_t)nxt.pm * tstep : cA; const char* nB = has_next ? (const char*)g.Bt + (size_t)nxt.pn * tstep : cB;
#pragma unroll 1
        for (int t = 0; t < nt; t += 2) {
            const bool last = (t == nt - 2); const bool rx = (t == 0) && (ui > 0) && (Epi::NSTORE > 0) && MK_RELAX;
            const char* a1 = cA + (size_t)(t + 1) * kstepA;
            const char* a2 = last ? nA : cA + (size_t)(t + 2) * kstepA; const char* b2 = last ? nB : cB + (size_t)(t + 2) * kstep;
            const char* a3 = a2 + kstepA; const char* b3 = b2 + kstep;
            if (last && has_next) S.a_ready(nxt);
            if constexpr (SP2) {
            PG8_LDB(B0, 0, 0); PG8_LDB(B1, 0, 1); PG8_SCHED; PG8_LDA(At, 0, 0); PG8_STAGE(PG8_SA(1, 1), a1 + hstepA, voffA);
            PG8_WAIT_V8X(); PG8_WAIT_L(0); PG8_BAR; if (MK_MMAZ && t == 0) { PG8_MMAZ(0, 0, At, B0); PG8_MMAZ(0, 1, At, B1); } else { PG8_MMA(0, 0, At, B0); PG8_MMA(0, 1, At, B1); } PG8_BAR; PG8_SCHED;
            PG8_LDA(At, 0, 1); PG8_STAGE(PG8_SB(0, 0), b2, voffB); PG8_STAGE(PG8_SB(0, 1), b2 + hstepB, voffB); PG8_STAGE(PG8_SA(0, 0), a2, voffA);
            PG8_WAIT_V8X(); PG8_WAIT_L(0); PG8_BAR; if (MK_MMAZ && t == 0) { PG8_MMAZ(1, 0, At, B0); PG8_MMAZ(1, 1, At, B1); } else { PG8_MMA(1, 0, At, B0); PG8_MMA(1, 1, At, B1); } PG8_BAR; PG8_SCHED;
            PG8_LDB(B0, 1, 0); PG8_LDB(B1, 1, 1); PG8_SCHED; PG8_LDA(At, 1, 0); PG8_STAGE(PG8_SA(0, 1), a2 + hstepA, voffA);
            PG8_WAIT_V(8); PG8_WAIT_L(0); PG8_BAR; PG8_MMA(0, 0, At, B0); PG8_MMA(0, 1, At, B1); PG8_BAR; PG8_SCHED;
            PG8_LDA(At, 1, 1); PG8_STAGE(PG8_SB(1, 0), b3, voffB); PG8_STAGE(PG8_SB(1, 1), b3 + hstepB, voffB); PG8_STAGE(PG8_SA(1, 0), a3, voffA);
            PG8_WAIT_V(8); PG8_WAIT_L(0); PG8_BAR; PG8_MMA(1, 0, At, B0); PG8_MMA(1, 1, At, B1); PG8_BAR; PG8_SCHED;
            } else {
            PG8_LDB(B0, 0, 0); PG8_SCHED; PG8_LDA(At, 0, 0); PG8_STAGE(PG8_SA(1, 1), a1 + hstepA, voffA);
            PG8_WAIT_L(8); PG8_BAR; PG8_WAIT_L(0); PG8_MMA(0, 0, At, B0); PG8_BAR; PG8_SCHED;
            PG8_LDB(B1, 0, 1); PG8_STAGE(PG8_SB(0, 0), b2, voffB);
            PG8_BAR; PG8_WAIT_L(0); PG8_MMA(0, 1, At, B1); PG8_BAR;
            PG8_LDA(At, 0, 1); PG8_STAGE(PG8_SA(0, 0), a2, voffA);
            PG8_BAR; PG8_WAIT_L(0); PG8_MMA(1, 0, At, B0); PG8_BAR; PG8_SCHED;
            PG8_STAGE(PG8_SB(0, 1), b2 + hstepB, voffB);
            PG8_WAIT_V(6); PG8_BAR; PG8_MMA(1, 1, At, B1); PG8_BAR;
            PG8_LDB(B0, 1, 0); PG8_SCHED; PG8_LDA(At, 1, 0); PG8_STAGE(PG8_SA(0, 1), a2 + hstepA, voffA);
            PG8_WAIT_L(8); PG8_BAR; PG8_WAIT_L(0); PG8_MMA(0, 0, At, B0); PG8_BAR; PG8_SCHED;
            PG8_LDB(B1, 1, 1); PG8_STAGE(PG8_SB(1, 0), b3, voffB);
            PG8_BAR; PG8_WAIT_L(0); PG8_MMA(0, 1, At, B1); PG8_BAR;
            PG8_LDA(At, 1, 1); PG8_STAGE(PG8_SA(1, 0), a3, voffA);
            PG8_BAR; PG8_WAIT_L(0); PG8_MMA(1, 0, At, B0); PG8_BAR; PG8_SCHED;
            PG8_STAGE(PG8_SB(1, 1), b3 + hstepB, voffB);
            PG8_WAIT_V(6); PG8_BAR; PG8_MMA(1, 1, At, B1); PG8_BAR;
            }
        }
        if constexpr (ALIGN_EPI) { if (wr == 0) PG8_BAR; }
        if constexpr (!Epi::AFTER_DRAIN) { const int le_ = mk_lane(); E(acc, cur, wr, wc, le_ & 15, le_ >> 4); S.done(cur); }
        if (!has_next) break;
        if constexpr (!(SP2 && MK_MMAZ))
#pragma unroll
        for (int a = 0; a < 2; ++a)
#pragma unroll
            for (int b = 0; b < 2; ++b)
#pragma unroll
                for (int m = 0; m < 4; ++m)
#pragma unroll
                    for (int n = 0; n < 2; ++n) acc[a][b][m][n] = (f32x4){0.f, 0.f, 0.f, 0.f};
        cur = nxt; cA = nA; cB = nB; ++ui;
        if constexpr (ALIGN_EPI) { if (wr == 1) PG8_BAR; }
    }
    PG8_WAIT_V(0);
    if constexpr (!ALIGN_EPI) { if (wr == 0) PG8_BAR; }
    PG8_BAR;
    if constexpr (Epi::AFTER_DRAIN) { E.fused(acc, cur, wr, wc, fr, fq, lds, wid, lane); S.done(cur); }
#undef PG8_SA
#undef PG8_SB
#undef PG8_STAGE
#undef PG8_LDA
#undef PG8_LDB
#undef PG8_MMA
#undef PG8_MMAZ
#undef PG8_WAIT_V
#undef PG8_WAIT_V8X
#undef PG8_WAIT_L
#undef PG8_BAR
#undef PG8_SCHED
}
}
#include <hip/hip_bf16.h>
#ifndef ATTN_OUT_FP8
#define ATTN_OUT_FP8 MK_FP8_WOUT
#endif
#include <cmath>
namespace attn_body {
using bf16=__hip_bfloat16;
using bf16x8=__attribute__((ext_vector_type(8)))short;
using s16x4=__attribute__((ext_vector_type(4)))short;
using f32x16=__attribute__((ext_vector_type(16)))float;
using u32x4=__attribute__((ext_vector_type(4)))unsigned;
constexpr int BATCH=32,NHEAD=8,SEQ=2048,D=64,DM=3584,OP=1024;
constexpr int NW=8,QBLK=32,QB=QBLK*NW,KVBLK=64,NQB=SEQ/QB;
constexpr int ATTN_PITCH=DM, ATTN_UNIT_ROWS=QB;
__device__ __forceinline__ int crow(int r,int hi){return (r&3)+8*(r>>2)+4*hi;}
#define SBAR() __builtin_amdgcn_sched_barrier(0)
__device__ __forceinline__ void cmask(f32x16&p0,f32x16&p1,int jb,int qrel,int hi){
  const float NEG=-INFINITY; int kb=64*jb+4*hi;
  #pragma unroll
  for(int r=0;r<16;++r){int kv=kb+(r&3)+8*(r>>2); if(kv>qrel)p0[r]=NEG; if(kv+32>qrel)p1[r]=NEG;}
}

constexpr int NSLOT=3, SLOTB=8192;
constexpr int LDS_K=0, LDS_V=NSLOT*SLOTB, LDS_WS=2*NSLOT*SLOTB, LDS_OST=LDS_WS+NW*64*4, LDS_BYTES=LDS_OST+NW*4096;
constexpr float C2=0.125f*1.4426950408889634f;
__device__ __forceinline__ void glds16(const void*gsrc,unsigned lds_dst){unsigned keep;
  asm volatile("s_mov_b32 %0, m0\n\ts_mov_b32 m0, %2\n\ts_nop 0\n\tglobal_load_lds_dwordx4 %1, off\n\ts_mov_b32 m0, %0":"=&s"(keep):"v"(gsrc),"s"(lds_dst):"memory");}
__device__ __forceinline__ float max3f(float a,float b,float c){float r;asm("v_max3_f32 %0, %1, %2, %3":"=v"(r):"v"(a),"v"(b),"v"(c));return r;}
__device__ __forceinline__ float max2f(float a,float b){float r;asm("v_max_f32_e32 %0, %1, %2":"=v"(r):"v"(a),"v"(b));return r;}
__device__ __forceinline__ float fadd_s(float a,float b){float r;asm("v_add_f32_e32 %0, %1, %2":"=v"(r):"v"(a),"v"(b));return r;}
__device__ __forceinline__ float fsub_s(float a,float b){float r;asm("v_sub_f32_e32 %0, %1, %2":"=v"(r):"v"(a),"v"(b));return r;}
typedef float f32x2_t __attribute__((ext_vector_type(2))); typedef __bf16 bf16x2_t __attribute__((ext_vector_type(2)));
__device__ __forceinline__ unsigned cvtpk_s(float lo,float hi){f32x2_t v={lo,hi};bf16x2_t b=__builtin_convertvector(v,bf16x2_t);return __builtin_bit_cast(unsigned,b);}
#define WAIT_BAR(N) asm volatile("s_waitcnt vmcnt(" #N ") lgkmcnt(0)\n\ts_barrier":::"memory")

__device__ __forceinline__ void qkt(f32x16&p0,f32x16&p1,const char*Kslot,const bf16x8*qr,const f32x16&negm,int r32,int hi){
  const char*kb=Kslot+hi*1024+r32*16;
  #pragma unroll
  for(int d0=0;d0<4;++d0){
    const bf16x8 b0=*reinterpret_cast<const bf16x8*>(kb+d0*2048);
    const bf16x8 b1=*reinterpret_cast<const bf16x8*>(kb+d0*2048+512);
    if(d0==0){p0=__builtin_amdgcn_mfma_f32_32x32x16_bf16(b0,qr[0],negm,0,0,0);p1=__builtin_amdgcn_mfma_f32_32x32x16_bf16(b1,qr[0],negm,0,0,0);}
    else{p0=__builtin_amdgcn_mfma_f32_32x32x16_bf16(b0,qr[d0],p0,0,0,0);p1=__builtin_amdgcn_mfma_f32_32x32x16_bf16(b1,qr[d0],p1,0,0,0);}}
}
typedef __attribute__((address_space(3))) const char* lds_cptr;
typedef short v4i16_t __attribute__((ext_vector_type(4)));
__device__ __forceinline__ void kload8(bf16x8*kf,lds_cptr kp){
  kf[0]=*(const __attribute__((address_space(3))) bf16x8*)(kp);      kf[1]=*(const __attribute__((address_space(3))) bf16x8*)(kp+512);
  kf[2]=*(const __attribute__((address_space(3))) bf16x8*)(kp+2048); kf[3]=*(const __attribute__((address_space(3))) bf16x8*)(kp+2560);
  kf[4]=*(const __attribute__((address_space(3))) bf16x8*)(kp+4096); kf[5]=*(const __attribute__((address_space(3))) bf16x8*)(kp+4608);
  kf[6]=*(const __attribute__((address_space(3))) bf16x8*)(kp+6144); kf[7]=*(const __attribute__((address_space(3))) bf16x8*)(kp+6656);
}
__device__ __forceinline__ void kload2(bf16x8*kf,lds_cptr kp,int j){ kf[2*j]=*(const __attribute__((address_space(3))) bf16x8*)(kp+j*2048); kf[2*j+1]=*(const __attribute__((address_space(3))) bf16x8*)(kp+j*2048+512); }
__device__ __forceinline__ s16x4 vtr(lds_cptr p){ return __builtin_bit_cast(s16x4,__builtin_amdgcn_ds_read_tr16_b64_v4i16((__attribute__((address_space(3))) v4i16_t*)p)); }
__device__ __forceinline__ float rowmax(const f32x16&p0,const f32x16&p1){
  float a=max3f(p0[0],p0[1],p1[0]),b=max3f(p0[2],p0[3],p1[1]);a=max3f(a,p1[2],p1[3]);
  #pragma unroll
  for(int r=4;r<16;r+=4){a=max3f(a,p0[r],p0[r+1]);b=max3f(b,p0[r+2],p0[r+3]);a=max3f(a,p1[r],p1[r+1]);b=max3f(b,p1[r+2],p1[r+3]);}
  const float m=max2f(a,b);
  auto rr=__builtin_amdgcn_permlane32_swap(__float_as_uint(m),__float_as_uint(m),false,false);
  return max2f(__uint_as_float(rr[0]),__uint_as_float(rr[1]));
}
__device__ __forceinline__ void pv(f32x16*o,int vb,bf16x8 pa0,bf16x8 pa1,bf16x8 pa2,bf16x8 pa3){
  #pragma unroll
  for(int d0=0;d0<2;++d0){s16x4 lo[4],hi[4];
    #pragma unroll
    for(int ks=0;ks<4;++ks){
      asm volatile("ds_read_b64_tr_b16 %0,%1 offset:%c2":"=&v"(lo[ks]):"v"(vb),"i"(d0*4096+ks*1024):"memory");
      asm volatile("ds_read_b64_tr_b16 %0,%1 offset:%c2":"=&v"(hi[ks]):"v"(vb),"i"(d0*4096+ks*1024+512):"memory");}
    asm volatile("s_waitcnt lgkmcnt(0)":::"memory");SBAR();
    #define PK(k) (bf16x8){lo[k][0],lo[k][1],lo[k][2],lo[k][3],hi[k][0],hi[k][1],hi[k][2],hi[k][3]}
    o[d0]=__builtin_amdgcn_mfma_f32_32x32x16_bf16(pa0,PK(0),o[d0],0,0,0);
    o[d0]=__builtin_amdgcn_mfma_f32_32x32x16_bf16(pa1,PK(1),o[d0],0,0,0);
    o[d0]=__builtin_amdgcn_mfma_f32_32x32x16_bf16(pa2,PK(2),o[d0],0,0,0);
    o[d0]=__builtin_amdgcn_mfma_f32_32x32x16_bf16(pa3,PK(3),o[d0],0,0,0);
    #undef PK
  }
}

#ifndef ATTN_STORE16
#define ATTN_STORE16(p,v) (*(__attribute__((address_space(1))) u32x4*)(p)=(v))
#endif
template<int THRL> __device__ __forceinline__ void attn_unit(int b,int h,int qb,const bf16*Q,const bf16*K,const bf16*V,bf16*O,const float*kmean,const float*beta,char*shm,const int wv){
  int tid_o=wv*64+mk_lane(); asm volatile("":"+v"(tid_o));
  const int tid=tid_o,lane=tid&63,r32=lane&31,hi=lane>>5; const int wid=__builtin_amdgcn_readfirstlane(tid>>6);
  const long rowbase=(long)b*SEQ; const int q0=qb*QB;
  const int hoff=(h>>2)*256+(h&3)*64;
  const bf16*Qw=Q+(rowbase+q0+wid*QBLK)*DM+hoff;
  const bf16*Kh=K+rowbase*DM+hoff,*Vh=V+rowbase*DM+h*D;
  const unsigned lds0=(unsigned)(uintptr_t)shm;
  float*wsf=(float*)(shm+LDS_WS)+wid*64;
  const bf16*ksrc=Kh+(long)lane*DM+wid*8;
  const bf16*vsrc=Vh+(long)(16*(wid&3)+(lane>>2))*DM+(wid>>2)*32+(lane&3)*8;
  const unsigned kdst=lds0+LDS_K+wid*1024, vdst=lds0+LDS_V+wid*1024;
  #define DMA_K(t,slot) glds16(ksrc+(long)(t)*KVBLK*DM,(unsigned)__builtin_amdgcn_readfirstlane(kdst+(slot)))
  #define DMA_V(t,slot) glds16(vsrc+(long)(t)*KVBLK*DM,(unsigned)__builtin_amdgcn_readfirstlane(vdst+(slot)))
  const int vb0=(int)(lds0+LDS_V)+((lane>>4)&1)*32+(lane&3)*8+(4*hi+((lane&15)>>2))*64;
  const char*Kbase=shm+LDS_K; bf16x8 kf[8];
  const lds_cptr shm3=(lds_cptr)shm; const lds_cptr kp0=shm3+LDS_K+hi*1024+r32*16; const lds_cptr vp0=shm3+LDS_V+((lane>>4)&1)*32+(lane&3)*8+(4*hi+((lane&15)>>2))*64;
  const int NT=(q0+QB)/KVBLK;
  DMA_K(0,0);DMA_V(0,0);DMA_K(1,SLOTB);
  bf16x8 qr[4];
  #pragma unroll
  for(int d0=0;d0<4;++d0)qr[d0]=*reinterpret_cast<const bf16x8*>(&Qw[(long)r32*DM+d0*16+hi*8]);
  unsigned selbits=(2u<<qb)-1u;
  if(qb>3){
    float g[7];
    #pragma unroll
    for(int n=0;n<7;++n){ g[n]=-INFINITY;
      if(n<qb){ const float*km=kmean+((long)(b*NHEAD+h)*8+n)*64+hi*8; float a=0.f;
        #pragma unroll
        for(int d0=0;d0<4;++d0){ const float4 k0=*reinterpret_cast<const float4*>(km+d0*16),k1=*reinterpret_cast<const float4*>(km+d0*16+4); const bf16x8 qq=qr[d0];
          a+=__uint_as_float((unsigned)(unsigned short)qq[0]<<16)*k0.x+__uint_as_float((unsigned)(unsigned short)qq[1]<<16)*k0.y+__uint_as_float((unsigned)(unsigned short)qq[2]<<16)*k0.z+__uint_as_float((unsigned)(unsigned short)qq[3]<<16)*k0.w
            +__uint_as_float((unsigned)(unsigned short)qq[4]<<16)*k1.x+__uint_as_float((unsigned)(unsigned short)qq[5]<<16)*k1.y+__uint_as_float((unsigned)(unsigned short)qq[6]<<16)*k1.z+__uint_as_float((unsigned)(unsigned short)qq[7]<<16)*k1.w; }
        a+=__shfl_xor(a,32); g[n]=a; } }
    selbits=1u<<qb;
    #pragma unroll
    for(int n=0;n<7;++n){ int rank=0;
      #pragma unroll
      for(int m2=0;m2<7;++m2) if(m2!=n) rank+=((g[m2]>g[n])||(g[m2]==g[n]&&m2<n))?1:0;
      if(n<qb&&rank<3) selbits|=1u<<n; }
  }
  #define MWORD(t) ((unsigned)(((int)(selbits<<(31-((t)>>2))))>>31))
  float mhat=0.f,l_reg=0.f;f32x16 o[2];f32x16 negm; { float zf; asm volatile("v_mov_b32 %0, 0":"=v"(zf));
    _Pragma("unroll") for(int r=0;r<16;++r){o[0][r]=zf;o[1][r]=zf;negm[r]=zf;} } asm volatile("":"+v"(negm));
  const int qrel=wid*QBLK+r32;
  #define CMASK(P0,P1,t) do{int jb_=(t)-(NT-4); if(jb_>=0)cmask(P0,P1,jb_,qrel,hi);}while(0)
  bool resc=false;
  #define START(P0,P1) do{ const float rm=(selbits&1u)?rowmax(P0,P1):0.f; resc=false; \
    { const float dl=rm; mhat=fadd_s(mhat,dl); \
      _Pragma("unroll") for(int r=0;r<16;++r){P0[r]=fsub_s(P0[r],dl);P1[r]=fsub_s(P1[r],dl);} \
      _Pragma("unroll") for(int r=0;r<16;++r)negm[r]=-mhat; asm volatile("":"+v"(negm)); } \
    _Pragma("unroll") for(int r=0;r<16;++r)P0[r]=__builtin_amdgcn_exp2f(P0[r]); }while(0)
  #define RESC() do{ if(resc){ asm volatile("s_waitcnt lgkmcnt(0)":::"memory"); \
      _Pragma("unroll") for(int d_=0;d_<2;++d_) _Pragma("unroll") for(int r=0;r<16;++r)o[d_][r]*=wsf[crow(r,hi)]; } }while(0)
  f32x16 pA0,pA1,pB0,pB1;
  int sl_prev=0,sl_cur=0,sl_next=SLOTB;
  #define ROT() do{sl_prev=sl_cur;sl_cur=sl_next;sl_next=(sl_next==(NSLOT-1)*SLOTB)?0:sl_next+SLOTB;}while(0)
  DMA_K(2,2*SLOTB);
  WAIT_BAR(3);
  qkt(pA0,pA1,Kbase,qr,negm,r32,hi);asm volatile("s_nop 15\n\ts_nop 7":"+v"(pA0),"+v"(pA1));CMASK(pA0,pA1,0);
  START(pA0,pA1);
  _Pragma("unroll") for(int r=0;r<16;++r)pA1[r]=__builtin_amdgcn_exp2f(pA1[r]);
  WAIT_BAR(0);
  DMA_K(3,0);DMA_V(1,SLOTB);
  ROT();
  kload8(kf,kp0+sl_cur);
  WAIT_BAR(2);
  s16x4 vlo[8],vhi[8]; u32x4 pw0,pw1,pw2,pw3;
  #define PKW(P,B) (cvtpk_s(P[B],P[B+1])&mwp_)
  #define PAF(k) __builtin_bit_cast(bf16x8,pw##k)
  #define VFR(i) (bf16x8){vlo[i][0],vlo[i][1],vlo[i][2],vlo[i][3],vhi[i][0],vhi[i][1],vhi[i][2],vhi[i][3]}
  #define PIN(x) asm volatile("":"+v"(x))
  #define MX3(a,b,c) __builtin_fmaxf(__builtin_fmaxf((a),(b)),(c))
  #define GAPA(MF,A0,A1,A2,A3,W0,W1,PW) do{ MF; sacc+=A0; sacc+=A1; sacc+=A2; sacc+=A3; PIN(sacc); W0; W1; PIN(PW); SBAR(); }while(0)
  #define EX(v) __builtin_amdgcn_exp2f(v)
  #define GAPB(MF,X,B) do{ MF; X[B]=EX(X[B]); X[B+1]=EX(X[B+1]); X[B+2]=EX(X[B+2]); X[B+3]=EX(X[B+3]); PIN(X); SBAR(); }while(0)
  #define VRD(i) do{ vlo[i]=vtr(vp_+(((i)>>2)*4096+((i)&3)*1024)); vhi[i]=vtr(vp_+(((i)>>2)*4096+((i)&3)*1024+512)); }while(0)
  #define KRD(G,j) do{ if(G){ kload2(kf,kp0+sl_next,j); SBAR(); } }while(0)
  #define STEP(C0,C1,P0,P1,t,GK,GV,GL) do{ SBAR(); \
    const unsigned mwp_=MWORD((t)-1), mwc_=MWORD(t); \
    const lds_cptr vp_=vp0+sl_prev; \
    VRD(0); SBAR(); float sacc=(P0[0]+P0[1]); \
    GAPA(C0=__builtin_amdgcn_mfma_f32_32x32x16_bf16(kf[0],qr[0],negm,0,0,0), P0[2],P0[3],P0[4],P0[5],     pw0[0]=PKW(P0,0), pw0[1]=PKW(P0,2), pw0); \
    VRD(4); SBAR(); GAPA(C1=__builtin_amdgcn_mfma_f32_32x32x16_bf16(kf[1],qr[0],negm,0,0,0), P0[6],P0[7],P0[8],P0[9],     pw0[2]=PKW(P0,4), pw0[3]=PKW(P0,6), pw0); \
    VRD(1); SBAR(); GAPA(C0=__builtin_amdgcn_mfma_f32_32x32x16_bf16(kf[2],qr[1],C0,0,0,0),   P0[10],P0[11],P0[12],P0[13], pw1[0]=PKW(P0,8), pw1[1]=PKW(P0,10), pw1); \
    VRD(5); SBAR(); GAPA(C1=__builtin_amdgcn_mfma_f32_32x32x16_bf16(kf[3],qr[1],C1,0,0,0),   P0[14],P0[15],P1[0],P1[1],   pw1[2]=PKW(P0,12),pw1[3]=PKW(P0,14), pw1); \
    VRD(2); SBAR(); GAPA(C0=__builtin_amdgcn_mfma_f32_32x32x16_bf16(kf[4],qr[2],C0,0,0,0),   P1[2],P1[3],P1[4],P1[5],     pw2[0]=PKW(P1,0), pw2[1]=PKW(P1,2), pw2); \
    VRD(6); SBAR(); GAPA(C1=__builtin_amdgcn_mfma_f32_32x32x16_bf16(kf[5],qr[2],C1,0,0,0),   P1[6],P1[7],P1[8],P1[9],     pw2[2]=PKW(P1,4), pw2[3]=PKW(P1,6), pw2); \
    VRD(3); SBAR(); GAPA(C0=__builtin_amdgcn_mfma_f32_32x32x16_bf16(kf[6],qr[3],C0,0,0,0),   P1[10],P1[11],P1[12],P1[13], pw3[0]=PKW(P1,8), pw3[1]=PKW(P1,10), pw3); \
    VRD(7); SBAR(); GAPA(C1=__builtin_amdgcn_mfma_f32_32x32x16_bf16(kf[7],qr[3],C1,0,0,0),   P1[14],P1[15],0.f,0.f,       pw3[2]=PKW(P1,12),pw3[3]=PKW(P1,14), pw3); \
    l_reg+=(mwp_?sacc:0.f); \
    if(GK){DMA_K((t)+3,sl_cur);} if(GV){DMA_V((t)+1,sl_next);} \
    CMASK(C0,C1,t); \
    { float a=MX3(C0[0],C0[1],C1[0]),b=MX3(C0[2],C0[3],C1[1]); a=MX3(a,C1[2],C1[3]); \
      _Pragma("unroll") for(int r=4;r<16;r+=4){a=MX3(a,C0[r],C0[r+1]);b=MX3(b,C0[r+2],C0[r+3]);a=MX3(a,C1[r],C1[r+1]);b=MX3(b,C1[r+2],C1[r+3]);} \
      float rm=__builtin_fmaxf(a,b); { auto rr=__builtin_amdgcn_permlane32_swap(__float_as_uint(rm),__float_as_uint(rm),false,false); rm=__builtin_fmaxf(__uint_as_float(rr[0]),__uint_as_float(rr[1])); } \
      rm=mwc_?rm:-INFINITY; resc=false; \
      if(__builtin_expect(__any(rm>(float)THRL),0)){ const float dl=__builtin_fmaxf(rm,0.f); mhat+=dl; \
        _Pragma("unroll") for(int r=0;r<16;++r){C0[r]-=dl;C1[r]-=dl;} \
        _Pragma("unroll") for(int r=0;r<16;++r)negm[r]=-mhat; asm volatile("":"+v"(negm)); \
        const float f=__builtin_amdgcn_exp2f(-dl); l_reg*=f; if(hi==0)wsf[r32]=f; resc=true; } } \
    SBAR(); \
    GAPB(o[0]=__builtin_amdgcn_mfma_f32_32x32x16_bf16(PAF(0),VFR(0),o[0],0,0,0), C0,0); \
    GAPB(o[1]=__builtin_amdgcn_mfma_f32_32x32x16_bf16(PAF(0),VFR(4),o[1],0,0,0), C0,4); \
    KRD(GL,0); GAPB(o[0]=__builtin_amdgcn_mfma_f32_32x32x16_bf16(PAF(1),VFR(1),o[0],0,0,0), C0,8); \
    KRD(GL,1); GAPB(o[1]=__builtin_amdgcn_mfma_f32_32x32x16_bf16(PAF(1),VFR(5),o[1],0,0,0), C0,12); \
    KRD(GL,2); GAPB(o[0]=__builtin_amdgcn_mfma_f32_32x32x16_bf16(PAF(2),VFR(2),o[0],0,0,0), C1,0); \
    KRD(GL,3); GAPB(o[1]=__builtin_amdgcn_mfma_f32_32x32x16_bf16(PAF(2),VFR(6),o[1],0,0,0), C1,4); \
    GAPB(o[0]=__builtin_amdgcn_mfma_f32_32x32x16_bf16(PAF(3),VFR(3),o[0],0,0,0), C1,8); \
    GAPB(o[1]=__builtin_amdgcn_mfma_f32_32x32x16_bf16(PAF(3),VFR(7),o[1],0,0,0), C1,12); \
    }while(0)
  int t=1;
  #undef CMASK
  #define CMASK(P0,P1,t) do{}while(0)
  for(;t+5<NT;t+=2){
    STEP(pB0,pB1,pA0,pA1,t,true,true,true);     WAIT_BAR(2); RESC(); ROT();
    STEP(pA0,pA1,pB0,pB1,t+1,true,true,true);   WAIT_BAR(2); RESC(); ROT();
  }
  #undef CMASK
  #define CMASK(P0,P1,t) do{int jb_=(t)-(NT-4); if(jb_>=0)cmask(P0,P1,jb_,qrel,hi);}while(0)
  #define ENDW(tt) do{ if((tt)+3<NT){WAIT_BAR(2);} else if((tt)+2<NT){WAIT_BAR(1);} else {WAIT_BAR(0);} }while(0)
  for(;t+1<NT;t+=2){
    STEP(pB0,pB1,pA0,pA1,t,(t+3<NT),(t+1<NT),(t+1<NT));       ENDW(t);   RESC(); ROT();
    STEP(pA0,pA1,pB0,pB1,t+1,(t+4<NT),(t+2<NT),(t+2<NT));     ENDW(t+1); RESC(); ROT();
  }
  STEP(pB0,pB1,pA0,pA1,NT-1,false,false,false); RESC();
  { const unsigned mwp_=0xffffffffu; float sacc=pB0[0]+pB0[1]; _Pragma("unroll") for(int r=2;r<16;++r)sacc+=pB0[r]; _Pragma("unroll") for(int r=0;r<16;++r)sacc+=pB1[r]; l_reg+=sacc;
    pw0=(u32x4){PKW(pB0,0),PKW(pB0,2),PKW(pB0,4),PKW(pB0,6)};pw1=(u32x4){PKW(pB0,8),PKW(pB0,10),PKW(pB0,12),PKW(pB0,14)};pw2=(u32x4){PKW(pB1,0),PKW(pB1,2),PKW(pB1,4),PKW(pB1,6)};pw3=(u32x4){PKW(pB1,8),PKW(pB1,10),PKW(pB1,12),PKW(pB1,14)};
    SBAR(); pv(o,vb0+sl_cur,PAF(0),PAF(1),PAF(2),PAF(3)); }
  #undef PKW
  #undef PAF
  #undef VFR
  #undef PIN
  #undef MX3
  #undef GAPA
  #undef GAPB
  #undef EX
  #undef VRD
  #undef KRD
  #undef STEP
  #undef ENDW
  {auto rr=__builtin_amdgcn_permlane32_swap(__float_as_uint(l_reg),__float_as_uint(l_reg),false,false);l_reg=__uint_as_float(rr[0])+__uint_as_float(rr[1]);}
  if(hi==0)wsf[32+r32]=l_reg;asm volatile("s_waitcnt lgkmcnt(0)":::"memory");
  float rli[16];
  #pragma unroll
  for(int r=0;r<16;++r)rli[r]=__builtin_amdgcn_rcpf(wsf[32+crow(r,hi)]);
  bf16*Ow=O+(rowbase+q0+wid*QBLK)*OP+h*D;
  typedef float f4g_ __attribute__((ext_vector_type(4)));
  const f4g_ bg0=*(const __attribute__((address_space(1))) f4g_*)(beta+h*D+(lane&7)*8), bg1=*(const __attribute__((address_space(1))) f4g_*)(beta+h*D+(lane&7)*8+4);
  { bf16*stg=(bf16*)(shm+LDS_OST)+wid*2048;
    #pragma unroll
    for(int r=0;r<16;++r){const int orow=crow(r,hi);
      #pragma unroll
      for(int d0=0;d0<2;++d0)stg[orow*64+d0*32+r32]=__float2bfloat16(o[d0][r]*rli[r]);}
    asm volatile("s_waitcnt lgkmcnt(0)":::"memory");
    int lane_e=lane; asm volatile("":"+v"(lane_e));
    #pragma unroll
    for(int i=0;i<4;++i){const int row=i*8+(lane_e>>3),ch=lane_e&7; const u32x4 v=*(const u32x4*)(stg+row*64+ch*8);
      float f[8]; f[0]=__uint_as_float(v.x<<16);f[1]=__uint_as_float(v.x&0xffff0000u);f[2]=__uint_as_float(v.y<<16);f[3]=__uint_as_float(v.y&0xffff0000u);f[4]=__uint_as_float(v.z<<16);f[5]=__uint_as_float(v.z&0xffff0000u);f[6]=__uint_as_float(v.w<<16);f[7]=__uint_as_float(v.w&0xffff0000u);
      float sq=((f[0]*f[0]+f[1]*f[1])+(f[2]*f[2]+f[3]*f[3]))+((f[4]*f[4]+f[5]*f[5])+(f[6]*f[6]+f[7]*f[7]));
      sq+=__shfl_xor(sq,1);sq+=__shfl_xor(sq,2);sq+=__shfl_xor(sq,4);
      const float rn=1.0f/sqrtf(sq*(1.0f/64.0f)+1e-6f);
      const float4 b0=make_float4(bg0[0],bg0[1],bg0[2],bg0[3]),b1=make_float4(bg1[0],bg1[1],bg1[2],bg1[3]);
#if ATTN_OUT_FP8
      { typedef unsigned u32x2_t __attribute__((ext_vector_type(2))); u32x2_t w8; w8.x=pg8::pk4_fp8(f[0]*rn*b0.x,f[1]*rn*b0.y,f[2]*rn*b0.z,f[3]*rn*b0.w); w8.y=pg8::pk4_fp8(f[4]*rn*b1.x,f[5]*rn*b1.y,f[6]*rn*b1.z,f[7]*rn*b1.w);
        MIX_STNT(w8,(__attribute__((address_space(1))) u32x2_t*)((unsigned char*)O+((rowbase+q0+wid*QBLK+row)*OP+h*D+ch*8))); }
#else
      u32x4 w; w.x=cvtpk_s(f[0]*rn*b0.x,f[1]*rn*b0.y);w.y=cvtpk_s(f[2]*rn*b0.z,f[3]*rn*b0.w);w.z=cvtpk_s(f[4]*rn*b1.x,f[5]*rn*b1.y);w.w=cvtpk_s(f[6]*rn*b1.z,f[7]*rn*b1.w);
      ATTN_STORE16(Ow+(long)row*OP+ch*8,w);
#endif
      } }
  asm volatile("s_waitcnt lgkmcnt(0)\n\ts_barrier":::"memory");
  #undef MWORD
  #undef DMA_K
  #undef DMA_V
  #undef CMASK
  #undef START
  #undef RESC
  #undef ROT
}
constexpr int ATTN_LDS_BYTES=LDS_BYTES;
struct AttnTensors { const bf16* Q; const bf16* K; const bf16* V; bf16* O; const float* kmean; const float* beta; };
struct AttnUnit { int bh; int qb; };
struct StaticOrder {
  int vcu,G;
  __device__ __forceinline__ explicit StaticOrder(int grid,int vcu_):vcu(vcu_),G(grid){}
  __device__ __forceinline__ bool next(int i,AttnUnit&u)const{
    if(G==256){ const int p=vcu>>1;
#ifndef MK_DEAL
#define MK_DEAL 22
#endif
#if MK_DEAL == 23
      if(vcu&1){ if(i>=12)return false; if(i<8){u.bh=2*p;u.qb=7-i;} else {u.bh=2*p+1; const int k=i-8; u.qb=(k==0)?5:(k==1)?3:(k==2)?1:0;} }
      else { if(i>=4)return false; u.bh=2*p+1; u.qb=(i==0)?7:(i==1)?6:(i==2)?4:2; }
#elif MK_DEAL == 24
      if(vcu&1){ if(i>=12)return false; if(i<8){u.bh=2*p;u.qb=7-i;} else {u.bh=2*p+1; const int k=i-8; u.qb=(k==0)?4:(k==1)?3:(k==2)?1:0;} }
      else { if(i>=4)return false; u.bh=2*p+1; u.qb=(i==0)?7:(i==1)?6:(i==2)?5:2; }
#elif MK_DEAL == 21
      if(vcu&1){ if(i>=12)return false; if(i<8){u.bh=2*p;u.qb=7-i;} else {u.bh=2*p+1; const int k=i-8; u.qb=(k==0)?5:(k==1)?3:(k==2)?2:1;} }
      else { if(i>=4)return false; u.bh=2*p+1; u.qb=(i==0)?7:(i==1)?6:(i==2)?4:0; }
#else
      if(vcu&1){ if(i>=12)return false; if(i<8){u.bh=2*p;u.qb=7-i;} else {u.bh=2*p+1; const int k=i-8; u.qb=(k==0)?5:(k==1)?3:(k==2)?2:0;} }
      else { if(i>=4)return false; u.bh=2*p+1; u.qb=(i==0)?7:(i==1)?6:(i==2)?4:1; }
#endif
      return true; }
    const int bh=vcu+(i>>3)*G; if(bh>=BATCH*NHEAD)return false; u.bh=bh; u.qb=7-(i&7); return true; }
  __device__ __forceinline__ void a_ready(const AttnUnit&)const{}
  __device__ __forceinline__ void done(const AttnUnit&)const{}
};
template<class Sched,int THRL=8> __device__ __forceinline__ void attn_phase(char*lds,const AttnTensors&T,const Sched&S,const int wv){
  AttnUnit u;
  for(int i=0;S.next(i,u);++i){ S.a_ready(u); attn_unit<THRL>(u.bh/NHEAD,u.bh%NHEAD,u.qb,T.Q,T.K,T.V,T.O,T.kmean,T.beta,lds,wv); S.done(u); }
}
#undef SBAR
#undef WAIT_BAR
}
#ifndef RET_OUT_FP8
#define RET_OUT_FP8 MK_FP8_WOUT
#define RGAS __attribute__((address_space(1)))
#ifndef MK_NT_RET
#define MK_NT_RET 0
#endif
#if MK_NT_RET
#define RET_LDNT(p) __builtin_nontemporal_load(p)
#else
#define RET_LDNT(p) (*(p))
#endif
#endif
namespace ret_body {
typedef short bf16x8 __attribute__((ext_vector_type(8)));
typedef short s16x4 __attribute__((ext_vector_type(4)));
typedef float f32x16 __attribute__((ext_vector_type(16)));
typedef unsigned u32x4 __attribute__((ext_vector_type(4)));
typedef unsigned u32x2 __attribute__((ext_vector_type(2)));
typedef float f32x4r __attribute__((ext_vector_type(4)));
#define RLAS __attribute__((address_space(3)))
constexpr int SEQ = 2048, INW = 3584, OP = 1024, PC_RQ = 0, PC_RK = 512, PC_RV = 1024, PC_RG = 1536;
constexpr int R0 = 0, R1 = 32768, R2 = 65536, R3 = 98304, RBETA = 131072 + 1024, RDEC = RBETA + 512, RET_LDS_END = RDEC + 512;
__device__ __forceinline__ int sw_off(int row, int ch) { return 256 * row + 16 * (ch ^ (((row & 3) << 2) | ((row >> 2) & 3))); }
__device__ __forceinline__ bf16x8 ld_row(const RLAS unsigned char* base, int row, int ch) { return *(const RLAS bf16x8*)(base + sw_off(row, ch)); }
__device__ __forceinline__ s16x4 tr4(const RLAS unsigned char* p) { typedef short v4i16_t __attribute__((ext_vector_type(4))); return __builtin_bit_cast(s16x4, __builtin_amdgcn_ds_read_tr16_b64_v4i16((RLAS v4i16_t*)p)); }
__device__ __forceinline__ bf16x8 ld_tr(const RLAS unsigned char* base, int k0, int c0ch, int lane) {
    const int g = lane >> 4, i = lane & 15, q = i >> 2, p = i & 3;
    const int row = k0 + 8 * (g >> 1) + q, ch = c0ch + 2 * (g & 1) + (p >> 1);
    const s16x4 lo = tr4(base + sw_off(row, ch) + 8 * (p & 1)), hi = tr4(base + sw_off(row + 4, ch) + 8 * (p & 1));
    return (bf16x8){lo[0], lo[1], lo[2], lo[3], hi[0], hi[1], hi[2], hi[3]};
}
__device__ __forceinline__ unsigned cvtpk(float lo, float hi) { typedef float f32x2_t __attribute__((ext_vector_type(2))); typedef __bf16 bf16x2_t __attribute__((ext_vector_type(2)));
    f32x2_t v = {lo, hi}; bf16x2_t b = __builtin_convertvector(v, bf16x2_t); return __builtin_bit_cast(unsigned, b); }
__device__ __forceinline__ float bflo(unsigned u) { return __uint_as_float(u << 16); }
__device__ __forceinline__ float bfhi(unsigned u) { return __uint_as_float(u & 0xffff0000u); }
#define RMFMA(a, b, c) __builtin_amdgcn_mfma_f32_32x32x16_bf16(a, b, c, 0, 0, 0)
#define OPQ1(a) asm volatile("" : "+v"(a))
#define OPQ2(a, b) asm volatile("" : "+v"(a), "+v"(b))

__device__ __forceinline__ void ret_unit(const unsigned short* PROJ, unsigned short* MIX, const float* beta_g, int b, int h, RLAS unsigned char* lds, const int w  ) {
#define LANE_IDX() const int lane = mk_lane(), tid = w * 64 + lane, l31 = lane & 31, hi = lane >> 5; (void)tid; (void)l31; (void)hi
    const int qi = w & 3, pb = w >> 2;
    const float gamma = 1.0f - exp2f(-5.0f - (float)h), lg = log2f(gamma);
    RLAS unsigned char* r0 = lds + R0; RLAS unsigned char* r1 = lds + R1; RLAS unsigned char* r2 = lds + R2; RLAS unsigned char* r3 = lds + R3;
    RLAS float* betas = (RLAS float*)(lds + RBETA); RLAS float* dtab = (RLAS float*)(lds + RDEC);
    { LANE_IDX(); for (int i = tid; i < 32768 / 16; i += 512) ((RLAS u32x4*)r3)[i] = (u32x4){0u, 0u, 0u, 0u};
      if (tid < 128) { betas[tid] = beta_g[h * 128 + tid]; dtab[tid] = __builtin_amdgcn_exp2f((float)tid * lg); } }
    f32x16 st[2];
#pragma unroll
    for (int j = 0; j < 2; ++j)
#pragma unroll
        for (int r = 0; r < 16; ++r) st[j][r] = 0.f;
    const float cd = exp2f(128.0f * lg);
    u32x4 gq[4], gk[4], gv[4];
#define RET_LOAD(cc) do { LANE_IDX(); const int lrow = tid >> 2, lcb = (tid & 3) * 4; const unsigned short* p = PROJ + ((size_t)b * SEQ + (cc) * 128 + lrow) * INW + h * 128 + lcb * 8; \
        const unsigned short* pqk = PROJ + ((size_t)b * SEQ + (cc) * 128 + lrow) * INW + (h >> 1) * 256 + (tid & 3) * 64 + (h & 1) * 32;     \
        _Pragma("unroll") for (int i = 0; i < 4; ++i) { gq[i] = RET_LDNT((const RGAS u32x4*)(pqk + PC_RQ + i * 8)); gk[i] = RET_LDNT((const RGAS u32x4*)(pqk + PC_RK + i * 8)); gv[i] = RET_LDNT((const RGAS u32x4*)(p + PC_RV + i * 8)); } } while (0)
    RET_LOAD(0);
#pragma unroll 1
    for (int c = 0; c < 16; ++c) {
        const size_t grow = (size_t)b * SEQ + c * 128;
        float lgc = lg; asm volatile("" : "+v"(lgc));
        {
            LANE_IDX(); const int lrow = tid >> 2, lcb = (tid & 3) * 4;
#pragma unroll
            for (int i = 0; i < 4; ++i) { *(RLAS u32x4*)(r0 + sw_off(lrow, lcb + i)) = gq[i]; *(RLAS u32x4*)(r1 + sw_off(lrow, lcb + i)) = gk[i]; *(RLAS u32x4*)(r2 + sw_off(lrow, lcb + i)) = gv[i]; }
        }
        __syncthreads();
        f32x16 ao[2], as[2];
        { LANE_IDX();
        float zf; asm volatile("v_mov_b32 %0, 0" : "=v"(zf));
#pragma unroll
        for (int j = 0; j < 2; ++j)
#pragma unroll
            for (int r = 0; r < 16; ++r) { ao[j][r] = zf; as[j][r] = zf; }
#pragma unroll 2
        for (int ks = 0; ks < 8; ++ks) {
            const bf16x8 bq = ld_row(r0, 32 * qi + l31, 2 * ks + hi);
#pragma unroll
            for (int j = 0; j < 2; ++j) { const bf16x8 a = ld_row(r3, 32 * (2 * pb + j) + l31, 2 * ks + hi); ao[j] = RMFMA(a, bq, ao[j]); }
#pragma unroll
            for (int j = 0; j < 2; ++j) if (2 * pb + j <= qi) { const bf16x8 a = ld_row(r1, 32 * (2 * pb + j) + l31, 2 * ks + hi); as[j] = RMFMA(a, bq, as[j]); }
        }
        const float qdec = __builtin_amdgcn_exp2f((float)(32 * qi + l31 + 1) * lgc);
#pragma unroll
        for (int j = 0; j < 2; ++j)
#pragma unroll
            for (int r = 0; r < 16; ++r) ao[j][r] *= qdec;
        }
        __syncthreads();
        { LANE_IDX();
#pragma unroll
        for (int j = 0; j < 2; ++j) if (2 * pb + j <= qi) {
            const int kb = 2 * pb + j, q = 32 * qi + l31;
#pragma unroll
            for (int g4 = 0; g4 < 4; ++g4) { float pv[4];
#pragma unroll
                for (int i = 0; i < 4; ++i) { const int key = 32 * kb + 8 * g4 + 4 * hi + i, diff = q - key; pv[i] = diff >= 0 ? as[j][4 * g4 + i] * dtab[diff >= 0 ? diff : 0] : 0.f; }
                u32x2 wv; wv.x = cvtpk(pv[0], pv[1]); wv.y = cvtpk(pv[2], pv[3]);
                *(RLAS u32x2*)(r0 + sw_off(q, 4 * kb + g4) + 8 * hi) = wv; }
        }
        }
        __syncthreads();
        if (c + 1 < 16) RET_LOAD(c + 1);
        u32x4 grg[4];
        { LANE_IDX(); const int lrow = tid >> 2, seg = tid & 3; const unsigned short* gp = PROJ + (grow + lrow) * INW + PC_RG + h * 128 + 32 * seg;
#pragma unroll
          for (int i = 0; i < 4; ++i) grg[i] = RET_LDNT((const RGAS u32x4*)(gp + 8 * i)); }
        { LANE_IDX();
#pragma unroll 2
        for (int ks = 0; ks < 8; ++ks) if (ks < 2 * qi + 2) {
            const bf16x8 bp = ld_row(r0, 32 * qi + l31, 2 * ks + hi);
#pragma unroll
            for (int j = 0; j < 2; ++j) { const bf16x8 a = ld_tr(r2, 16 * ks, 4 * (2 * pb + j), lane); ao[j] = RMFMA(a, bp, ao[j]); }
        }
#pragma unroll
        for (int j = 0; j < 2; ++j)
#pragma unroll
            for (int r = 0; r < 16; ++r) st[j][r] *= cd;
#pragma unroll 2
        for (int ks = 0; ks < 8; ++ks) {
            const bf16x8 ak = ld_tr(r1, 16 * ks, 4 * qi, lane);
            float kf[8];
            const f32x4r d0 = *(const RLAS f32x4r*)(dtab + 120 - 16 * ks - 8 * hi), d1 = *(const RLAS f32x4r*)(dtab + 124 - 16 * ks - 8 * hi);
            const float dk[8] = {d1[3], d1[2], d1[1], d1[0], d0[3], d0[2], d0[1], d0[0]};
#pragma unroll
            for (int i = 0; i < 8; ++i) kf[i] = __uint_as_float((unsigned)(unsigned short)ak[i] << 16) * dk[i];
            u32x4 aw; aw.x = cvtpk(kf[0], kf[1]); aw.y = cvtpk(kf[2], kf[3]); aw.z = cvtpk(kf[4], kf[5]); aw.w = cvtpk(kf[6], kf[7]);
            const bf16x8 a = __builtin_bit_cast(bf16x8, aw);
#pragma unroll
            for (int j = 0; j < 2; ++j) { const bf16x8 bv = ld_tr(r2, 16 * ks, 4 * (2 * pb + j), lane); st[j] = RMFMA(a, bv, st[j]); }
        }
        }
        __syncthreads();
        { LANE_IDX();
#pragma unroll
        for (int j = 0; j < 2; ++j) { const int eb = 2 * pb + j;
#pragma unroll
            for (int g4 = 0; g4 < 4; ++g4) {
                u32x2 wo; wo.x = cvtpk(ao[j][4 * g4 + 0], ao[j][4 * g4 + 1]); wo.y = cvtpk(ao[j][4 * g4 + 2], ao[j][4 * g4 + 3]);
                *(RLAS u32x2*)(r1 + sw_off(32 * qi + l31, 4 * eb + g4) + 8 * hi) = wo;
                u32x2 ws; ws.x = cvtpk(st[j][4 * g4 + 0], st[j][4 * g4 + 1]); ws.y = cvtpk(st[j][4 * g4 + 2], st[j][4 * g4 + 3]);
                *(RLAS u32x2*)(r3 + sw_off(32 * eb + l31, 4 * qi + g4) + 8 * hi) = ws; }
        }
        }
        __syncthreads();
        {
            LANE_IDX(); const int lrow = tid >> 2, seg = tid & 3; float o[32]; float sq = 0.f;
#pragma unroll
            for (int i = 0; i < 4; ++i) { const u32x4 v = *(const RLAS u32x4*)(r1 + sw_off(lrow, 4 * seg + i));
                o[8 * i + 0] = bflo(v.x); o[8 * i + 1] = bfhi(v.x); o[8 * i + 2] = bflo(v.y); o[8 * i + 3] = bfhi(v.y); o[8 * i + 4] = bflo(v.z); o[8 * i + 5] = bfhi(v.z); o[8 * i + 6] = bflo(v.w); o[8 * i + 7] = bfhi(v.w); }
#pragma unroll
            for (int i = 0; i < 32; ++i) sq += o[i] * o[i];
            sq += __shfl_xor(sq, 1); sq += __shfl_xor(sq, 2);
            const float rn = 1.0f / sqrtf(sq * (1.0f / 128.0f) + 1e-6f);
            unsigned short* op = MIX + (grow + lrow) * OP + h * 128 + 32 * seg;
#pragma unroll
            for (int i = 0; i < 4; ++i) { const u32x4 gr = grg[i];
                const float gg[8] = {bflo(gr.x), bfhi(gr.x), bflo(gr.y), bfhi(gr.y), bflo(gr.z), bfhi(gr.z), bflo(gr.w), bfhi(gr.w)};
                float y[8];
#pragma unroll
                for (int k = 0; k < 8; ++k) { const float g1 = gg[k]; const float sg = g1 * __builtin_amdgcn_rcpf(1.0f + __builtin_amdgcn_exp2f(-1.4426950408889634f * g1)); y[k] = o[8 * i + k] * rn * sg * betas[32 * seg + 8 * i + k]; }
#if RET_OUT_FP8
                { u32x2 w8; w8.x = pg8::pk4_fp8(y[0], y[1], y[2], y[3]); w8.y = pg8::pk4_fp8(y[4], y[5], y[6], y[7]);
                  MIX_STNT(w8, (__attribute__((address_space(1))) u32x2*)((unsigned char*)MIX + (grow + lrow) * OP + h * 128 + 32 * seg + 8 * i)); }
                if (i == 1) __builtin_amdgcn_sched_barrier(0); }
#else
                u32x4 wv; wv.x = cvtpk(y[0], y[1]); wv.y = cvtpk(y[2], y[3]); wv.z = cvtpk(y[4], y[5]); wv.w = cvtpk(y[6], y[7]);
                *(u32x4*)(op + 8 * i) = wv;
                if (i == 1) __builtin_amdgcn_sched_barrier(0); }
#endif
        }
        __syncthreads();
    }
}
#undef RET_LOAD
#undef LANE_IDX
#undef RMFMA
#undef OPQ1
#undef OPQ2
#undef RLAS
}
#define GAS __attribute__((address_space(1)))
#define LAS __attribute__((address_space(3)))
typedef unsigned short bf16;
typedef unsigned v4u __attribute__((ext_vector_type(4)));
typedef float f32x4 __attribute__((ext_vector_type(4)));
typedef short bf16x8 __attribute__((ext_vector_type(8)));
typedef GAS unsigned gu32;
typedef GAS unsigned long long gu64;
#define RLX_AGENT __ATOMIC_RELAXED, __HIP_MEMORY_SCOPE_AGENT
#define LDS_WAIT() asm volatile("s_waitcnt lgkmcnt(0)" ::: "memory")
#define VM_WAIT() asm volatile("s_waitcnt vmcnt(0)" ::: "memory")
__device__ __forceinline__ unsigned long long rt() { return __builtin_amdgcn_s_memrealtime(); }
__device__ __forceinline__ unsigned f2bf(float f) { unsigned u = __builtin_bit_cast(unsigned, f); return (u + 0x7fffu + ((u >> 16) & 1u)) >> 16; }
__device__ __forceinline__ unsigned pk2(float lo, float hi) { return f2bf(lo) | (f2bf(hi) << 16); }

#define XB_TMO      128
#define XB_XCNT(j)  (256  + 64 * (j))
#define XB_XSUB(j)  (1280 + 64 * (j))
#define XB_XGEN(j)  (2304 + 64 * (j))
#define XB_TOP      3328
#define XB_TOPGEN   3392
#define XCD_BAR_WORDS 3456
#define XB_SPIN_CAP (1u << 18)

__device__ __forceinline__ unsigned xb_ld(unsigned* p)              { return __hip_atomic_load(p, __ATOMIC_RELAXED, __HIP_MEMORY_SCOPE_AGENT); }
__device__ __forceinline__ unsigned xb_add(unsigned* p, unsigned v) { return __hip_atomic_fetch_add(p, v, __ATOMIC_RELAXED, __HIP_MEMORY_SCOPE_AGENT); }
__device__ __forceinline__ unsigned xb_xcc_id() { return (unsigned)__builtin_amdgcn_s_getreg((3 << 11) | 20) & 0xFu; }
#define XB_SPIN(cond, bar) do { unsigned _sp = 0; while (cond) { __builtin_amdgcn_s_sleep(1); \
    if ((++_sp & 255u) == 0u) { if (xb_ld(&(bar)[XB_TMO])) break; if (_sp > XB_SPIN_CAP) { atomicAdd(&(bar)[XB_TMO], 1u); break; } } } } while (0)

struct XcdBarrier {
    unsigned* bar; unsigned x;
    bool t0;
    volatile LAS unsigned* st;
};

__device__ __forceinline__ XcdBarrier xcd_barrier_post(unsigned* bar, volatile LAS unsigned* st) {
    XcdBarrier b; b.bar = bar; b.x = xb_xcc_id(); b.st = st; b.t0 = (threadIdx.x == 0);
    if (b.t0) (void)xb_add(&bar[XB_XCNT(b.x)], 1u);
    return b;
}
__device__ __forceinline__ void xcd_barrier_complete(unsigned* bar, unsigned x, unsigned& nloc, unsigned& nx) {
    const unsigned G = gridDim.x * gridDim.y * gridDim.z;
    unsigned sum, cnt, mine, sp = 0u;
    for (;;) {
        sum = 0u; cnt = 0u; mine = 0u;
#pragma unroll
        for (unsigned j = 0; j < 16; ++j) { const unsigned c = xb_ld(&bar[XB_XCNT(j)]); sum += c; cnt += (c > 0u) ? 1u : 0u; mine = (j == x) ? c : mine; }
        if (sum == G) break;
        __builtin_amdgcn_s_sleep(1);
        if ((++sp & 255u) == 0u) { if (xb_ld(&bar[XB_TMO])) break; if (sp > XB_SPIN_CAP) { atomicAdd(&bar[XB_TMO], 1u); break; } }
    }
    nloc = mine > 0u ? mine : 1u; nx = cnt > 0u ? cnt : 1u;
}

__device__ __forceinline__ void xcd_barrier(const XcdBarrier& b) {
    asm volatile("s_waitcnt vmcnt(0)" ::: "memory");
    __syncthreads();
    if (b.t0) {
        unsigned* bar = b.bar;
        __builtin_amdgcn_s_waitcnt(0);
        unsigned nloc = b.st[0], nx = b.st[1];
        if (nloc == 0u) { xcd_barrier_complete(bar, b.x, nloc, nx); b.st[0] = nloc; b.st[1] = nx; }
        const unsigned old = xb_add(&bar[XB_XSUB(b.x)], 1u);
        const unsigned gen = old / nloc;
        if (old + 1u == (gen + 1u) * nloc) {
            __builtin_amdgcn_fence(__ATOMIC_RELEASE, "agent");
            asm volatile("s_waitcnt vmcnt(0)" ::: "memory");
            const unsigned og = xb_add(&bar[XB_TOP], 1u);
            const unsigned tg = og / nx;
            if (og + 1u == (tg + 1u) * nx) xb_add(&bar[XB_TOPGEN], 1u);
            else XB_SPIN(xb_ld(&bar[XB_TOPGEN]) == tg, bar);
            __builtin_amdgcn_fence(__ATOMIC_ACQUIRE, "agent");
            xb_add(&bar[XB_XGEN(b.x)], 1u);
            asm volatile("s_waitcnt vmcnt(0)" ::: "memory");
        } else {
            XB_SPIN(xb_ld(&bar[XB_XGEN(b.x)]) == gen, bar);
            __builtin_amdgcn_fence(__ATOMIC_ACQUIRE, "agent");
            asm volatile("s_waitcnt vmcnt(0)" ::: "memory");
        }
    }
    __syncthreads();
}

#define LB_SUB(j) (64 * (j))
#define LB_GEN(j) (1024 + 64 * (j))
#define LB_WORDS 2048
__device__ __forceinline__ void xcc_local_barrier(const XcdBarrier& b, unsigned* lbar) {
    asm volatile("s_waitcnt vmcnt(0)" ::: "memory");
    __syncthreads();
    if (b.t0) {
        __builtin_amdgcn_s_waitcnt(0);
        unsigned nloc = b.st[0]; if (nloc == 0u) nloc = 1u;
        const unsigned old = xb_add(&lbar[LB_SUB(b.x)], 1u);
        const unsigned gen = old / nloc;
        if (old + 1u == (gen + 1u) * nloc) xb_add(&lbar[LB_GEN(b.x)], 1u);
        else XB_SPIN(xb_ld(&lbar[LB_GEN(b.x)]) == gen, b.bar);
        __builtin_amdgcn_fence(__ATOMIC_ACQUIRE, "agent");
        asm volatile("s_waitcnt vmcnt(0)" ::: "memory");
    }
    __syncthreads();
}

#ifndef PG8_SP2
#define PG8_SP2 true
#endif
#ifndef PG8_ALIGN
#define PG8_ALIGN true
#endif
#ifndef MK_DUP
#define MK_DUP (-1)
#endif
#ifndef MK_FP8
#define MK_FP8 1
#endif
#ifndef MK_FP8_P1
#define MK_FP8_P1 1
#endif
#ifndef MK_FP8_P2
#define MK_FP8_P2 1
#endif
#ifndef MK_STAGGER
#define MK_STAGGER 0
#endif
#ifndef MK_FP8_WIN
#define MK_FP8_WIN 0
#endif
#ifndef MK_LOCAL_BAR
#define MK_LOCAL_BAR 0
#endif
#ifndef MK_XSTAG_TICKS
#define MK_XSTAG_TICKS 0
#endif
#ifndef MK_PER_PHASE
#define MK_PER_PHASE 0
#endif

constexpr int NWAVES = 8;
constexpr int BATCH = 32, SEQ = 2048, D = 1024, M = BATCH * SEQ;
static_assert(pg8::SS_M == M, "row-statistics pitch");
constexpr int FF = 2816, INW = 3584;
constexpr int RH = 4, RD = 128, AH = 8, AD = 64, NBLK = 8, BLK = 256;
constexpr int PC_RQ = 0, PC_RK = 512, PC_RV = 1024, PC_RG = 1536, PC_AQ = 2048, PC_AK = 2560, PC_AV = 3072;
constexpr float EPS = 1e-6f;
constexpr float C2 = 0.125f * 1.4426950408889634f;
constexpr int N_PHASES = 10;

constexpr size_t MiB = 1u << 20;
constexpr size_t WS_CTL = 0, CTL_ZERO_BYTES = 1 * MiB;
constexpr size_t WS_W1A = 2 * MiB, WS_WD1 = 14 * MiB, WS_WIN = 20 * MiB, WS_WOUT = 27 * MiB, WS_W2A = 29 * MiB, WS_WD2 = 40 * MiB;
constexpr size_t WS_ROPE_R = 46 * MiB, WS_ROPE_A = 47 * MiB, WS_KMEAN = 47 * MiB + 512 * 1024, WS_RS0 = 48 * MiB, WS_SS1 = 49 * MiB, WS_SS2 = 53 * MiB;
constexpr size_t WS_XB = 64 * MiB, WS_MIX = 192 * MiB, WS_BIG = 320 * MiB, WS_XB8 = 768 * MiB, WS_END = 832 * MiB;
static_assert(WS_W1A + (size_t)2 * FF * D * 2 <= WS_WD1 && WS_WD1 + (size_t)D * FF * 2 <= WS_WIN && WS_WIN + (size_t)INW * D * 2 <= WS_WOUT && WS_WOUT + (size_t)D * D * 2 <= WS_W2A &&
              WS_W2A + (size_t)2 * FF * D * 2 <= WS_WD2 && WS_WD2 + (size_t)D * FF * 2 <= WS_ROPE_R && WS_ROPE_R + (size_t)SEQ * 64 * 8 <= WS_ROPE_A && WS_ROPE_A + (size_t)SEQ * 8 * 8 <= WS_KMEAN &&
              WS_KMEAN + (size_t)BATCH * AH * NBLK * AD * 4 <= WS_RS0 && WS_RS0 + (size_t)M * 4 <= WS_SS1 && WS_SS1 + (size_t)M * 64 <= WS_SS2 && WS_SS2 + (size_t)M * 64 <= WS_XB &&
              WS_XB + (size_t)M * D * 2 <= WS_MIX && WS_MIX + (size_t)M * D * 2 <= WS_BIG && WS_BIG + (size_t)M * INW * 2 <= WS_XB8 && WS_XB8 + (size_t)M * D <= WS_END, "d_ws map");
constexpr int CW_TMO = 0, CW_CODE = 1;
constexpr int CW_BAR = 4096, CW_LBAR = 8192, CW_XTAB = 12288;

constexpr int RING_OFF = 0, RING_BYTES = 131072;
constexpr int LDSCTL_OFF = RING_BYTES, MISC_OFF = LDSCTL_OFF + 320;
constexpr int LDS_BYTES = 158720;
constexpr int TB_OFF = 140288;
constexpr int RTAB_OFF = 132096;
static_assert(MISC_OFF + 128 <= RTAB_OFF && RTAB_OFF + 4 * 256 * 8 <= TB_OFF && TB_OFF + 8 * 2304 <= LDS_BYTES, "LDS map");


typedef float f32x2 __attribute__((ext_vector_type(2)));
struct Frame {
    LAS unsigned char* lds;
    volatile LAS unsigned* MISC;
    gu32* ctl;
    int tid, lane, wave;
    int vcu, G;
    const float* x; float* out;
    bf16 *W1A, *WD1, *WIN, *WOUT, *W2A, *WD2;
    bf16 *XB, *MIXB, *HB, *PROJ;
    unsigned char *XB8, *H8, *W2A8, *WD28, *WIN8;
    f32x2 *ROPE_R, *ROPE_A;
    float *KMEAN, *RS0, *SS1, *SS2;
};
__device__ __forceinline__ float bf_lo(unsigned u) { return __uint_as_float(u << 16); }
__device__ __forceinline__ float bf_hi(unsigned u) { return __uint_as_float(u & 0xffff0000u); }
__device__ __forceinline__ void unpack8(const v4u r, float (&x)[8]) { x[0] = bf_lo(r.x); x[1] = bf_hi(r.x); x[2] = bf_lo(r.y); x[3] = bf_hi(r.y); x[4] = bf_lo(r.z); x[5] = bf_hi(r.z); x[6] = bf_lo(r.w); x[7] = bf_hi(r.w); }
__device__ __forceinline__ v4u pack8(const float (&y)[8]) { v4u o; o.x = pk2(y[0], y[1]); o.y = pk2(y[2], y[3]); o.z = pk2(y[4], y[5]); o.w = pk2(y[6], y[7]); return o; }
__device__ __forceinline__ float wave_sum(float v) {
#pragma unroll
    for (int o = 1; o < 64; o <<= 1) v += __shfl_xor(v, o);
    return v;
}
__device__ __forceinline__ float silu_f(float g) { return g * __builtin_amdgcn_rcpf(1.0f + __builtin_amdgcn_exp2f(-1.4426950408889634f * g)); }

template <bool WINMAP = false> __device__ __forceinline__ void p0_transpose_item(const float* W, int K, int N, bf16* WT, int k0, int n0, int dst_row0, const float* kscale, LAS float* scr, int lane) {
    const int scol = WINMAP ? pg8::win_orig_col(n0 + (lane & 31)) : n0 + (lane & 31);
    float wv[32];
#pragma unroll
    for (int i = 0; i < 32; ++i) wv[i] = P0_LDNT((const GAS float*)W + (size_t)(k0 + 2 * i + (lane >> 5)) * N + scol);
#pragma unroll
    for (int i = 0; i < 32; ++i) { const int kk = 2 * i + (lane >> 5); const float sc = kscale ? kscale[k0 + kk] : 1.0f; scr[kk * 33 + (lane & 31)] = wv[i] * sc; }
    LDS_WAIT(); asm volatile("" ::: "memory");
    const int c = lane & 7;
#pragma unroll
    for (int j = 0; j < 4; ++j) { const int n = (lane >> 3) + 8 * j; const LAS float* s = scr + (8 * c) * 33 + n;
        v4u o; o.x = pk2(s[0 * 33], s[1 * 33]); o.y = pk2(s[2 * 33], s[3 * 33]); o.z = pk2(s[4 * 33], s[5 * 33]); o.w = pk2(s[6 * 33], s[7 * 33]);
        P0_STNT(o, (GAS v4u*)(WT + (size_t)(dst_row0 + n) * K + k0 + 8 * c)); }
    LDS_WAIT(); asm volatile("" ::: "memory");
}
template <bool WINMAP = false> __device__ __forceinline__ void p0_transpose_item_f8(const float* W, int K, int N, unsigned char* WT, int k0, int n0, int dst_row0, const float* kscale, float mul, LAS float* scr, int lane) {
    const int scol = WINMAP ? pg8::win_orig_col(n0 + (lane & 31)) : n0 + (lane & 31);
    float wv[32];
#pragma unroll
    for (int i = 0; i < 32; ++i) wv[i] = P0_LDNT((const GAS float*)W + (size_t)(k0 + 2 * i + (lane >> 5)) * N + scol);
#pragma unroll
    for (int i = 0; i < 32; ++i) { const int kk = 2 * i + (lane >> 5); const float sc = (kscale ? kscale[k0 + kk] : 1.0f) * mul; scr[kk * 33 + (lane & 31)] = wv[i] * sc; }
    LDS_WAIT(); asm volatile("" ::: "memory");
    const int c = lane & 7;
#pragma unroll
    for (int j = 0; j < 4; ++j) { const int n = (lane >> 3) + 8 * j; const LAS float* s = scr + (8 * c) * 33 + n;
        pg8::u32x2 o; o.x = pg8::pk4_fp8(s[0 * 33], s[1 * 33], s[2 * 33], s[3 * 33]); o.y = pg8::pk4_fp8(s[4 * 33], s[5 * 33], s[6 * 33], s[7 * 33]);
        P0_STNT(o, (GAS pg8::u32x2*)(WT + (size_t)(dst_row0 + n) * K + k0 + 8 * c)); }
    LDS_WAIT(); asm volatile("" ::: "memory");
}
__device__ __forceinline__ void x_row_to_bf16(Frame& F, const float* xrow, bf16* orow, float* rs) {
    const GAS f32x4* xr = (const GAS f32x4*)xrow + F.lane;
    f32x4 v[4]; float s = 0.f;
#pragma unroll
    for (int j = 0; j < 4; ++j) { v[j] = xr[64 * j]; s += (v[j].x * v[j].x + v[j].y * v[j].y) + (v[j].z * v[j].z + v[j].w * v[j].w); }
    const float tot = wave_sum(s);
    if (F.lane == 0) *rs = 1.0f / sqrtf(tot * (1.f / D) + EPS);
    GAS unsigned long long* o8 = (GAS unsigned long long*)orow + F.lane;
#pragma unroll
    for (int j = 0; j < 4; ++j) o8[64 * j] = (unsigned long long)pk2(v[j].x, v[j].y) | ((unsigned long long)pk2(v[j].z, v[j].w) << 32);
}
__device__ __forceinline__ void x_rows2_to_bf16(Frame& F, const float* xrow, bf16* orow, float* rs, size_t estride, int rstride, unsigned char* o8row = nullptr) {
    const GAS f32x4* xr = (const GAS f32x4*)xrow + F.lane; const GAS f32x4* xr2 = (const GAS f32x4*)(xrow + estride) + F.lane;
    f32x4 v[4], v2[4]; float s = 0.f, s2 = 0.f;
#pragma unroll
    for (int j = 0; j < 4; ++j) { v[j] = P0_LDNT(xr + 64 * j); v2[j] = P0_LDNT(xr2 + 64 * j); }
#pragma unroll
    for (int j = 0; j < 4; ++j) { s += (v[j].x * v[j].x + v[j].y * v[j].y) + (v[j].z * v[j].z + v[j].w * v[j].w); s2 += (v2[j].x * v2[j].x + v2[j].y * v2[j].y) + (v2[j].z * v2[j].z + v2[j].w * v2[j].w); }
    const float tot = wave_sum(s), tot2 = wave_sum(s2);
    if (F.lane == 0) { rs[0] = 1.0f / sqrtf(tot * (1.f / D) + EPS); rs[rstride] = 1.0f / sqrtf(tot2 * (1.f / D) + EPS); }
    GAS unsigned long long* o8 = (GAS unsigned long long*)orow + F.lane; GAS unsigned long long* o82 = (GAS unsigned long long*)(orow + estride) + F.lane;
    if (MK_FP8_P1) {
        GAS unsigned* q8 = (GAS unsigned*)o8row + F.lane; GAS unsigned* q82 = (GAS unsigned*)(o8row + estride) + F.lane;
#pragma unroll
        for (int j = 0; j < 4; ++j) { q8[64 * j] = pg8::pk4_fp8(v[j].x, v[j].y, v[j].z, v[j].w); q82[64 * j] = pg8::pk4_fp8(v2[j].x, v2[j].y, v2[j].z, v2[j].w); }
    }
#pragma unroll
    for (int j = 0; j < 4; ++j) { P0_STNT((unsigned long long)pk2(v[j].x, v[j].y) | ((unsigned long long)pk2(v[j].z, v[j].w) << 32), o8 + 64 * j); P0_STNT((unsigned long long)pk2(v2[j].x, v2[j].y) | ((unsigned long long)pk2(v2[j].z, v2[j].w) << 32), o82 + 64 * j); }
}
struct Args { const float* in[16]; float* out; unsigned char* ws; float invf_r[64]; float invf_a[8]; int ph_lo, ph_hi, li, pad; };
__device__ __forceinline__ void p0_prologue(Frame& F, const Args& args) {
    LAS float* scr = (LAS float*)(F.lds + RING_OFF + F.wave * 16384);
    const int gw = F.vcu * NWAVES + F.wave, NGW = F.G * NWAVES;
    constexpr int I_GU = (D / 64) * (FF / 32), I_DN = (FF / 64) * (D / 32), I_IN = (D / 64) * (INW / 32), I_OUT = (D / 64) * (D / 32);
    constexpr int NITEMS = 2 * (2 * I_GU + I_DN) + I_IN + I_OUT;
    for (int it = gw; it < NITEMS; it += NGW) {
        int r = it;
#pragma unroll
        for (int f = 0; f < 2; ++f) {
            const float* nw = args.in[f == 0 ? 1 : 12]; const float* wg = args.in[f == 0 ? 2 : 13]; const float* wu = args.in[f == 0 ? 3 : 14]; const float* wd = args.in[f == 0 ? 4 : 15];
            bf16* WA = f == 0 ? F.W1A : F.W2A; bf16* WD = f == 0 ? F.WD1 : F.WD2;
            if (r >= 0 && r < I_GU) { const int nblk = FF / 32, kb = r / nblk, nb = r % nblk, n0 = 32 * nb; const int dr = 256 * (n0 / 128) + (n0 % 128);
                if (f == 1 && MK_FP8) p0_transpose_item_f8(wg, D, FF, F.W2A8, 64 * kb, n0, dr, nw, pg8::W8_SCALE, scr, F.lane); else if (f == 0 && MK_FP8_P1) p0_transpose_item_f8(wg, D, FF, (unsigned char*)F.W1A, 64 * kb, n0, dr, nw, pg8::W8_SCALE, scr, F.lane); else p0_transpose_item(wg, D, FF, WA, 64 * kb, n0, dr, nw, scr, F.lane); r = -1; } else if (r >= 0) r -= I_GU;
            if (r >= 0 && r < I_GU) { const int nblk = FF / 32, kb = r / nblk, nb = r % nblk, n0 = 32 * nb; const int dr = 256 * (n0 / 128) + 128 + (n0 % 128);
                if (f == 1 && MK_FP8) p0_transpose_item_f8(wu, D, FF, F.W2A8, 64 * kb, n0, dr, nw, pg8::W8_SCALE, scr, F.lane); else if (f == 0 && MK_FP8_P1) p0_transpose_item_f8(wu, D, FF, (unsigned char*)F.W1A, 64 * kb, n0, dr, nw, pg8::W8_SCALE, scr, F.lane); else p0_transpose_item(wu, D, FF, WA, 64 * kb, n0, dr, nw, scr, F.lane); r = -1; } else if (r >= 0) r -= I_GU;
            if (r >= 0 && r < I_DN) { const int nblk = D / 32, kb = r / nblk, nb = r % nblk, n0 = 32 * nb;
                if (f == 1 && MK_FP8) p0_transpose_item_f8(wd, FF, D, F.WD28, 64 * kb, n0, n0, nullptr, pg8::W8_SCALE, scr, F.lane); else if (f == 0 && MK_FP8_P2) p0_transpose_item_f8(wd, FF, D, (unsigned char*)F.WD1, 64 * kb, n0, n0, nullptr, pg8::W8_SCALE, scr, F.lane); else p0_transpose_item(wd, FF, D, WD, 64 * kb, n0, n0, nullptr, scr, F.lane); r = -1; } else if (r >= 0) r -= I_DN;
        }
        if (r >= 0 && r < I_IN) { const int nblk = INW / 32, kb = r / nblk, nb = r % nblk, n0 = 32 * nb, tile = n0 >> 8;
            if (MK_FP8_WIN == 2) {
                if (tile == 4 || tile == 5 || tile == 12 || tile == 13) p0_transpose_item_f8<true>(args.in[6], D, INW, F.WIN8, 64 * kb, n0, (tile < 8 ? tile - 4 : tile - 10) * 256 + (n0 & 255), args.in[5], pg8::W8_SCALE, scr, F.lane);
                else p0_transpose_item<true>(args.in[6], D, INW, F.WIN + 524288, 64 * kb, n0, (tile < 4 ? tile : tile - 2) * 256 + (n0 & 255), args.in[5], scr, F.lane);
            } else
            if (MK_FP8_WIN && (tile < 8 || tile >= 12)) p0_transpose_item_f8<true>(args.in[6], D, INW, F.WIN8, 64 * kb, n0, tile < 8 ? n0 : n0 - 1024, args.in[5], pg8::W8_SCALE, scr, F.lane);
            else p0_transpose_item<true>(args.in[6], D, INW, F.WIN, 64 * kb, n0, n0, args.in[5], scr, F.lane);
            r = -1; } else if (r >= 0) r -= I_IN;
        if (r >= 0 && r < I_OUT) { const int nblk = D / 32, kb = r / nblk, nb = r % nblk, n0 = 32 * nb;
            if (MK_FP8_WOUT) p0_transpose_item_f8(args.in[11], D, D, (unsigned char*)F.WOUT, 64 * kb, n0, n0, nullptr, pg8::W8_SCALE, scr, F.lane); else p0_transpose_item(args.in[11], D, D, F.WOUT, 64 * kb, n0, n0, nullptr, scr, F.lane); r = -1; }
    }
    if (M % (2 * NGW) == 0) { for (int m = gw; m < M; m += 2 * NGW) x_rows2_to_bf16(F, F.x + (size_t)m * D, F.XB + (size_t)m * D, F.RS0 + m, (size_t)NGW * D, NGW, F.XB8 + (size_t)m * D); }
    else { for (int m = gw; m < M; m += NGW) x_row_to_bf16(F, F.x + (size_t)m * D, F.XB + (size_t)m * D, F.RS0 + m); }
    const int gt = F.vcu * (NWAVES * 64) + F.tid, NGT = F.G * NWAVES * 64;
    for (int idx = gt; idx < BATCH * AH * NBLK * AD; idx += NGT) F.KMEAN[idx] = 0.f;
    for (int idx = gt; idx < SEQ * 72; idx += NGT) {
        const int pos = idx / 72, i = idx % 72;
        float invf = 0.f;
#pragma unroll
        for (int k = 0; k < 64; ++k) invf = (i == k) ? args.invf_r[k] : invf;
#pragma unroll
        for (int k = 0; k < 8; ++k) invf = (i == 64 + k) ? args.invf_a[k] : invf;
        const float ang = (float)pos * invf;
        double rv = (double)ang * 0.15915494309189535; rv -= floor(rv);
        const float a = (float)(rv * 6.283185307179586);
        f32x2 cs; cs.x = cosf(a); cs.y = sinf(a);
        if (i < 64) F.ROPE_R[pos * 64 + i] = cs; else F.ROPE_A[pos * 8 + (i - 64)] = cs;
    }
}

__global__ void __launch_bounds__(NWAVES * 64, 2) mk_fwd(Args args) {
    __shared__ __attribute__((aligned(16))) unsigned char lds[LDS_BYTES];
    Frame F;
#if MK_F8SAT
    asm volatile("s_setreg_imm32_b32 hwreg(HW_REG_MODE, 23, 1), 1");
#endif
    F.lds = (LAS unsigned char*)lds;
    F.MISC = (volatile LAS unsigned*)(F.lds + MISC_OFF);
    F.wave = __builtin_amdgcn_readfirstlane((int)threadIdx.x >> 6); F.lane = mk_lane(); F.tid = F.wave * 64 + F.lane;
    F.G = gridDim.x; { const int bx = blockIdx.x; F.vcu = (F.G % 8 == 0) ? (bx % 8) * (F.G / 8) + bx / 8 : bx; }
    unsigned char* ws = args.ws;
    F.ctl = (gu32*)(ws + WS_CTL);
    F.x = args.in[0]; F.out = args.out;
#define FRAME_PTRS() do { unsigned char* ws = args.ws; asm volatile("" : "+s"(ws)); F.lane = mk_lane(); F.tid = F.wave * 64 + F.lane; \
    F.W1A = (bf16*)(ws + WS_W1A); F.WD1 = (bf16*)(ws + WS_WD1); F.WIN = (bf16*)(ws + WS_WIN); F.WOUT = (bf16*)(ws + WS_WOUT); F.W2A = (bf16*)(ws + WS_W2A); F.WD2 = (bf16*)(ws + WS_WD2); \
    F.XB8 = ws + WS_XB8; F.H8 = ws + WS_BIG; F.W2A8 = ws + WS_W2A; F.WD28 = ws + WS_WD2; F.WIN8 = ws + WS_WIN; \
    F.XB = (bf16*)(ws + WS_XB); F.MIXB = (bf16*)(ws + WS_MIX); F.HB = (bf16*)(ws + WS_BIG); F.PROJ = (bf16*)(ws + WS_BIG); \
    F.ROPE_R = (f32x2*)(ws + WS_ROPE_R); F.ROPE_A = (f32x2*)(ws + WS_ROPE_A); \
    F.KMEAN = (float*)(ws + WS_KMEAN); F.RS0 = (float*)(ws + WS_RS0); F.SS1 = (float*)(ws + WS_SS1); F.SS2 = (float*)(ws + WS_SS2); } while (0)
    FRAME_PTRS();
    for (int u = F.tid; u < (LDS_BYTES - LDSCTL_OFF) / 4; u += NWAVES * 64) ((LAS unsigned*)(F.lds + LDSCTL_OFF))[u] = 0u;
    __syncthreads();
    XcdBarrier bar; bar.bar = (unsigned*)(F.ctl + CW_BAR); bar.x = 0; bar.st = nullptr; bar.t0 = false;
    if (!MK_PER_PHASE) bar = xcd_barrier_post((unsigned*)(F.ctl + CW_BAR), F.MISC + 8);
    if (!MK_PER_PHASE && MK_LOCAL_BAR && F.tid == 0) __hip_atomic_store(F.ctl + CW_XTAB + blockIdx.x, bar.x + 1u, RLX_AGENT);
#define GRID_BAR() do { if (!MK_PER_PHASE) { unsigned char* w_ = args.ws; asm volatile("" : "+s"(w_)); XcdBarrier b_; b_.bar = (unsigned*)w_ + CW_BAR; b_.x = xb_xcc_id(); b_.st = F.MISC + 8; b_.t0 = (F.wave == 0) && (mk_lane() == 0); \
        if (MK_LOCAL_BAR && F.MISC[12] != 0u) xcc_local_barrier(b_, (unsigned*)w_ + CW_LBAR); else xcd_barrier(b_); } } while (0)
#ifndef MK_STAG4
#define MK_STAG4 0
#endif
#ifndef MK_STAG7
#define MK_STAG7 750
#endif
#ifndef MK_STAG9
#define MK_STAG9 1400
#endif
#define STAGGER4(ticks) do { const unsigned long long w_ = (unsigned long long)(ticks) * (MK_STAG4 == 1 ? (blockIdx.x & 3) : (MK_STAG4 == 2 ? ((blockIdx.x >> 3) & 1) : 0)); if (w_) { const unsigned long long t0_ = rt(); while (rt() - t0_ < w_) __builtin_amdgcn_s_sleep(8); } } while (0)
#define STAGGER(ticks) do { if (MK_STAGGER && (F.vcu & 1)) { const unsigned long long t0_ = rt(); while (rt() - t0_ < (unsigned long long)(ticks)) __builtin_amdgcn_s_sleep(8); } } while (0)
    const int lo = args.ph_lo, hi = args.ph_hi;
#define IN(k) (lo <= (k) && (k) < hi)
#define BOTH(k) (IN(k) && IN((k) + 1))

#if MK_DUP == 0
    if (IN(0)) { FRAME_PTRS(); p0_prologue(F, args); GRID_BAR(); }
#endif
    if (IN(0)) { FRAME_PTRS(); p0_prologue(F, args); if (BOTH(0)) GRID_BAR(); }
    if (!MK_PER_PHASE && MK_LOCAL_BAR && IN(0) && BOTH(0)) {
        bool ok = true;
        if (F.tid < F.G) { const unsigned v = __hip_atomic_load(F.ctl + CW_XTAB + F.tid, RLX_AGENT), r0 = __hip_atomic_load(F.ctl + CW_XTAB + (F.tid & 7), RLX_AGENT); ok = (v != 0u) && (v == r0); }
        const bool local_ok = (__syncthreads_and(ok ? 1 : 0) != 0) && F.G == 256;
        if (F.tid == 0) F.MISC[12] = local_ok ? 1u : 0u;
        __syncthreads();
        if (local_ok && MK_XSTAG_TICKS > 0) { const unsigned long long t0_ = rt(), w_ = (unsigned long long)MK_XSTAG_TICKS * (blockIdx.x & 7); while (rt() - t0_ < w_) __builtin_amdgcn_s_sleep(8); }
    }

#if MK_DUP == 1
    if (IN(1)) { FRAME_PTRS();
#if MK_FP8_P1
        pg8::Gemm g{(const pg8::bf16_t*)F.XB8, (const pg8::bf16_t*)F.W1A, M, 2 * FF, D}; pg8::StaticOrder S; S.init(M, 2 * FF, F.G, (int)blockIdx.x);
#else
        pg8::Gemm g{F.XB, F.W1A, M, 2 * FF, D}; pg8::StaticOrder S; S.init(M, 2 * FF, F.G, (int)blockIdx.x);
#endif
        const pg8::RTab rt_ = pg8::fill_rstd_table<false, 1>((LAS float*)(F.lds + RTAB_OFF), S, F.RS0, F.tid, MK_FP8_P1 ? 1.0f / pg8::W8_SCALE : 1.0f, MK_FP8_P2 ? pg8::H8_SCALE : 1.0f);
        pg8::EpiSwiGLU<false, MK_FP8_P1 != 0, true, MK_FP8_P2 != 0> E{F.HB, FF, F.RS0, rt_, F.lds + TB_OFF + F.wave * 2304};
        pg8::gemm_phase<pg8::EpiSwiGLU<false, MK_FP8_P1 != 0, true, MK_FP8_P2 != 0>, pg8::StaticOrder, PG8_ALIGN, PG8_SP2, MK_FP8_P1 != 0>(F.lds + RING_OFF, g, S, E, F.wave);
        GRID_BAR();
    }
#endif
    if (IN(1)) { FRAME_PTRS(); STAGGER(1300);
#if MK_FP8_P1
        pg8::Gemm g{(const pg8::bf16_t*)F.XB8, (const pg8::bf16_t*)F.W1A, M, 2 * FF, D}; pg8::StaticOrder S; S.init(M, 2 * FF, F.G, (int)blockIdx.x);
#else
        pg8::Gemm g{F.XB, F.W1A, M, 2 * FF, D}; pg8::StaticOrder S; S.init(M, 2 * FF, F.G, (int)blockIdx.x);
#endif
        const pg8::RTab rt_ = pg8::fill_rstd_table<false, 1>((LAS float*)(F.lds + RTAB_OFF), S, F.RS0, F.tid, MK_FP8_P1 ? 1.0f / pg8::W8_SCALE : 1.0f, MK_FP8_P2 ? pg8::H8_SCALE : 1.0f);
        pg8::EpiSwiGLU<false, MK_FP8_P1 != 0, true, MK_FP8_P2 != 0> E{F.HB, FF, F.RS0, rt_, F.lds + TB_OFF + F.wave * 2304};
        pg8::gemm_phase<pg8::EpiSwiGLU<false, MK_FP8_P1 != 0, true, MK_FP8_P2 != 0>, pg8::StaticOrder, PG8_ALIGN, PG8_SP2, MK_FP8_P1 != 0>(F.lds + RING_OFF, g, S, E, F.wave);
        if (BOTH(1)) GRID_BAR();
    }
#if MK_DUP == 2 || MK_DUP == 22
    if (IN(2)) { FRAME_PTRS();
        pg8::Gemm g{F.HB, F.WD1, M, D, FF}; pg8::StaticOrder S; S.init(M, D, F.G, (int)blockIdx.x);
#if MK_DUP == 22
        pg8::EpiNone E{};
        pg8::gemm_phase<pg8::EpiNone, pg8::StaticOrder, PG8_ALIGN, PG8_SP2, false, 2>(F.lds + RING_OFF, g, S, E, F.wave);
#else
#ifndef MK_EDBG
#define MK_EDBG 0
#endif
        pg8::EpiResid<true, false, true, 1, MK_FP8_WIN != 0> E{nullptr, F.XB, nullptr, (bf16*)(args.ws + WS_MIX), (float*)(args.ws + ((size_t)736 << 20)), args.ws + ((size_t)672 << 20), F.lds + TB_OFF + F.wave * 2304};
#if MK_FP8_P2
        pg8::gemm_phase<pg8::EpiResid<true, false, true, 2, MK_FP8_WIN != 0>, pg8::StaticOrder, PG8_ALIGN, PG8_SP2, true, 1>(F.lds + RING_OFF, g, S, E, F.wave);
#else
        pg8::gemm_phase<pg8::EpiResid<true, false, true, 1, MK_FP8_WIN != 0>, pg8::StaticOrder, PG8_ALIGN, PG8_SP2, false, 2>(F.lds + RING_OFF, g, S, E, F.wave);
#endif
#endif
        GRID_BAR();
    }
#endif
    if (IN(2)) { FRAME_PTRS();
        pg8::Gemm g{F.HB, F.WD1, M, D, FF}; pg8::StaticOrder S; S.init(M, D, F.G, (int)blockIdx.x);
#if MK_FP8_P2
        pg8::EpiResid<true, false, true, 2, MK_FP8_WIN != 0> E{nullptr, F.XB, nullptr, F.XB, F.SS1, F.XB8, F.lds + TB_OFF + F.wave * 2304};
#else
        pg8::EpiResid<true, false, true, 1, MK_FP8_WIN != 0> E{nullptr, F.XB, nullptr, F.XB, F.SS1, F.XB8, F.lds + TB_OFF + F.wave * 2304};
#endif
#if MK_FP8_P2
        pg8::gemm_phase<pg8::EpiResid<true, false, true, 2, MK_FP8_WIN != 0>, pg8::StaticOrder, PG8_ALIGN, PG8_SP2, true, 1>(F.lds + RING_OFF, g, S, E, F.wave);
#else
        pg8::gemm_phase<pg8::EpiResid<true, false, true, 1, MK_FP8_WIN != 0>, pg8::StaticOrder, PG8_ALIGN, PG8_SP2, false, 2>(F.lds + RING_OFF, g, S, E, F.wave);
#endif
        if (BOTH(2)) GRID_BAR();
    }
#if MK_DUP == 33
    if (IN(3)) { FRAME_PTRS();
        pg8::Gemm g{F.XB, F.WIN, M, INW, D}; pg8::StaticOrder S; S.init(M, INW, F.G, (int)blockIdx.x); pg8::EpiNone E{};
        pg8::gemm_phase<pg8::EpiNone, pg8::StaticOrder, PG8_ALIGN, PG8_SP2>(F.lds + RING_OFF, g, S, E, F.wave);
        GRID_BAR();
    }
#endif
#if MK_DUP == 3
    if (IN(3)) { FRAME_PTRS();
#if MK_FP8_WIN
        {   pg8::Gemm g{F.XB, F.WIN + (size_t)2048 * D, M, 1024, D}; pg8::StaticOrder S; S.init(M, 1024, F.G, (int)blockIdx.x);
            pg8::EpiProjFused<1, false> E{F.PROJ, INW, F.SS1, (const pg8::f32x4*)F.ROPE_R, (const pg8::f32x4*)F.ROPE_A, args.in[8], args.in[9], F.KMEAN, F.lds + TB_OFF + F.wave * 2304, pg8::RTab{nullptr, 0}};
            pg8::gemm_phase<pg8::EpiProjFused<1, false>, pg8::StaticOrder, PG8_ALIGN, PG8_SP2>(F.lds + RING_OFF, g, S, E, F.wave); }
        {   pg8::Gemm g{(const pg8::bf16_t*)F.XB8, (const pg8::bf16_t*)F.WIN8, M, 2560, D}; pg8::StaticOrder S; S.init(M, 2560, F.G, (int)blockIdx.x);
            const pg8::RTab rt_ = pg8::fill_rstd_table<true>((LAS float*)(F.lds + RTAB_OFF), S, F.SS1, F.tid);
            pg8::EpiProjFused<2, true> E{F.PROJ, INW, F.SS1, (const pg8::f32x4*)F.ROPE_R, (const pg8::f32x4*)F.ROPE_A, args.in[8], args.in[9], F.KMEAN, F.lds + TB_OFF + F.wave * 2304, rt_};
            pg8::gemm_phase<pg8::EpiProjFused<2, true>, pg8::StaticOrder, PG8_ALIGN, PG8_SP2, true, 1>(F.lds + RING_OFF, g, S, E, F.wave); }
#else
        pg8::Gemm g{F.XB, F.WIN, M, INW, D}; pg8::StaticOrder S; S.init(M, INW, F.G, (int)blockIdx.x);
        const pg8::RTab rt_ = pg8::fill_rstd_table<true>((LAS float*)(F.lds + RTAB_OFF), S, F.SS1, F.tid);
        pg8::EpiProjFused<0, false> E{F.PROJ, INW, F.SS1, (const pg8::f32x4*)F.ROPE_R, (const pg8::f32x4*)F.ROPE_A, args.in[8], args.in[9], F.KMEAN, F.lds + TB_OFF + F.wave * 2304, rt_};
        pg8::gemm_phase<pg8::EpiProjFused<0, false>, pg8::StaticOrder, PG8_ALIGN, PG8_SP2>(F.lds + RING_OFF, g, S, E, F.wave);
#endif
        GRID_BAR();
    }
#endif
    if (IN(3)) { FRAME_PTRS(); STAGGER(1500);
#if MK_FP8_WIN == 2
        {   pg8::Gemm g{F.XB, F.WIN + 524288, M, 2560, D}; pg8::StaticOrder S; S.init(M, 2560, F.G, (int)blockIdx.x);
            const pg8::RTab rt_ = pg8::fill_rstd_table<true>((LAS float*)(F.lds + RTAB_OFF), S, F.SS1, F.tid);
            pg8::EpiProjFused<3, false> E{F.PROJ, INW, F.SS1, (const pg8::f32x4*)F.ROPE_R, (const pg8::f32x4*)F.ROPE_A, args.in[8], args.in[9], F.KMEAN, F.lds + TB_OFF + F.wave * 2304, rt_};
            pg8::gemm_phase<pg8::EpiProjFused<3, false>, pg8::StaticOrder, PG8_ALIGN, PG8_SP2>(F.lds + RING_OFF, g, S, E, F.wave); }
        {   pg8::Gemm g{(const pg8::bf16_t*)F.XB8, (const pg8::bf16_t*)F.WIN8, M, 1024, D}; pg8::StaticOrder S; S.init(M, 1024, F.G, (int)blockIdx.x);
            const pg8::RTab rt_ = pg8::fill_rstd_table<true>((LAS float*)(F.lds + RTAB_OFF), S, F.SS1, F.tid);
            pg8::EpiProjFused<4, true> E{F.PROJ, INW, F.SS1, (const pg8::f32x4*)F.ROPE_R, (const pg8::f32x4*)F.ROPE_A, args.in[8], args.in[9], F.KMEAN, F.lds + TB_OFF + F.wave * 2304, rt_};
            pg8::gemm_phase<pg8::EpiProjFused<4, true>, pg8::StaticOrder, PG8_ALIGN, PG8_SP2, true, 1>(F.lds + RING_OFF, g, S, E, F.wave); }
#elif MK_FP8_WIN
        {   pg8::Gemm g{F.XB, F.WIN + (size_t)2048 * D, M, 1024, D}; pg8::StaticOrder S; S.init(M, 1024, F.G, (int)blockIdx.x);
            pg8::EpiProjFused<1, false> E{F.PROJ, INW, F.SS1, (const pg8::f32x4*)F.ROPE_R, (const pg8::f32x4*)F.ROPE_A, args.in[8], args.in[9], F.KMEAN, F.lds + TB_OFF + F.wave * 2304, pg8::RTab{nullptr, 0}};
            pg8::gemm_phase<pg8::EpiProjFused<1, false>, pg8::StaticOrder, PG8_ALIGN, PG8_SP2>(F.lds + RING_OFF, g, S, E, F.wave); }
        {   pg8::Gemm g{(const pg8::bf16_t*)F.XB8, (const pg8::bf16_t*)F.WIN8, M, 2560, D}; pg8::StaticOrder S; S.init(M, 2560, F.G, (int)blockIdx.x);
            const pg8::RTab rt_ = pg8::fill_rstd_table<true>((LAS float*)(F.lds + RTAB_OFF), S, F.SS1, F.tid);
            pg8::EpiProjFused<2, true> E{F.PROJ, INW, F.SS1, (const pg8::f32x4*)F.ROPE_R, (const pg8::f32x4*)F.ROPE_A, args.in[8], args.in[9], F.KMEAN, F.lds + TB_OFF + F.wave * 2304, rt_};
            pg8::gemm_phase<pg8::EpiProjFused<2, true>, pg8::StaticOrder, PG8_ALIGN, PG8_SP2, true, 1>(F.lds + RING_OFF, g, S, E, F.wave); }
#else
        pg8::Gemm g{F.XB, F.WIN, M, INW, D}; pg8::StaticOrder S; S.init(M, INW, F.G, (int)blockIdx.x);
        const pg8::RTab rt_ = pg8::fill_rstd_table<true>((LAS float*)(F.lds + RTAB_OFF), S, F.SS1, F.tid);
        pg8::EpiProjFused<0, false> E{F.PROJ, INW, F.SS1, (const pg8::f32x4*)F.ROPE_R, (const pg8::f32x4*)F.ROPE_A, args.in[8], args.in[9], F.KMEAN, F.lds + TB_OFF + F.wave * 2304, rt_};
        pg8::gemm_phase<pg8::EpiProjFused<0, false>, pg8::StaticOrder, PG8_ALIGN, PG8_SP2>(F.lds + RING_OFF, g, S, E, F.wave);
#endif
        if (BOTH(3)) GRID_BAR();
    }
    if (IN(4)) { FRAME_PTRS();
    }
#if MK_DUP == 5
    if (IN(5)) { FRAME_PTRS();
        static_assert(ret_body::RET_LDS_END <= LDS_BYTES && ret_body::RBETA >= MISC_OFF + 128, "retention body LDS vs frame");
        if (F.G == 256) { if (!(F.vcu & 1)) { const int u = F.vcu >> 1; ret_body::ret_unit(F.PROJ, F.MIXB, args.in[7], u / RH, u % RH, F.lds, F.wave); } }
        else for (int u = F.vcu; u < BATCH * RH; u += F.G) ret_body::ret_unit(F.PROJ, F.MIXB, args.in[7], u / RH, u % RH, F.lds, F.wave);
        GRID_BAR();
    }
#endif
    if (IN(5)) { FRAME_PTRS();
        static_assert(ret_body::RET_LDS_END <= LDS_BYTES && ret_body::RBETA >= MISC_OFF + 128, "retention body LDS vs frame");
        if (F.G == 256) { if (!(F.vcu & 1)) { const int u = F.vcu >> 1; ret_body::ret_unit(F.PROJ, F.MIXB, args.in[7], u / RH, u % RH, F.lds, F.wave); } }
        else for (int u = F.vcu; u < BATCH * RH; u += F.G) ret_body::ret_unit(F.PROJ, F.MIXB, args.in[7], u / RH, u % RH, F.lds, F.wave);
    }
#if MK_DUP == 6
    if (IN(6)) { FRAME_PTRS();
        static_assert(attn_body::ATTN_LDS_BYTES <= RING_BYTES, "attention body LDS vs frame");
        const attn_body::AttnTensors AT{(const attn_body::bf16*)(F.PROJ + PC_AQ), (const attn_body::bf16*)(F.PROJ + PC_AK), (const attn_body::bf16*)(F.PROJ + PC_AV), (attn_body::bf16*)(MK_FP8_WOUT ? (bf16*)((unsigned char*)F.MIXB + 512) : F.MIXB + 512), F.KMEAN, args.in[10]};
        const attn_body::StaticOrder SA((int)F.G, F.vcu);
        attn_body::attn_phase<attn_body::StaticOrder>((char*)lds + RING_OFF, AT, SA, F.wave);
        GRID_BAR();
    }
#endif
    if (IN(6)) { FRAME_PTRS();
        static_assert(attn_body::ATTN_LDS_BYTES <= RING_BYTES, "attention body LDS vs frame");
        const attn_body::AttnTensors AT{(const attn_body::bf16*)(F.PROJ + PC_AQ), (const attn_body::bf16*)(F.PROJ + PC_AK), (const attn_body::bf16*)(F.PROJ + PC_AV), (attn_body::bf16*)(MK_FP8_WOUT ? (bf16*)((unsigned char*)F.MIXB + 512) : F.MIXB + 512), F.KMEAN, args.in[10]};
        const attn_body::StaticOrder SA((int)F.G, F.vcu);
        attn_body::attn_phase<attn_body::StaticOrder>((char*)lds + RING_OFF, AT, SA, F.wave);
        if (BOTH(6)) GRID_BAR();
    }
    if (IN(7)) { FRAME_PTRS(); STAGGER4(MK_STAG7);
#if MK_FP8_WOUT
        pg8::Gemm g{F.MIXB, F.WOUT, M, D, D}; pg8::StaticOrder S; S.init(M, D, F.G, (int)blockIdx.x);
        pg8::EpiResid<true, false, true, 3, MK_FP8 != 0> E{nullptr, F.XB, nullptr, F.XB, F.SS2, F.XB8, F.lds + TB_OFF + F.wave * 2304};
        pg8::gemm_phase<pg8::EpiResid<true, false, true, 3, MK_FP8 != 0>, pg8::StaticOrder, PG8_ALIGN, PG8_SP2, true>(F.lds + RING_OFF, g, S, E, F.wave);
#else
        pg8::Gemm g{F.MIXB, F.WOUT, M, D, D}; pg8::StaticOrder S; S.init(M, D, F.G, (int)blockIdx.x);
        pg8::EpiResid<true, false, true, 0, MK_FP8 != 0> E{nullptr, F.XB, nullptr, F.XB, F.SS2, F.XB8, F.lds + TB_OFF + F.wave * 2304};
        pg8::gemm_phase<pg8::EpiResid<true, false, true, 0, MK_FP8 != 0>, pg8::StaticOrder, PG8_ALIGN, PG8_SP2>(F.lds + RING_OFF, g, S, E, F.wave);
#endif
        if (BOTH(7)) GRID_BAR();
    }
#if MK_DUP == 8
    if (IN(8)) { FRAME_PTRS();
#if MK_FP8
        pg8::Gemm g{(const pg8::bf16_t*)F.XB8, (const pg8::bf16_t*)F.W2A8, M, 2 * FF, D}; pg8::StaticOrder S; S.init(M, 2 * FF, F.G, (int)blockIdx.x);
        const pg8::RTab rt_ = pg8::fill_rstd_table<true, 1>((LAS float*)(F.lds + RTAB_OFF), S, F.SS2, F.tid, 1.0f / pg8::W8_SCALE, pg8::H8_SCALE);
        pg8::EpiSwiGLU<true, true, true> E{(pg8::bf16_t*)F.H8, FF, F.SS2, rt_, F.lds + TB_OFF + F.wave * 2304};
        pg8::gemm_phase<pg8::EpiSwiGLU<true, true, true>, pg8::StaticOrder, PG8_ALIGN, PG8_SP2, true, 1>(F.lds + RING_OFF, g, S, E, F.wave);
#else
        pg8::Gemm g{F.XB, F.W2A, M, 2 * FF, D}; pg8::StaticOrder S; S.init(M, 2 * FF, F.G, (int)blockIdx.x);
        pg8::EpiSwiGLU<true> E{F.HB, FF, F.SS2, pg8::RTab{nullptr, 0}};
        pg8::gemm_phase<pg8::EpiSwiGLU<true>, pg8::StaticOrder, PG8_ALIGN, PG8_SP2>(F.lds + RING_OFF, g, S, E, F.wave);
#endif
        GRID_BAR();
    }
#endif
    if (IN(8)) { FRAME_PTRS(); STAGGER(750);
#if MK_FP8
        pg8::Gemm g{(const pg8::bf16_t*)F.XB8, (const pg8::bf16_t*)F.W2A8, M, 2 * FF, D}; pg8::StaticOrder S; S.init(M, 2 * FF, F.G, (int)blockIdx.x);
        const pg8::RTab rt_ = pg8::fill_rstd_table<true, 1>((LAS float*)(F.lds + RTAB_OFF), S, F.SS2, F.tid, 1.0f / pg8::W8_SCALE, pg8::H8_SCALE);
        pg8::EpiSwiGLU<true, true, true> E{(pg8::bf16_t*)F.H8, FF, F.SS2, rt_, F.lds + TB_OFF + F.wave * 2304};
        pg8::gemm_phase<pg8::EpiSwiGLU<true, true, true>, pg8::StaticOrder, PG8_ALIGN, PG8_SP2, true, 1>(F.lds + RING_OFF, g, S, E, F.wave);
#else
        pg8::Gemm g{F.XB, F.W2A, M, 2 * FF, D}; pg8::StaticOrder S; S.init(M, 2 * FF, F.G, (int)blockIdx.x);
        pg8::EpiSwiGLU<true> E{F.HB, FF, F.SS2, pg8::RTab{nullptr, 0}};
        pg8::gemm_phase<pg8::EpiSwiGLU<true>, pg8::StaticOrder, PG8_ALIGN, PG8_SP2>(F.lds + RING_OFF, g, S, E, F.wave);
#endif
        if (BOTH(8)) GRID_BAR();
    }
#if defined(MK_PROBE) && (MK_PROBE == 90 || MK_PROBE == 91)
    if (IN(8)) { FRAME_PTRS();
        const unsigned long long t0 = __builtin_amdgcn_s_memtime(), r0 = __builtin_amdgcn_s_memrealtime();
#if MK_PROBE == 90
        { pg8::Gemm g{(const pg8::bf16_t*)F.XB8, (const pg8::bf16_t*)F.W2A8, M, 2 * FF, D}; pg8::StaticOrder S; S.init(M, 2 * FF, F.G, (int)blockIdx.x); pg8::EpiNone E{};
        pg8::gemm_phase<pg8::EpiNone, pg8::StaticOrder, PG8_ALIGN, PG8_SP2, true, 1>(F.lds + RING_OFF, g, S, E, F.wave); }
#else
        { pg8::Gemm g{F.XB, F.W1A, M, 2 * FF, D}; pg8::StaticOrder S; S.init(M, 2 * FF, F.G, (int)blockIdx.x); pg8::EpiNone E{};
        pg8::gemm_phase<pg8::EpiNone, pg8::StaticOrder, PG8_ALIGN, PG8_SP2>(F.lds + RING_OFF, g, S, E, F.wave); }
#endif
        const unsigned long long t1 = __builtin_amdgcn_s_memtime(), r1 = __builtin_amdgcn_s_memrealtime();
        if (blockIdx.x == 0) { const unsigned long long ticks = 5000ull * (t1 - t0) / (r1 - r0);
            while (__builtin_amdgcn_s_memrealtime() - r1 < ticks) __builtin_amdgcn_s_sleep(32); }
        GRID_BAR();
    }
#elif defined(MK_PROBE)
    if (IN(8)) { FRAME_PTRS();
#if MK_PROBE == 81
        pg8::Gemm g{(const pg8::bf16_t*)F.XB8, (const pg8::bf16_t*)F.W2A8, M, 2 * FF, D}; pg8::StaticOrder S; S.init(M, 2 * FF, F.G, (int)blockIdx.x); pg8::EpiNone E{};
        pg8::gemm_phase<pg8::EpiNone, pg8::StaticOrder, PG8_ALIGN, PG8_SP2, true, 1>(F.lds + RING_OFF, g, S, E, F.wave);
#elif MK_PROBE == 82
        pg8::Gemm g{(const pg8::bf16_t*)(args.ws + (512u << 10)), (const pg8::bf16_t*)F.W2A8, M, 2 * FF, D}; pg8::Row0Order S; S.init(M, 2 * FF, F.G, (int)blockIdx.x); pg8::EpiNone E{};
        pg8::gemm_phase<pg8::EpiNone, pg8::Row0Order, PG8_ALIGN, PG8_SP2, true>(F.lds + RING_OFF, g, S, E, F.wave);
#elif MK_PROBE == 83
        pg8::Gemm g{(const pg8::bf16_t*)F.XB8, (const pg8::bf16_t*)F.W2A8, M, 2 * FF, D}; pg8::Row0Order S; S.init(M, 2 * FF, F.G, (int)blockIdx.x); pg8::EpiNone E{};
        pg8::gemm_phase<pg8::EpiNone, pg8::Row0Order, PG8_ALIGN, PG8_SP2, true, 1>(F.lds + RING_OFF, g, S, E, F.wave);
#elif MK_PROBE == 11
        pg8::Gemm g{F.XB, F.W1A, M, 2 * FF, D}; pg8::StaticOrder S; S.init(M, 2 * FF, F.G, (int)blockIdx.x); pg8::EpiNone E{};
        pg8::gemm_phase<pg8::EpiNone, pg8::StaticOrder, PG8_ALIGN, PG8_SP2>(F.lds + RING_OFF, g, S, E, F.wave);
#endif
        GRID_BAR();
    }
#endif
    if (IN(9)) { FRAME_PTRS(); STAGGER4(MK_STAG9);
#if MK_FP8
        pg8::Gemm g{(const pg8::bf16_t*)F.H8, (const pg8::bf16_t*)F.WD28, M, D, FF}; pg8::StaticOrder S; S.init(M, D, F.G, (int)blockIdx.x);
        pg8::EpiResid<true, true, false, 2> E{nullptr, F.XB, F.out, nullptr, nullptr, nullptr, F.lds + TB_OFF + F.wave * 2304};
        pg8::gemm_phase<pg8::EpiResid<true, true, false, 2>, pg8::StaticOrder, PG8_ALIGN, PG8_SP2, true, 1>(F.lds + RING_OFF, g, S, E, F.wave);
#else
        pg8::Gemm g{F.HB, F.WD2, M, D, FF}; pg8::StaticOrder S; S.init(M, D, F.G, (int)blockIdx.x);
        pg8::EpiResid<true, true, false, 1> E{nullptr, F.XB, F.out, nullptr, nullptr, nullptr, F.lds + TB_OFF + F.wave * 2304};
        pg8::gemm_phase<pg8::EpiResid<true, true, false, 1>, pg8::StaticOrder, PG8_ALIGN, PG8_SP2>(F.lds + RING_OFF, g, S, E, F.wave);
#endif
    }
#if defined(MK_F8SAT_PROBE)
    {   FRAME_PTRS(); GRID_BAR();
        if (blockIdx.x == 0 && F.tid == 0) { float big = (float)gridDim.x * 4.0f, huge = big * 1e27f; asm volatile("" : "+v"(big), "+v"(huge));
            int w1 = 0; w1 = __builtin_amdgcn_cvt_pk_fp8_f32(big, -big, w1, false); int w2 = 0; w2 = __builtin_amdgcn_cvt_pk_fp8_f32(huge, -huge, w2, false);
            if ((w1 & 0xffff) != 0xfe7e || (w2 & 0xffff) != 0xfe7e) F.out[0] = __builtin_nanf(""); } }
#endif
#undef IN
#undef BOTH
#undef GRID_BAR
}

extern "C" void kernel_launch(void* const* d_in, const int* in_sizes, int n_in, void* d_out, int out_size, void* d_ws, size_t ws_size, hipStream_t stream) {
    static int grid = 0;
    if (grid == 0) {
        if (n_in != 16 || in_sizes[0] != M * D || out_size != M * D || ws_size < WS_END) { fprintf(stderr, "kernel_launch: unexpected shapes (n_in %d, in0 %d, out %d, ws %zu); nothing launched\n", n_in, n_in > 0 ? in_sizes[0] : -1, out_size, ws_size); grid = -1; return; }
        int dev = 0, cus = 0, per_cu = 0;
        if (hipGetDevice(&dev) != hipSuccess || hipDeviceGetAttribute(&cus, hipDeviceAttributeMultiprocessorCount, dev) != hipSuccess) { fprintf(stderr, "kernel_launch: device query failed\n"); grid = -1; return; }
        if (hipOccupancyMaxActiveBlocksPerMultiprocessor(&per_cu, (const void*)mk_fwd, NWAVES * 64, 0) != hipSuccess || per_cu < 1)
            fprintf(stderr, "kernel_launch: note: occupancy query reports %d workgroups per CU\n", per_cu);
        (void)hipGetLastError();
        grid = cus;
    }
    if (grid < 0) return;
    if (hipMemsetAsync((char*)d_ws + WS_CTL, 0, CTL_ZERO_BYTES, stream) != hipSuccess) { fprintf(stderr, "kernel_launch: memset failed\n"); return; }
    Args a{};
    for (int i = 0; i < 16; ++i) a.in[i] = (const float*)d_in[i];
    a.out = (float*)d_out; a.ws = (unsigned char*)d_ws;
    for (int i = 0; i < 64; ++i) a.invf_r[i] = (float)std::pow(10000.0, -(double)i * 2.0 / 128.0);
    for (int i = 0; i < 8; ++i) a.invf_a[i] = (float)std::pow(500000.0, -(double)i * 2.0 / 16.0);
#if MK_PER_PHASE
    for (int p = 0; p < N_PHASES; ++p) { a.ph_lo = p; a.ph_hi = p + 1; a.li = p; hipLaunchKernelGGL(mk_fwd, dim3(grid), dim3(NWAVES * 64), 0, stream, a); }
#else
    a.ph_lo = 0; a.ph_hi = N_PHASES; a.li = 0;
    hipLaunchKernelGGL(mk_fwd, dim3(grid), dim3(NWAVES * 64), 0, stream, a);
#endif
    const hipError_t le = hipPeekAtLastError();
    if (le != hipSuccess) fprintf(stderr, "kernel_launch: launch failed: %s\n", hipGetErrorName(le));
}
```
